# Optimizing an MI355X kernel written in HIP

```python
import jax, jax.numpy as jnp
from jax import lax
import numpy as np

D_MODEL = 2048
BATCH = 4
SEQ = 4096
DEPTH = 4

CHUNK = 64

FOX_WIDTH = D_MODEL // 2
FOX_HEAD_DIM = 128
FOX_HEADS = FOX_WIDTH // FOX_HEAD_DIM
Q_BLOCK = 128
FORGET_BIAS_MEAN = 2.0

SGU_WIDTH = D_MODEL // 2
SGU_GROUP_DIM = 128
SGU_GROUPS = SGU_WIDTH // SGU_GROUP_DIM
SGU_CHUNK = 128

D_FF = 5632
CONV_WIDTH = 3

RMS_EPS = 1e-6

IN_WIDTH = 3 * FOX_WIDTH + FOX_HEADS + 2 * SGU_WIDTH + 2 * D_MODEL

kernel_name = "hybrid_fox_sgu_convffn_trunk"


def rmsnorm(x, gain):
    xf = x.astype(jnp.float32)
    inv = lax.rsqrt(jnp.mean(xf * xf, axis=-1, keepdims=True) + RMS_EPS)
    return (xf * inv).astype(x.dtype) * gain


def split_in_proj(proj):
    sizes = (FOX_WIDTH, FOX_WIDTH, FOX_WIDTH, FOX_HEADS,
             SGU_WIDTH, SGU_WIDTH, D_MODEL, D_MODEL)
    points = tuple(int(p) for p in np.cumsum(sizes)[:-1])
    return jnp.split(proj, points, axis=-1)


def forgetting_attention(q, k, v, log_f):
    B, S, H, Dh = q.shape
    n_blk = S // Q_BLOCK
    scale = Dh ** -0.5
    c = jnp.cumsum(log_f, axis=1).transpose(0, 2, 1)
    qb = q.reshape(B, n_blk, Q_BLOCK, H, Dh).transpose(1, 0, 2, 3, 4)
    cb = c.reshape(B, H, n_blk, Q_BLOCK).transpose(2, 0, 1, 3)
    kpos = jnp.arange(S)

    def block(args):
        i, qi, ci = args
        s = jnp.einsum('bqhd,bkhd->bhqk', qi, k,
                       preferred_element_type=jnp.float32) * scale
        s = s + ci[..., :, None] - c[:, :, None, :]
        qpos = i * Q_BLOCK + jnp.arange(Q_BLOCK)
        mask = kpos[None, :] <= qpos[:, None]
        s = jnp.where(mask, s, -1e30)
        p = jax.nn.softmax(s, axis=-1).astype(v.dtype)
        return jnp.einsum('bhqk,bkhd->bqhd', p, v)

    o = lax.map(block, (jnp.arange(n_blk), qb, cb))
    return o.transpose(1, 0, 2, 3, 4).reshape(B, S, H * Dh)


def spatial_gating(u, v, g_norm, w_s, b_s):
    B, S, _ = v.shape
    n = S // SGU_CHUNK
    vc = rmsnorm(v, g_norm).reshape(B, n, SGU_CHUNK, SGU_GROUPS, SGU_GROUP_DIM)
    w = jnp.tril(w_s)
    mixed = jnp.einsum('gts,bnsgc->bntgc', w, vc) + b_s.T[None, None, :, :, None]
    return u * mixed.reshape(B, S, SGU_WIDTH)


def conv_ffn(h, w_up, conv_w, conv_b, w_down):
    S = h.shape[1]
    a, b = jnp.split(h @ w_up, 2, axis=-1)
    a_pad = jnp.pad(a, ((0, 0), (CONV_WIDTH - 1, 0), (0, 0)))
    acc = conv_b + conv_w[0] * a_pad[:, 0:S]
    for tap in range(1, CONV_WIDTH):
        acc = acc + conv_w[tap] * a_pad[:, tap:tap + S]
    return (jax.nn.gelu(acc) * b) @ w_down


def setup_inputs(seed: int = 0) -> dict:
    key = jax.random.key(seed)
    ks = jax.random.split(key, 16)
    f32 = jnp.float32

    def nrm(k, shape, fan_in):
        return jax.random.normal(k, shape, f32) * (fan_in ** -0.5)

    def gain(k, shape):
        return 1.0 + 0.01 * jax.random.normal(k, shape, f32)

    return {
        "x": jax.random.normal(ks[0], (BATCH, SEQ, D_MODEL), f32),
        "g_mix": gain(ks[1], (DEPTH, D_MODEL)),
        "w_in": nrm(ks[2], (DEPTH, D_MODEL, IN_WIDTH), D_MODEL),
        "b_forget": FORGET_BIAS_MEAN + 0.5 * jax.random.normal(ks[3], (DEPTH, FOX_HEADS), f32),
        "g_sgu": gain(ks[4], (DEPTH, SGU_WIDTH)),
        "w_spatial": nrm(ks[5], (DEPTH, SGU_GROUPS, SGU_CHUNK, SGU_CHUNK), SGU_CHUNK),
        "b_spatial": 1.0 + 0.1 * jax.random.normal(ks[6], (DEPTH, SGU_GROUPS, SGU_CHUNK), f32),
        "w_branch_a": nrm(ks[7], (DEPTH, FOX_WIDTH, D_MODEL), FOX_WIDTH),
        "w_branch_b": nrm(ks[8], (DEPTH, SGU_WIDTH, D_MODEL), SGU_WIDTH),
        "w_out": nrm(ks[9], (DEPTH, D_MODEL, D_MODEL), D_MODEL),
        "g_ffn": gain(ks[10], (DEPTH, D_MODEL)),
        "w_up": nrm(ks[11], (DEPTH, D_MODEL, 2 * D_FF), D_MODEL),
        "conv_w": nrm(ks[12], (DEPTH, CONV_WIDTH, D_FF), CONV_WIDTH),
        "conv_b": 0.01 * jax.random.normal(ks[13], (DEPTH, D_FF), f32),
        "w_down": nrm(ks[14], (DEPTH, D_FF, D_MODEL), D_FF),
        "g_final": gain(ks[15], (D_MODEL,)),
    }


def reference(x, g_mix, w_in, b_forget, g_sgu, w_spatial, b_spatial,
              w_branch_a, w_branch_b, w_out, g_ffn, w_up, conv_w, conv_b,
              w_down, g_final):
    B, S, _ = x.shape
    for l in range(DEPTH):
        h = rmsnorm(x, g_mix[l])
        q, k, v, f_logit, u, vg, gate_a, gate_b = split_in_proj(h @ w_in[l])
        log_f = jax.nn.log_sigmoid((f_logit + b_forget[l]).astype(jnp.float32))
        y_a = forgetting_attention(
            q.reshape(B, S, FOX_HEADS, FOX_HEAD_DIM),
            k.reshape(B, S, FOX_HEADS, FOX_HEAD_DIM),
            v.reshape(B, S, FOX_HEADS, FOX_HEAD_DIM),
            log_f)
        y_b = spatial_gating(jax.nn.gelu(u), jax.nn.gelu(vg),
                             g_sgu[l], w_spatial[l], b_spatial[l])
        merged = (jax.nn.sigmoid(gate_a) * (y_a @ w_branch_a[l])
                  + jax.nn.sigmoid(gate_b) * (y_b @ w_branch_b[l]))
        x = x + merged @ w_out[l]
        x = x + conv_ffn(rmsnorm(x, g_ffn[l]), w_up[l], conv_w[l], conv_b[l], w_down[l])
    return rmsnorm(x, g_final)
```

```cpp
#include <hip/hip_runtime.h>
#include <cstdio>
#include <cstdint>
#include <cstring>

#define LAS __attribute__((address_space(3)))
#define GAS __attribute__((address_space(1)))
typedef unsigned short bf16;
typedef short bf16x8 __attribute__((ext_vector_type(8)));
typedef float f32x4 __attribute__((ext_vector_type(4)));
typedef float f32x2 __attribute__((ext_vector_type(2)));
typedef unsigned u32x4 __attribute__((ext_vector_type(4)));
typedef unsigned u32x2 __attribute__((ext_vector_type(2)));

constexpr int DM = 2048, NB = 4, SEQ = 4096, DEPTH = 4, MTOK = NB * SEQ;
constexpr int FW = 1024, NH = 8, HD = 128, SW = 1024, NG = 8, GD = 128, SCH = 128, DFF = 5632, INW = 9224, NIN = 9216, NUP = 2 * DFF;
constexpr float RMS_EPS = 1e-6f;
constexpr float ATT_SCALE = 0.08838834764831845f;

__device__ __forceinline__ float bf_lo(unsigned w) { return __uint_as_float(w << 16); }
__device__ __forceinline__ float bf_hi(unsigned w) { return __uint_as_float(w & 0xffff0000u); }
__device__ __forceinline__ float bf2f(bf16 b) { return __uint_as_float(((unsigned)b) << 16); }
__device__ __forceinline__ unsigned cvt_pk_bf16(float lo, float hi) { unsigned r; asm volatile("v_cvt_pk_bf16_f32 %0, %1, %2" : "=v"(r) : "v"(lo), "v"(hi)); return r; }
__device__ __forceinline__ bf16 f2bf(float f) { return (bf16)(cvt_pk_bf16(f, 0.f) & 0xffffu); }
__device__ __forceinline__ float gelu_tanh(float x) {
    const float u = x * (0.7978845608028654f + 0.035677408136300125f * x * x);
    const float e = __builtin_amdgcn_exp2f(-2.8853900817779268f * u);
    return x * __builtin_amdgcn_rcpf(1.0f + e);
}
__device__ __forceinline__ float sigmoid_f(float x) { return __builtin_amdgcn_rcpf(1.0f + __builtin_amdgcn_exp2f(-1.4426950408889634f * x)); }
__device__ __forceinline__ float log_sigmoid_f(float z) { return fminf(z, 0.f) - log1pf(__expf(-fabsf(z))); }
__device__ __forceinline__ float wave_sum(float v) {
#pragma unroll
    for (int o = 1; o < 64; o <<= 1) v += __shfl_xor(v, o);
    return v;
}
__device__ __forceinline__ float wave_max(float v) {
#pragma unroll
    for (int o = 1; o < 64; o <<= 1) v = fmaxf(v, __shfl_xor(v, o));
    return v;
}

namespace pg8 {
#define PG8_LAS __attribute__((address_space(3)))
typedef unsigned short bf16_t;
typedef short bf16x8 __attribute__((ext_vector_type(8)));
typedef float f32x4 __attribute__((ext_vector_type(4)));
typedef unsigned u32x4 __attribute__((ext_vector_type(4)));
constexpr int BM = 256, BK = 64, HALF = 128, HTB = HALF * BK * 2  , STAGE_BYTES = 8 * HTB, NXCD = 8, WGM = 8;

__host__ __device__ __forceinline__ int lds_byte(int r, int c) { const int st = (r >> 4) * 2 + (c >> 5), rr = r & 15, cc = c & 31, ob = rr * 64 + cc * 2; return st * 1024 + (ob ^ (((ob >> 9) & 1) << 5)); }
__host__ __device__ __forceinline__ void stage_rc(int b, int& R, int& C) { const int st = b / 1024, sb = b % 1024, swz = sb ^ (((sb >> 9) & 1) << 5); R = (st >> 1) * 16 + swz / 64; C = (st & 1) * 32 + (swz % 64) / 2; }
__host__ __device__ __forceinline__ int perm32(int rho) { const int n = rho >> 4, i = rho & 15; return 8 * (i >> 2) + 4 * n + (i & 3); }

struct Unit { int pm, pn; };
struct Gemm { const bf16_t* A; const bf16_t* Bt; int M, N, K; };

struct StaticOrder {
    int nM, nN, nwg, G, c;
    __host__ __device__ void init(int M, int N, int G_, int c_) { nM = M / BM; nN = N / BM; nwg = nM * nN; G = G_; c = c_; }
    __host__ __device__ bool next(int i, Unit& u) const {
        const long L = (long)i * G + c; if (L >= nwg) return false;
        int wgid = (int)L; { const int q = nwg / NXCD, r = nwg % NXCD, xcd = wgid % NXCD, off = wgid / NXCD; wgid = (xcd < r ? xcd * (q + 1) : r * (q + 1) + (xcd - r) * q) + off; }
        const int nig = WGM * nN, gid = wgid / nig, fm = gid * WGM, gsz = (nM - fm) < WGM ? (nM - fm) : WGM;
        u.pm = fm + ((wgid % nig) % gsz); u.pn = (wgid % nig) / gsz; return true;
    }
    __device__ __forceinline__ void a_ready(const Unit&) const {}
    __device__ __forceinline__ void done(const Unit&) const {}
};

__device__ __forceinline__ void row_inv8(const float* ssq, int row0, int fq, float (&inv)[2][4]) {
#pragma unroll
    for (int ai = 0; ai < 2; ++ai)
#pragma unroll
        for (int m = 0; m < 4; ++m) {
            const f32x4* p = (const f32x4*)(ssq + (size_t)(row0 + ai * HALF + m * 16) * 32) + 2 * fq;
            const f32x4 a = p[0], b = p[1];
            float s = ((a[0] + a[1]) + (a[2] + a[3])) + ((b[0] + b[1]) + (b[2] + b[3]));
            s += __shfl_xor(s, 16); s += __shfl_xor(s, 32);
            inv[ai][m] = rsqrtf(s * (1.0f / DM) + RMS_EPS);
        }
}
struct EpiInProj {
    static constexpr bool PERM = false, APERM = false, AFTER_DRAIN = false;
    const float* ssq; bf16* R1;
    __device__ __forceinline__ void operator()(const f32x4 (&acc)[2][2][4][2], const Unit& u, int wr, int wc, int fr, int fq) const {
        const int row0 = u.pm * BM + wr * 64 + fr;
        float inv[2][4]; row_inv8(ssq, row0, fq, inv);
        int mode, ld, colb; bf16* base;
        if (u.pn < 20) { const int t = u.pn >> 2; base = R1 + (size_t)t * MTOK * 1024; ld = 1024; colb = (u.pn & 3) * 256; mode = t < 3 ? 0 : 1; }
        else { const int t = (u.pn - 20) >> 3; base = R1 + (size_t)5 * MTOK * 1024 + (size_t)t * MTOK * 2048; ld = 2048; colb = ((u.pn - 20) & 7) * 256; mode = 2; }
#pragma unroll
        for (int ai = 0; ai < 2; ++ai)
#pragma unroll
            for (int m = 0; m < 4; ++m) { bf16* rowp = base + (size_t)(row0 + ai * HALF + m * 16) * ld + colb + wc * 32 + 4 * fq;
#pragma unroll
                for (int bj = 0; bj < 2; ++bj)
#pragma unroll
                    for (int n = 0; n < 2; ++n) { f32x4 v = acc[ai][bj][m][n] * inv[ai][m];
                        if (mode == 1) { v[0] = gelu_tanh(v[0]); v[1] = gelu_tanh(v[1]); v[2] = gelu_tanh(v[2]); v[3] = gelu_tanh(v[3]); }
                        else if (mode == 2) { v[0] = sigmoid_f(v[0]); v[1] = sigmoid_f(v[1]); v[2] = sigmoid_f(v[2]); v[3] = sigmoid_f(v[3]); }
                        u32x2 w; w.x = cvt_pk_bf16(v[0], v[1]); w.y = cvt_pk_bf16(v[2], v[3]);
                        *(u32x2*)(rowp + bj * HALF + n * 16) = w; } }
    }
};
struct EpiBranchA {
    static constexpr bool PERM = false, APERM = false, AFTER_DRAIN = false;
    const bf16* SA; float* T;
    __device__ __forceinline__ void operator()(const f32x4 (&acc)[2][2][4][2], const Unit& u, int wr, int wc, int fr, int fq) const {
        const int row0 = u.pm * BM + wr * 64 + fr, col0 = u.pn * BM + wc * 32 + 4 * fq;
#pragma unroll
        for (int ai = 0; ai < 2; ++ai)
#pragma unroll
            for (int m = 0; m < 4; ++m) { const size_t off = (size_t)(row0 + ai * HALF + m * 16) * DM + col0;
#pragma unroll
                for (int bj = 0; bj < 2; ++bj)
#pragma unroll
                    for (int n = 0; n < 2; ++n) { const u32x2 g = *(const u32x2*)(SA + off + bj * HALF + n * 16);
                        const f32x4 gv = {bf_lo(g.x), bf_hi(g.x), bf_lo(g.y), bf_hi(g.y)};
                        *(f32x4*)(T + off + bj * HALF + n * 16) = acc[ai][bj][m][n] * gv; } }
    }
};
struct EpiBranchB {
    static constexpr bool PERM = false, APERM = false, AFTER_DRAIN = false;
    const bf16* SB; const float* T; bf16* MG;
    __device__ __forceinline__ void operator()(const f32x4 (&acc)[2][2][4][2], const Unit& u, int wr, int wc, int fr, int fq) const {
        const int row0 = u.pm * BM + wr * 64 + fr, col0 = u.pn * BM + wc * 32 + 4 * fq;
#pragma unroll
        for (int ai = 0; ai < 2; ++ai)
#pragma unroll
            for (int m = 0; m < 4; ++m) { const size_t off = (size_t)(row0 + ai * HALF + m * 16) * DM + col0;
#pragma unroll
                for (int bj = 0; bj < 2; ++bj)
#pragma unroll
                    for (int n = 0; n < 2; ++n) { const u32x2 g = *(const u32x2*)(SB + off + bj * HALF + n * 16);
                        const f32x4 gv = {bf_lo(g.x), bf_hi(g.x), bf_lo(g.y), bf_hi(g.y)};
                        const f32x4 t = *(const f32x4*)(T + off + bj * HALF + n * 16);
                        const f32x4 v = t + acc[ai][bj][m][n] * gv;
                        u32x2 w; w.x = cvt_pk_bf16(v[0], v[1]); w.y = cvt_pk_bf16(v[2], v[3]);
                        *(u32x2*)(MG + off + bj * HALF + n * 16) = w; } }
    }
};
struct EpiResid {
    static constexpr bool PERM = false, APERM = false, AFTER_DRAIN = false;
    const float* xin; float* xout;
    __device__ __forceinline__ void operator()(const f32x4 (&acc)[2][2][4][2], const Unit& u, int wr, int wc, int fr, int fq) const {
        const int row0 = u.pm * BM + wr * 64 + fr, col0 = u.pn * BM + wc * 32 + 4 * fq;
#pragma unroll
        for (int ai = 0; ai < 2; ++ai)
#pragma unroll
            for (int m = 0; m < 4; ++m) { const size_t off = (size_t)(row0 + ai * HALF + m * 16) * DM + col0;
#pragma unroll
                for (int bj = 0; bj < 2; ++bj)
#pragma unroll
                    for (int n = 0; n < 2; ++n) { const f32x4 b = *(const f32x4*)(xin + off + bj * HALF + n * 16);
                        *(f32x4*)(xout + off + bj * HALF + n * 16) = b + acc[ai][bj][m][n]; } }
    }
};
struct EpiUp1 {
    static constexpr bool PERM = false, APERM = false, AFTER_DRAIN = false;
    const float* ssq; bf16* AR; bf16* BR;
    __device__ __forceinline__ void operator()(const f32x4 (&acc)[2][2][4][2], const Unit& u, int wr, int wc, int fr, int fq) const {
        const int row0 = u.pm * BM + wr * 64 + fr, ch0 = u.pn * HALF + wc * 32 + 4 * fq;
        float inv[2][4]; row_inv8(ssq, row0, fq, inv);
#pragma unroll
        for (int ai = 0; ai < 2; ++ai)
#pragma unroll
            for (int m = 0; m < 4; ++m) { const size_t off = (size_t)(row0 + ai * HALF + m * 16) * DFF + ch0;
#pragma unroll
                for (int bj = 0; bj < 2; ++bj)
#pragma unroll
                    for (int n = 0; n < 2; ++n) { const f32x4 v = acc[ai][bj][m][n] * inv[ai][m];
                        u32x2 w; w.x = cvt_pk_bf16(v[0], v[1]); w.y = cvt_pk_bf16(v[2], v[3]);
                        *(u32x2*)((bj ? BR : AR) + off + n * 16) = w; } }
    }
};

template <class Epi, class Sched, bool ALIGN_EPI = false, bool SP2 = false>
__device__ __forceinline__ void gemm_phase(PG8_LAS unsigned char* lds, const Gemm g, const Sched& S, const Epi& E, int tid_in) {
    const int tid = tid_in, wid = __builtin_amdgcn_readfirstlane(tid >> 6), lane = tid & 63, wr = wid >> 2, wc = wid & 3, fr = lane & 15, fq = lane >> 4;
    const int K = g.K, nt = K / BK;
    unsigned voffA[2], voffB[2];
#pragma unroll
    for (int i = 0; i < 2; ++i) { int R, C; stage_rc(tid * 16 + i * 8192, R, C); const int Rb = Epi::PERM ? ((R & ~31) + perm32(R & 31)) : R;
        const int Ra = Epi::APERM ? (128 * ((R >> 6) & 1) + 8 * (R & 15) + ((R >> 4) & 3)) : R; voffA[i] = (unsigned)(Ra * K + C) * 2u; voffB[i] = (unsigned)(Rb * K + C) * 2u; }
    const size_t kstep = (size_t)(BK * 2);
    const size_t hstep = (size_t)HALF * K * 2;
    const size_t tstep = 2 * hstep; const size_t hstepA = Epi::APERM ? (size_t)4 * K * 2 : hstep;
    const unsigned ldsw = (unsigned)wid * 1024u;
    const int aoff = lds_byte(wr * 64 + fr, fq * 8), boff = lds_byte(wc * 32 + fr, fq * 8);
#define PG8_SA(b, h) (((b) * 2 + (h)) * HTB)
#define PG8_SB(b, h) ((4 + (b) * 2 + (h)) * HTB)
#define PG8_STAGE(bufoff, gbase, voff) do { _Pragma("unroll") for (int _i = 0; _i < 2; ++_i) \
        __builtin_amdgcn_global_load_lds((const unsigned*)((const char*)(gbase) + (voff)[_i]), (PG8_LAS unsigned*)(lds + (bufoff) + ldsw + _i * 8192), 16, 0, 0); } while (0)
#define PG8_LDA(dst, b, h) do { _Pragma("unroll") for (int m = 0; m < 4; ++m) _Pragma("unroll") for (int k = 0; k < 2; ++k) dst[m][k] = *(const PG8_LAS bf16x8*)(lds + PG8_SA(b, h) + aoff + m * 2048 + k * 1024); } while (0)
#define PG8_LDB(dst, b, h) do { _Pragma("unroll") for (int n = 0; n < 2; ++n) _Pragma("unroll") for (int k = 0; k < 2; ++k) dst[n][k] = *(const PG8_LAS bf16x8*)(lds + PG8_SB(b, h) + boff + n * 2048 + k * 1024); } while (0)
#define PG8_MMA(ai, bj, At, Bt) do { __builtin_amdgcn_s_setprio(1); _Pragma("unroll") for (int m = 0; m < 4; ++m) _Pragma("unroll") for (int n = 0; n < 2; ++n) _Pragma("unroll") for (int k = 0; k < 2; ++k) \
        acc[ai][bj][m][n] = __builtin_amdgcn_mfma_f32_16x16x32_bf16(Bt[n][k], At[m][k], acc[ai][bj][m][n], 0, 0, 0); __builtin_amdgcn_s_setprio(0); } while (0)
#define PG8_WAIT_V(n) asm volatile("s_waitcnt vmcnt(" #n ")" ::: "memory")
#define PG8_WAIT_L(n) asm volatile("s_waitcnt lgkmcnt(" #n ")" ::: "memory")
#define PG8_BAR __builtin_amdgcn_s_barrier()
#define PG8_SCHED __builtin_amdgcn_sched_barrier(0)
    Unit cur, nxt; int ui = 0;
    if (!S.next(0, cur)) return;
    f32x4 acc[2][2][4][2];
#pragma unroll
    for (int a = 0; a < 2; ++a)
#pragma unroll
        for (int b = 0; b < 2; ++b)
#pragma unroll
            for (int m = 0; m < 4; ++m)
#pragma unroll
                for (int n = 0; n < 2; ++n) acc[a][b][m][n] = (f32x4){0.f, 0.f, 0.f, 0.f};
    bf16x8 At[4][2], B0[2][2], B1[2][2];
    const char* cA = (const char*)g.A + (size_t)cur.pm * tstep; const char* cB = (const char*)g.Bt + (size_t)cur.pn * tstep;
    S.a_ready(cur);
    if constexpr (SP2) {
        PG8_STAGE(PG8_SB(0, 0), cB, voffB); PG8_STAGE(PG8_SB(0, 1), cB + hstep, voffB); PG8_STAGE(PG8_SA(0, 0), cA, voffA); PG8_STAGE(PG8_SA(0, 1), cA + hstepA, voffA);
        if (wr == 1) PG8_BAR;
        PG8_WAIT_V(2); PG8_BAR;
        PG8_STAGE(PG8_SB(1, 0), cB + kstep, voffB); PG8_STAGE(PG8_SA(1, 0), cA + kstep, voffA); PG8_STAGE(PG8_SB(1, 1), cB + hstep + kstep, voffB);
        PG8_WAIT_V(6); PG8_BAR;
    } else {
        PG8_STAGE(PG8_SB(0, 0), cB, voffB); PG8_STAGE(PG8_SA(0, 0), cA, voffA); PG8_STAGE(PG8_SB(0, 1), cB + hstep, voffB); PG8_STAGE(PG8_SA(0, 1), cA + hstepA, voffA);
        if (wr == 1) PG8_BAR;
        PG8_WAIT_V(4); PG8_BAR;
        PG8_STAGE(PG8_SB(1, 0), cB + kstep, voffB); PG8_STAGE(PG8_SA(1, 0), cA + kstep, voffA); PG8_STAGE(PG8_SB(1, 1), cB + hstep + kstep, voffB);
        PG8_WAIT_V(6); PG8_BAR;
    }
    for (;;) {
        const bool has_next = S.next(ui + 1, nxt);
        const char* nA = has_next ? (const char*)g.A + (size_t)nxt.pm * tstep : cA; const char* nB = has_next ? (const char*)g.Bt + (size_t)nxt.pn * tstep : cB;
        for (int t = 0; t < nt; t += 2) {
            const bool last = (t == nt - 2);
            const char* a1 = cA + (size_t)(t + 1) * kstep;
            const char* a2 = last ? nA : cA + (size_t)(t + 2) * kstep; const char* b2 = last ? nB : cB + (size_t)(t + 2) * kstep;
            const char* a3 = a2 + kstep; const char* b3 = b2 + kstep;
            if (last && has_next) S.a_ready(nxt);
            if constexpr (SP2) {
            PG8_LDB(B0, 0, 0); PG8_LDB(B1, 0, 1); PG8_SCHED; PG8_LDA(At, 0, 0); PG8_STAGE(PG8_SA(1, 1), a1 + hstepA, voffA);
            PG8_WAIT_V(8); PG8_WAIT_L(0); PG8_BAR; PG8_MMA(0, 0, At, B0); PG8_MMA(0, 1, At, B1); PG8_BAR; PG8_SCHED;
            PG8_LDA(At, 0, 1); PG8_STAGE(PG8_SB(0, 0), b2, voffB); PG8_STAGE(PG8_SB(0, 1), b2 + hstep, voffB); PG8_STAGE(PG8_SA(0, 0), a2, voffA);
            PG8_WAIT_V(8); PG8_WAIT_L(0); PG8_BAR; PG8_MMA(1, 0, At, B0); PG8_MMA(1, 1, At, B1); PG8_BAR; PG8_SCHED;
            PG8_LDB(B0, 1, 0); PG8_LDB(B1, 1, 1); PG8_SCHED; PG8_LDA(At, 1, 0); PG8_STAGE(PG8_SA(0, 1), a2 + hstepA, voffA);
            PG8_WAIT_V(8); PG8_WAIT_L(0); PG8_BAR; PG8_MMA(0, 0, At, B0); PG8_MMA(0, 1, At, B1); PG8_BAR; PG8_SCHED;
            PG8_LDA(At, 1, 1); PG8_STAGE(PG8_SB(1, 0), b3, voffB); PG8_STAGE(PG8_SB(1, 1), b3 + hstep, voffB); PG8_STAGE(PG8_SA(1, 0), a3, voffA);
            PG8_WAIT_V(8); PG8_WAIT_L(0); PG8_BAR; PG8_MMA(1, 0, At, B0); PG8_MMA(1, 1, At, B1); PG8_BAR; PG8_SCHED;
            } else {
            PG8_LDB(B0, 0, 0); PG8_SCHED; PG8_LDA(At, 0, 0); PG8_STAGE(PG8_SA(1, 1), a1 + hstepA, voffA);
            PG8_WAIT_L(8); PG8_BAR; PG8_WAIT_L(0); PG8_MMA(0, 0, At, B0); PG8_BAR; PG8_SCHED;
            PG8_LDB(B1, 0, 1); PG8_STAGE(PG8_SB(0, 0), b2, voffB);
            PG8_BAR; PG8_WAIT_L(0); PG8_MMA(0, 1, At, B1); PG8_BAR;
            PG8_LDA(At, 0, 1); PG8_STAGE(PG8_SA(0, 0), a2, voffA);
            PG8_BAR; PG8_WAIT_L(0); PG8_MMA(1, 0, At, B0); PG8_BAR; PG8_SCHED;
            PG8_STAGE(PG8_SB(0, 1), b2 + hstep, voffB);
            PG8_WAIT_V(6); PG8_BAR; PG8_MMA(1, 1, At, B1); PG8_BAR;
            PG8_LDB(B0, 1, 0); PG8_SCHED; PG8_LDA(At, 1, 0); PG8_STAGE(PG8_SA(0, 1), a2 + hstepA, voffA);
            PG8_WAIT_L(8); PG8_BAR; PG8_WAIT_L(0); PG8_MMA(0, 0, At, B0); PG8_BAR; PG8_SCHED;
            PG8_LDB(B1, 1, 1); PG8_STAGE(PG8_SB(1, 0), b3, voffB);
            PG8_BAR; PG8_WAIT_L(0); PG8_MMA(0, 1, At, B1); PG8_BAR;
            PG8_LDA(At, 1, 1); PG8_STAGE(PG8_SA(1, 0), a3, voffA);
            PG8_BAR; PG8_WAIT_L(0); PG8_MMA(1, 0, At, B0); PG8_BAR; PG8_SCHED;
            PG8_STAGE(PG8_SB(1, 1), b3 + hstep, voffB);
            PG8_WAIT_V(6); PG8_BAR; PG8_MMA(1, 1, At, B1); PG8_BAR;
            }
        }
        if constexpr (ALIGN_EPI) { if (wr == 0) PG8_BAR; }
        if constexpr (!Epi::AFTER_DRAIN) { E(acc, cur, wr, wc, fr, fq); S.done(cur); }
        if (!has_next) break;
#pragma unroll
        for (int a = 0; a < 2; ++a)
#pragma unroll
            for (int b = 0; b < 2; ++b)
#pragma unroll
                for (int m = 0; m < 4; ++m)
#pragma unroll
                    for (int n = 0; n < 2; ++n) acc[a][b][m][n] = (f32x4){0.f, 0.f, 0.f, 0.f};
        cur = nxt; cA = nA; cB = nB; ++ui;
        if constexpr (ALIGN_EPI) { if (wr == 1) PG8_BAR; }
    }
    PG8_WAIT_V(0);
    if constexpr (!ALIGN_EPI) { if (wr == 0) PG8_BAR; }
    PG8_BAR;
    if constexpr (Epi::AFTER_DRAIN) { E.fused(acc, cur, wr, wc, fr, fq, lds, wid, lane); S.done(cur); }
#undef PG8_SA
#undef PG8_SB
#undef PG8_STAGE
#undef PG8_LDA
#undef PG8_LDB
#undef PG8_MMA
#undef PG8_WAIT_V
#undef PG8_WAIT_L
#undef PG8_BAR
#undef PG8_SCHED
}
}

constexpr size_t MiB = (size_t)1 << 20;
constexpr size_t WS_CTL = 0, CTL_ZERO_BYTES = 1 * MiB;
constexpr size_t WS_WF = 1 * MiB;
constexpr size_t WS_SSQ = 2 * MiB;
constexpr size_t WS_CL = 4 * MiB;
constexpr size_t WS_TOT = 5 * MiB;
constexpr size_t WS_W = 8 * MiB, W_LAYER = 118 * MiB;
constexpr size_t W_IN = 0, W_A = 36 * MiB, W_B = 40 * MiB, W_OUT = 44 * MiB, W_UP = 52 * MiB, W_DOWN = 96 * MiB;
constexpr size_t WS_X = 480 * MiB;
constexpr size_t WS_XB = 608 * MiB;
constexpr size_t WS_R1 = 672 * MiB;
constexpr size_t WS_YA = 960 * MiB, WS_YB = 992 * MiB, WS_MG = 1024 * MiB;
constexpr size_t WS_G = 1088 * MiB;
constexpr size_t WS_END = 1264 * MiB;
constexpr int CW_BAR = 4096;

constexpr int LDS_BYTES = 160 * 1024;
constexpr int MISC_OFF = LDS_BYTES - 256;

#define XB_TMO      128
#define XB_XCNT(j)  (256  + 64 * (j))
#define XB_XSUB(j)  (1280 + 64 * (j))
#define XB_XGEN(j)  (2304 + 64 * (j))
#define XB_TOP      3328
#define XB_TOPGEN   3392
#define XCD_BAR_WORDS 3456
#define XB_SPIN_CAP (1u << 18)

__device__ __forceinline__ unsigned xb_ld(unsigned* p)              { return __hip_atomic_load(p, __ATOMIC_RELAXED, __HIP_MEMORY_SCOPE_AGENT); }
__device__ __forceinline__ unsigned xb_add(unsigned* p, unsigned v) { return __hip_atomic_fetch_add(p, v, __ATOMIC_RELAXED, __HIP_MEMORY_SCOPE_AGENT); }
__device__ __forceinline__ unsigned xb_xcc_id() { return (unsigned)__builtin_amdgcn_s_getreg((3 << 11) | 20) & 0xFu; }
#define XB_SPIN(cond, bar) do { unsigned _sp = 0; while (cond) { __builtin_amdgcn_s_sleep(1); \
    if ((++_sp & 255u) == 0u) { if (xb_ld(&(bar)[XB_TMO])) break; if (_sp > XB_SPIN_CAP) { atomicAdd(&(bar)[XB_TMO], 1u); break; } } } } while (0)

struct XcdBarrier {
    unsigned* bar; unsigned x;
    volatile LAS unsigned* st;
};

__device__ __forceinline__ XcdBarrier xcd_barrier_post(unsigned* bar, volatile LAS unsigned* st) {
    XcdBarrier b; b.bar = bar; b.x = xb_xcc_id(); b.st = st;
    if (threadIdx.x == 0) (void)xb_add(&bar[XB_XCNT(b.x)], 1u);
    return b;
}
__device__ __forceinline__ void xcd_barrier_complete(unsigned* bar, unsigned x, unsigned& nloc, unsigned& nx) {
    const unsigned G = gridDim.x * gridDim.y * gridDim.z;
    unsigned sum, cnt, mine, sp = 0u;
    for (;;) {
        sum = 0u; cnt = 0u; mine = 0u;
#pragma unroll
        for (unsigned j = 0; j < 16; ++j) { const unsigned c = xb_ld(&bar[XB_XCNT(j)]); sum += c; cnt += (c > 0u) ? 1u : 0u; mine = (j == x) ? c : mine; }
        if (sum == G) break;
        __builtin_amdgcn_s_sleep(1);
        if ((++sp & 255u) == 0u) { if (xb_ld(&bar[XB_TMO])) break; if (sp > XB_SPIN_CAP) { atomicAdd(&bar[XB_TMO], 1u); break; } }
    }
    nloc = mine > 0u ? mine : 1u; nx = cnt > 0u ? cnt : 1u;
}

__device__ __forceinline__ void xcd_barrier(const XcdBarrier& b) {
    asm volatile("s_waitcnt vmcnt(0)" ::: "memory");
    __syncthreads();
    if (threadIdx.x == 0) {
        unsigned* bar = b.bar;
        __builtin_amdgcn_s_waitcnt(0);
        unsigned nloc = b.st[0], nx = b.st[1];
        if (nloc == 0u) { xcd_barrier_complete(bar, b.x, nloc, nx); b.st[0] = nloc; b.st[1] = nx; }
        const unsigned old = xb_add(&bar[XB_XSUB(b.x)], 1u);
        const unsigned gen = old / nloc;
        if (old + 1u == (gen + 1u) * nloc) {
            __builtin_amdgcn_fence(__ATOMIC_RELEASE, "agent");
            asm volatile("s_waitcnt vmcnt(0)" ::: "memory");
            const unsigned og = xb_add(&bar[XB_TOP], 1u);
            const unsigned tg = og / nx;
            if (og + 1u == (tg + 1u) * nx) xb_add(&bar[XB_TOPGEN], 1u);
            else XB_SPIN(xb_ld(&bar[XB_TOPGEN]) == tg, bar);
            __builtin_amdgcn_fence(__ATOMIC_ACQUIRE, "agent");
            xb_add(&bar[XB_XGEN(b.x)], 1u);
            asm volatile("s_waitcnt vmcnt(0)" ::: "memory");
        } else {
            XB_SPIN(xb_ld(&bar[XB_XGEN(b.x)]) == gen, bar);
            __builtin_amdgcn_fence(__ATOMIC_ACQUIRE, "agent");
            asm volatile("s_waitcnt vmcnt(0)" ::: "memory");
        }
    }
    __syncthreads();
}

struct Args { const float* in[16]; float* out; unsigned char* ws; int ph_lo, ph_hi; };
enum { IN_X = 0, IN_GMIX, IN_WIN, IN_BF, IN_GSGU, IN_WSP, IN_BSP, IN_WA, IN_WB, IN_WOUT, IN_GFFN, IN_WUP, IN_CW, IN_CB, IN_WDOWN, IN_GFIN };

__device__ __forceinline__ void tr_tile(const float* src, int ldS, int srcCol0, const float* gain, bf16* dst, int K, int dstRow0, int k0, float* T, int tid) {
    const int kr = tid >> 5, c4 = tid & 31;
    f32x4 v[4]; float g[4];
#pragma unroll
    for (int i = 0; i < 4; ++i) { const int k = k0 + kr + 16 * i; v[i] = *(const f32x4*)(src + (size_t)k * ldS + srcCol0 + 4 * c4); g[i] = gain ? gain[k] : 1.0f; }
#pragma unroll
    for (int i = 0; i < 4; ++i) { float* t = T + (kr + 16 * i) * 129 + 4 * c4; t[0] = v[i][0] * g[i]; t[1] = v[i][1] * g[i]; t[2] = v[i][2] * g[i]; t[3] = v[i][3] * g[i]; }
    __syncthreads();
#pragma unroll
    for (int i = 0; i < 2; ++i) { const int idx = tid + 512 * i, n = idx >> 3, kc = idx & 7; const float* t = T + (8 * kc) * 129 + n;
        u32x4 w; w.x = cvt_pk_bf16(t[0], t[129]); w.y = cvt_pk_bf16(t[2 * 129], t[3 * 129]); w.z = cvt_pk_bf16(t[4 * 129], t[5 * 129]); w.w = cvt_pk_bf16(t[6 * 129], t[7 * 129]);
        *(u32x4*)(dst + (size_t)(dstRow0 + n) * K + k0 + 8 * kc) = w; }
    __syncthreads();
}
__device__ __forceinline__ void ph_rowstats(const float* src, bf16* xb, float* ssq, int gw, int ngw, int lane) {
    for (int row = gw; row < MTOK; row += ngw) {
        const f32x4* p = (const f32x4*)(src + (size_t)row * DM) + lane; f32x4 v[8]; float s = 0.f;
#pragma unroll
        for (int j = 0; j < 8; ++j) { v[j] = p[64 * j]; s += (v[j][0] * v[j][0] + v[j][1] * v[j][1]) + (v[j][2] * v[j][2] + v[j][3] * v[j][3]); }
        s = wave_sum(s);
        u32x2* o = (u32x2*)(xb + (size_t)row * DM) + lane;
#pragma unroll
        for (int j = 0; j < 8; ++j) { u32x2 w; w.x = cvt_pk_bf16(v[j][0], v[j][1]); w.y = cvt_pk_bf16(v[j][2], v[j][3]); o[64 * j] = w; }
        if (lane < 32) ssq[(size_t)row * 32 + lane] = lane == 0 ? s : 0.f;
    }
}
__device__ __forceinline__ void ph_prologue(const Args& a, unsigned char* lds, int tid, int lane, int wave) {
    unsigned char* ws = a.ws; float* T = (float*)lds;
    constexpr int J_IN = 32 * 72, J_A = 16 * 16, J_OUT = 32 * 16, J_UP = 32 * 88, J_DOWN = 88 * 16, J_LAYER = J_IN + 2 * J_A + J_OUT + J_UP + J_DOWN;
    for (int j = blockIdx.x; j < DEPTH * J_LAYER; j += gridDim.x) {
        const int l = j / J_LAYER; int r = j % J_LAYER; bf16* wl = (bf16*)(ws + WS_W + (size_t)l * W_LAYER);
        if (r < J_IN) { const int tn = r % 72, kt = r / 72; tr_tile(a.in[IN_WIN] + (size_t)l * DM * INW, INW, tn * 128 < 3072 ? tn * 128 : tn * 128 + 8, a.in[IN_GMIX] + l * DM, (bf16*)((unsigned char*)wl + W_IN), DM, tn * 128, kt * 64, T, tid); continue; } r -= J_IN;
        if (r < J_A) { const int tn = r % 16, kt = r / 16; tr_tile(a.in[IN_WA] + (size_t)l * FW * DM, DM, tn * 128, nullptr, (bf16*)((unsigned char*)wl + W_A), FW, tn * 128, kt * 64, T, tid); continue; } r -= J_A;
        if (r < J_A) { const int tn = r % 16, kt = r / 16; tr_tile(a.in[IN_WB] + (size_t)l * SW * DM, DM, tn * 128, nullptr, (bf16*)((unsigned char*)wl + W_B), SW, tn * 128, kt * 64, T, tid); continue; } r -= J_A;
        if (r < J_OUT) { const int tn = r % 16, kt = r / 16; tr_tile(a.in[IN_WOUT] + (size_t)l * DM * DM, DM, tn * 128, nullptr, (bf16*)((unsigned char*)wl + W_OUT), DM, tn * 128, kt * 64, T, tid); continue; } r -= J_OUT;
        if (r < J_UP) { const int tn = r % 88, kt = r / 88; tr_tile(a.in[IN_WUP] + (size_t)l * DM * NUP, NUP, (tn & 1) * DFF + (tn >> 1) * 128, a.in[IN_GFFN] + l * DM, (bf16*)((unsigned char*)wl + W_UP), DM, tn * 128, kt * 64, T, tid); continue; } r -= J_UP;
        { const int tn = r % 16, kt = r / 16; tr_tile(a.in[IN_WDOWN] + (size_t)l * DFF * DM, DM, tn * 128, nullptr, (bf16*)((unsigned char*)wl + W_DOWN), DFF, tn * 128, kt * 64, T, tid); }
    }
    float* wf = (float*)(ws + WS_WF);
    for (int i = blockIdx.x * 512 + tid; i < DEPTH * NH * DM; i += gridDim.x * 512) { const int k = i % DM, h = (i / DM) % NH, l = i / (DM * NH);
        wf[i] = a.in[IN_WIN][((size_t)l * DM + k) * INW + 3 * FW + h] * a.in[IN_GMIX][l * DM + k]; }
    ph_rowstats(a.in[IN_X], (bf16*)(ws + WS_XB), (float*)(ws + WS_SSQ), blockIdx.x * 8 + wave, gridDim.x * 8, lane);
}

__device__ __forceinline__ void f_unit(const Args& a, int l, int chunk, unsigned char* lds, int tid, int lane, int wave) {
    unsigned char* ws = a.ws; const bf16* xb = (const bf16*)(ws + WS_XB); const float* wf = (const float*)(ws + WS_WF) + (size_t)l * NH * DM; const float* ssq = (const float*)(ws + WS_SSQ);
    float* part = (float*)lds;
    float* lf = (float*)(lds + 16384);
    { const int tl = (wave & 3) * 64 + lane, kh = wave >> 2;
      const bf16* xr = xb + (size_t)(chunk * 256 + tl) * DM + kh * 1024; const float* wk = wf + kh * 1024;
      float f[8];
#pragma unroll
      for (int h = 0; h < 8; ++h) f[h] = 0.f;
      for (int k8 = 0; k8 < 128; ++k8) { const u32x4 w = *(const u32x4*)(xr + 8 * k8);
          const float xv[8] = {bf_lo(w.x), bf_hi(w.x), bf_lo(w.y), bf_hi(w.y), bf_lo(w.z), bf_hi(w.z), bf_lo(w.w), bf_hi(w.w)};
#pragma unroll
          for (int h = 0; h < 8; ++h) {
#pragma unroll
              for (int j = 0; j < 8; ++j) f[h] += xv[j] * wk[h * DM + 8 * k8 + j]; } }
#pragma unroll
      for (int h = 0; h < 8; ++h) part[(kh * 256 + tl) * 8 + h] = f[h]; }
    __syncthreads();
    if (tid < 256) { const int row = chunk * 256 + tid; const f32x4* p = (const f32x4*)(ssq + (size_t)row * 32); float s = 0.f;
#pragma unroll
        for (int j = 0; j < 8; ++j) { const f32x4 q = p[j]; s += (q[0] + q[1]) + (q[2] + q[3]); }
        const float inv = rsqrtf(s * (1.0f / DM) + RMS_EPS);
#pragma unroll
        for (int h = 0; h < 8; ++h) lf[tid * 8 + h] = log_sigmoid_f((part[tid * 8 + h] + part[(256 + tid) * 8 + h]) * inv + a.in[IN_BF][l * NH + h]); }
    __syncthreads();
    if (tid < 8) { float run = 0.f; for (int t = 0; t < 256; ++t) { run += lf[t * 8 + tid]; lf[t * 8 + tid] = run; }
        ((float*)(ws + WS_TOT))[chunk * 8 + tid] = run; }
    __syncthreads();
    { float* cl = (float*)(ws + WS_CL); const int b = chunk >> 4, c16 = chunk & 15;
      for (int i = tid; i < 2048; i += 512) { const int tl = i & 255, h = i >> 8; cl[((size_t)(b * NH + h)) * SEQ + c16 * 256 + tl] = lf[tl * 8 + h]; } }
    __syncthreads();
}

__device__ __forceinline__ void attn_simple(const Args& a, unsigned char* lds, int tid, int lane, int wave) {
    unsigned char* ws = a.ws; const bf16* Q = (const bf16*)(ws + WS_R1); const bf16* Kp = Q + (size_t)MTOK * 1024; const bf16* Vp = Kp + (size_t)MTOK * 1024;
    bf16* YA = (bf16*)(ws + WS_YA); const float* cl = (const float*)(ws + WS_CL); const float* tot = (const float*)(ws + WS_TOT);
    float* ctab = (float*)lds; float* sc = (float*)(lds + 16384 + wave * 16384); float* qv = (float*)(lds + 16384 + 8 * 16384 + wave * 512);
    for (int item = blockIdx.x; item < NB * NH * 8; item += gridDim.x) {
        const int bh = item >> 3, sub = item & 7, b = bh >> 3, h = bh & 7;
        __syncthreads();
        for (int i = tid; i < SEQ; i += 512) { const int ch = i >> 8; float pre = 0.f; for (int j = 0; j < ch; ++j) pre += tot[(b * 16 + j) * 8 + h]; ctab[i] = cl[(size_t)bh * SEQ + i] + pre; }
        __syncthreads();
        for (int t = sub * 8 + wave; t < SEQ; t += 64) {
            const size_t rowq = (size_t)(b * SEQ + t) * 1024 + h * HD;
            { const unsigned w = *(const unsigned*)(Q + rowq + 2 * lane); qv[2 * lane] = bf_lo(w); qv[2 * lane + 1] = bf_hi(w); }
            const float ct = ctab[t]; float mx = -1e30f;
            for (int j = lane; j <= t; j += 64) { const bf16* kr = Kp + (size_t)(b * SEQ + j) * 1024 + h * HD; float s = 0.f;
#pragma unroll
                for (int d8 = 0; d8 < 16; ++d8) { const u32x4 w = *(const u32x4*)(kr + 8 * d8); const f32x4 q0 = *(const f32x4*)(qv + 8 * d8), q1 = *(const f32x4*)(qv + 8 * d8 + 4);
                    s += bf_lo(w.x) * q0[0] + bf_hi(w.x) * q0[1] + bf_lo(w.y) * q0[2] + bf_hi(w.y) * q0[3] + bf_lo(w.z) * q1[0] + bf_hi(w.z) * q1[1] + bf_lo(w.w) * q1[2] + bf_hi(w.w) * q1[3]; }
                s = s * ATT_SCALE + (ct - ctab[j]); sc[j] = s; mx = fmaxf(mx, s); }
            mx = wave_max(mx); float sum = 0.f;
            for (int j = lane; j <= t; j += 64) { const float p = __expf(sc[j] - mx); sc[j] = p; sum += p; }
            sum = wave_sum(sum);
            float o0 = 0.f, o1 = 0.f; const bf16* vb = Vp + (size_t)(b * SEQ) * 1024 + h * HD + 2 * lane;
#pragma unroll 8
            for (int j = 0; j <= t; ++j) { const float p = sc[j]; const unsigned w = *(const unsigned*)(vb + (size_t)j * 1024); o0 += p * bf_lo(w); o1 += p * bf_hi(w); }
            const float rs = 1.0f / sum;
            *(unsigned*)(YA + rowq + 2 * lane) = cvt_pk_bf16(o0 * rs, o1 * rs);
        }
    }
    __syncthreads();
}

__device__ __forceinline__ void sgu_simple(const Args& a, int l, unsigned char* lds, int tid, int lane, int wave) {
    unsigned char* ws = a.ws; const bf16* GU = (const bf16*)(ws + WS_R1) + (size_t)3 * MTOK * 1024; const bf16* GV = GU + (size_t)MTOK * 1024; bf16* YB = (bf16*)(ws + WS_YB);
    float* vn = (float*)lds; float* Wl = (float*)(lds + 65536); float* inv = (float*)(lds + 131072);
    const float* gs = a.in[IN_GSGU] + l * SW; const float* wsp = a.in[IN_WSP] + (size_t)l * NG * SCH * SCH; const float* bsp = a.in[IN_BSP] + (size_t)l * NG * SCH;
    for (int unit = blockIdx.x; unit < (MTOK / SCH) * NG; unit += gridDim.x) {
        const int n = unit >> 3, g = unit & 7, tok0 = n * SCH;
        __syncthreads();
        for (int i = 0; i < 16; ++i) { const int s = wave * 16 + i; const bf16* r = GV + (size_t)(tok0 + s) * SW + lane * 16; float ss = 0.f;
#pragma unroll
            for (int q = 0; q < 2; ++q) { const u32x4 w = *(const u32x4*)(r + 8 * q); const float e[8] = {bf_lo(w.x), bf_hi(w.x), bf_lo(w.y), bf_hi(w.y), bf_lo(w.z), bf_hi(w.z), bf_lo(w.w), bf_hi(w.w)};
#pragma unroll
                for (int j = 0; j < 8; ++j) ss += e[j] * e[j]; }
            ss = wave_sum(ss); if (lane == 0) inv[s] = rsqrtf(ss * (1.0f / SW) + RMS_EPS); }
        __syncthreads();
        for (int i = tid; i < SCH * GD; i += 512) { const int s = i >> 7, c = i & 127;
            vn[i] = bf2f(GV[(size_t)(tok0 + s) * SW + g * GD + c]) * inv[s] * gs[g * GD + c];
            Wl[i] = wsp[(size_t)g * SCH * SCH + i]; }
        __syncthreads();
        { const int c = tid & 127, tq = tid >> 7;
          for (int t = tq; t < SCH; t += 4) { float acc = 0.f; for (int s = 0; s <= t; ++s) acc += Wl[t * SCH + s] * vn[s * GD + c];
              const size_t o = (size_t)(tok0 + t) * SW + g * GD + c;
              YB[o] = f2bf((acc + bsp[g * SCH + t]) * bf2f(GU[o])); } }
    }
    __syncthreads();
}

__device__ __forceinline__ void conv_simple(const Args& a, int l, int tid) {
    unsigned char* ws = a.ws; const bf16* AR = (const bf16*)(ws + WS_R1); bf16* G = (bf16*)(ws + WS_G);
    const float* cw = a.in[IN_CW] + (size_t)l * 3 * DFF; const float* cb = a.in[IN_CB] + (size_t)l * DFF;
    constexpr int NCG = DFF / 8;
    for (size_t i = (size_t)blockIdx.x * 512 + tid; i < (size_t)MTOK * NCG; i += (size_t)gridDim.x * 512) {
        const int row = (int)(i / NCG), cg = (int)(i % NCG), s = row & (SEQ - 1); const size_t o = (size_t)row * DFF + 8 * cg;
        const u32x4 z = {0u, 0u, 0u, 0u};
        const u32x4 a0 = *(const u32x4*)(AR + o), a1 = s >= 1 ? *(const u32x4*)(AR + o - DFF) : z, a2 = s >= 2 ? *(const u32x4*)(AR + o - 2 * DFF) : z, bb = *(const u32x4*)(G + o);
        const float x0[8] = {bf_lo(a0.x), bf_hi(a0.x), bf_lo(a0.y), bf_hi(a0.y), bf_lo(a0.z), bf_hi(a0.z), bf_lo(a0.w), bf_hi(a0.w)};
        const float x1[8] = {bf_lo(a1.x), bf_hi(a1.x), bf_lo(a1.y), bf_hi(a1.y), bf_lo(a1.z), bf_hi(a1.z), bf_lo(a1.w), bf_hi(a1.w)};
        const float x2[8] = {bf_lo(a2.x), bf_hi(a2.x), bf_lo(a2.y), bf_hi(a2.y), bf_lo(a2.z), bf_hi(a2.z), bf_lo(a2.w), bf_hi(a2.w)};
        const float bv[8] = {bf_lo(bb.x), bf_hi(bb.x), bf_lo(bb.y), bf_hi(bb.y), bf_lo(bb.z), bf_hi(bb.z), bf_lo(bb.w), bf_hi(bb.w)};
        float r[8];
#pragma unroll
        for (int j = 0; j < 8; ++j) { const int c = 8 * cg + j; const float v = cb[c] + cw[c] * x2[j] + cw[DFF + c] * x1[j] + cw[2 * DFF + c] * x0[j]; r[j] = gelu_tanh(v) * bv[j]; }
        u32x4 w; w.x = cvt_pk_bf16(r[0], r[1]); w.y = cvt_pk_bf16(r[2], r[3]); w.z = cvt_pk_bf16(r[4], r[5]); w.w = cvt_pk_bf16(r[6], r[7]);
        *(u32x4*)(G + o) = w;
    }
}
__device__ __forceinline__ void ph_final(const Args& a, int gw, int ngw, int lane) {
    const float* x = (const float*)(a.ws + WS_X); const f32x4* gf = (const f32x4*)a.in[IN_GFIN] + lane;
    for (int row = gw; row < MTOK; row += ngw) {
        const f32x4* p = (const f32x4*)(x + (size_t)row * DM) + lane; f32x4 v[8]; float s = 0.f;
#pragma unroll
        for (int j = 0; j < 8; ++j) { v[j] = p[64 * j]; s += (v[j][0] * v[j][0] + v[j][1] * v[j][1]) + (v[j][2] * v[j][2] + v[j][3] * v[j][3]); }
        s = wave_sum(s); const float inv = rsqrtf(s * (1.0f / DM) + RMS_EPS);
        f32x4* o = (f32x4*)(a.out + (size_t)row * DM) + lane;
#pragma unroll
        for (int j = 0; j < 8; ++j) o[64 * j] = (v[j] * inv) * gf[64 * j];
    }
}

constexpr int PH_PER_LAYER = 9, N_PHASES = 2 + DEPTH * PH_PER_LAYER;
#define PHASE_BEGIN() int tid = threadIdx.x; asm volatile("" : "+v"(tid)); const int lane = tid & 63, wave = __builtin_amdgcn_readfirstlane(tid >> 6); \
    Args A = args; { unsigned char* w_ = args.ws; asm volatile("" : "+s"(w_)); A.ws = w_; } unsigned char* ws = A.ws; (void)lane; (void)wave; (void)ws
__global__ void __launch_bounds__(512, 2) fwd_kernel(Args args) {
    extern __shared__ __attribute__((aligned(16))) unsigned char lds[];
    volatile LAS unsigned* MISC = (volatile LAS unsigned*)((LAS unsigned char*)lds + MISC_OFF);
    if (threadIdx.x < 64) MISC[threadIdx.x] = 0u;
    __syncthreads();
    const int lo = args.ph_lo, hi = args.ph_hi;
    unsigned* ctl = (unsigned*)(args.ws + WS_CTL);
    XcdBarrier bar; bar.bar = ctl + CW_BAR; bar.x = 0; bar.st = nullptr;
    if (hi - lo > 1) bar = xcd_barrier_post(ctl + CW_BAR, MISC + 8);
#define IN(k) (lo <= (k) && (k) < hi)
#define SEAM(k) do { if (lo <= (k) && (k) + 1 < hi) xcd_barrier(bar); } while (0)
    const int G = gridDim.x;
    LAS unsigned char* ring = (LAS unsigned char*)lds;

    if (IN(0)) { PHASE_BEGIN(); ph_prologue(A, lds, tid, lane, wave); SEAM(0); }

    for (int l = 0; l < DEPTH; ++l) {
        const int pb = 1 + l * PH_PER_LAYER;
        if (IN(pb + 0)) { PHASE_BEGIN();
            for (int ch = blockIdx.x; ch < MTOK / 256; ch += G) f_unit(A, l, ch, lds, tid, lane, wave);
            const unsigned char* wl = ws + WS_W + (size_t)l * W_LAYER;
            pg8::Gemm g{(const bf16*)(ws + WS_XB), (const bf16*)(wl + W_IN), MTOK, NIN, DM}; pg8::StaticOrder S; S.init(MTOK, NIN, G, (int)blockIdx.x);
            pg8::EpiInProj E{(const float*)(ws + WS_SSQ), (bf16*)(ws + WS_R1)};
            pg8::gemm_phase<pg8::EpiInProj, pg8::StaticOrder, true, true>(ring, g, S, E, tid);
            SEAM(pb + 0);
        }
        if (IN(pb + 1)) { PHASE_BEGIN(); attn_simple(A, lds, tid, lane, wave); sgu_simple(A, l, lds, tid, lane, wave); SEAM(pb + 1); }
        if (IN(pb + 2)) { PHASE_BEGIN();
            const unsigned char* wl = ws + WS_W + (size_t)l * W_LAYER;
            float* T = (float*)(ws + WS_R1); bf16* R1 = (bf16*)(ws + WS_R1);
            { pg8::Gemm g{(const bf16*)(ws + WS_YA), (const bf16*)(wl + W_A), MTOK, DM, FW}; pg8::StaticOrder S; S.init(MTOK, DM, G, (int)blockIdx.x);
              pg8::EpiBranchA E{R1 + (size_t)5 * MTOK * 1024, T};
              pg8::gemm_phase<pg8::EpiBranchA, pg8::StaticOrder, true, true>(ring, g, S, E, tid); }
            { pg8::Gemm g{(const bf16*)(ws + WS_YB), (const bf16*)(wl + W_B), MTOK, DM, SW}; pg8::StaticOrder S; S.init(MTOK, DM, G, (int)blockIdx.x);
              pg8::EpiBranchB E{R1 + (size_t)5 * MTOK * 1024 + (size_t)MTOK * 2048, T, (bf16*)(ws + WS_MG)};
              pg8::gemm_phase<pg8::EpiBranchB, pg8::StaticOrder, true, true>(ring, g, S, E, tid); }
            SEAM(pb + 2);
        }
        if (IN(pb + 3)) { PHASE_BEGIN();
            const unsigned char* wl = ws + WS_W + (size_t)l * W_LAYER; float* XR = (float*)(ws + WS_X);
            pg8::Gemm g{(const bf16*)(ws + WS_MG), (const bf16*)(wl + W_OUT), MTOK, DM, DM}; pg8::StaticOrder S; S.init(MTOK, DM, G, (int)blockIdx.x);
            pg8::EpiResid E{l == 0 ? A.in[IN_X] : (const float*)XR, XR};
            pg8::gemm_phase<pg8::EpiResid, pg8::StaticOrder, true, true>(ring, g, S, E, tid);
            SEAM(pb + 3);
        }
        if (IN(pb + 4)) { PHASE_BEGIN(); ph_rowstats((const float*)(ws + WS_X), (bf16*)(ws + WS_XB), (float*)(ws + WS_SSQ), blockIdx.x * 8 + wave, G * 8, lane); SEAM(pb + 4); }
        if (IN(pb + 5)) { PHASE_BEGIN();
            const unsigned char* wl = ws + WS_W + (size_t)l * W_LAYER;
            pg8::Gemm g{(const bf16*)(ws + WS_XB), (const bf16*)(wl + W_UP), MTOK, NUP, DM}; pg8::StaticOrder S; S.init(MTOK, NUP, G, (int)blockIdx.x);
            pg8::EpiUp1 E{(const float*)(ws + WS_SSQ), (bf16*)(ws + WS_R1), (bf16*)(ws + WS_G)};
            pg8::gemm_phase<pg8::EpiUp1, pg8::StaticOrder, true, true>(ring, g, S, E, tid);
            SEAM(pb + 5);
        }
        if (IN(pb + 6)) { PHASE_BEGIN(); conv_simple(A, l, tid); SEAM(pb + 6); }
        if (IN(pb + 7)) { PHASE_BEGIN();
            const unsigned char* wl = ws + WS_W + (size_t)l * W_LAYER; float* XR = (float*)(ws + WS_X);
            pg8::Gemm g{(const bf16*)(ws + WS_G), (const bf16*)(wl + W_DOWN), MTOK, DM, DFF}; pg8::StaticOrder S; S.init(MTOK, DM, G, (int)blockIdx.x);
            pg8::EpiResid E{(const float*)XR, XR};
            pg8::gemm_phase<pg8::EpiResid, pg8::StaticOrder, true, true>(ring, g, S, E, tid);
            SEAM(pb + 7);
        }
        if (IN(pb + 8)) { PHASE_BEGIN(); ph_rowstats((const float*)(ws + WS_X), (bf16*)(ws + WS_XB), (float*)(ws + WS_SSQ), blockIdx.x * 8 + wave, G * 8, lane); SEAM(pb + 8); }
    }
    if (IN(N_PHASES - 1)) { PHASE_BEGIN(); ph_final(A, blockIdx.x * 8 + wave, G * 8, lane); }
#undef IN
#undef SEAM
}

#ifndef MK_LAUNCH_PER_PHASE
#define MK_LAUNCH_PER_PHASE 0
#endif
extern "C" void kernel_launch(void* const* d_in, const int* in_sizes, int n_in, void* d_out, int out_size, void* d_ws, size_t ws_size, hipStream_t stream) {
    static int grid = 0;
    if (grid == 0) {
        if (n_in != 16 || in_sizes[0] != MTOK * DM || out_size != MTOK * DM || ws_size < WS_END) { fprintf(stderr, "kernel_launch: unexpected shapes (n_in %d, in0 %d, out %d, ws %zu)\n", n_in, n_in > 0 ? in_sizes[0] : -1, out_size, ws_size); grid = -1; return; }
        int dev = 0, cus = 0, per_cu = 0;
        if (hipGetDevice(&dev) != hipSuccess || hipDeviceGetAttribute(&cus, hipDeviceAttributeMultiprocessorCount, dev) != hipSuccess) { grid = -1; return; }
        if (hipFuncSetAttribute((const void*)fwd_kernel, hipFuncAttributeMaxDynamicSharedMemorySize, LDS_BYTES) != hipSuccess) { fprintf(stderr, "kernel_launch: hipFuncSetAttribute failed\n"); grid = -1; return; }
        if (hipOccupancyMaxActiveBlocksPerMultiprocessor(&per_cu, (const void*)fwd_kernel, 512, LDS_BYTES) != hipSuccess || per_cu < 1) { fprintf(stderr, "kernel_launch: occupancy query reports %d\n", per_cu); }
        (void)hipGetLastError();
        grid = cus;
    }
    if (grid < 0) return;
    (void)hipMemsetAsync((char*)d_ws + WS_CTL, 0, CTL_ZERO_BYTES, stream);
    Args a; memset(&a, 0, sizeof(a));
    for (int i = 0; i < 16; ++i) a.in[i] = (const float*)d_in[i];
    a.out = (float*)d_out; a.ws = (unsigned char*)d_ws;
#if MK_LAUNCH_PER_PHASE
    for (int p = 0; p < N_PHASES; ++p) { a.ph_lo = p; a.ph_hi = p + 1; hipLaunchKernelGGL(fwd_kernel, dim3(grid), dim3(512), LDS_BYTES, stream, a); }
#else
    a.ph_lo = 0; a.ph_hi = N_PHASES; hipLaunchKernelGGL(fwd_kernel, dim3(grid), dim3(512), LDS_BYTES, stream, a);
#endif
}
```

```cpp
#include <hip/hip_runtime.h>
#include <cstdio>
#include <cstdint>
#include <cstring>

#define LAS __attribute__((address_space(3)))
#define GAS __attribute__((address_space(1)))
typedef unsigned short bf16;
typedef short bf16x8 __attribute__((ext_vector_type(8)));
typedef float f32x4 __attribute__((ext_vector_type(4)));
typedef float f32x2 __attribute__((ext_vector_type(2)));
typedef unsigned u32x4 __attribute__((ext_vector_type(4)));
typedef unsigned u32x2 __attribute__((ext_vector_type(2)));

constexpr int DM = 2048, NB = 4, SEQ = 4096, DEPTH = 4, MTOK = NB * SEQ;
constexpr int FW = 1024, NH = 8, HD = 128, SW = 1024, NG = 8, GD = 128, SCH = 128, DFF = 5632, INW = 9224, NIN = 9216, NUP = 2 * DFF;
constexpr float RMS_EPS = 1e-6f;
constexpr float ATT_SCALE = 0.08838834764831845f;

__device__ __forceinline__ float bf_lo(unsigned w) { return __uint_as_float(w << 16); }
__device__ __forceinline__ float bf_hi(unsigned w) { return __uint_as_float(w & 0xffff0000u); }
__device__ __forceinline__ float bf2f(bf16 b) { return __uint_as_float(((unsigned)b) << 16); }
__device__ __forceinline__ unsigned cvt_pk_bf16(float lo, float hi) { unsigned r; asm volatile("v_cvt_pk_bf16_f32 %0, %1, %2" : "=v"(r) : "v"(lo), "v"(hi)); return r; }
__device__ __forceinline__ bf16 f2bf(float f) { return (bf16)(cvt_pk_bf16(f, 0.f) & 0xffffu); }
__device__ __forceinline__ float gelu_tanh(float x) {
    const float u = x * (0.7978845608028654f + 0.035677408136300125f * x * x);
    const float e = __builtin_amdgcn_exp2f(-2.8853900817779268f * u);
    return x * __builtin_amdgcn_rcpf(1.0f + e);
}
__device__ __forceinline__ float sigmoid_f(float x) { return __builtin_amdgcn_rcpf(1.0f + __builtin_amdgcn_exp2f(-1.4426950408889634f * x)); }
__device__ __forceinline__ float log_sigmoid_f(float z) { return fminf(z, 0.f) - log1pf(__expf(-fabsf(z))); }
__device__ __forceinline__ float wave_sum(float v) {
#pragma unroll
    for (int o = 1; o < 64; o <<= 1) v += __shfl_xor(v, o);
    return v;
}
__device__ __forceinline__ float wave_max(float v) {
#pragma unroll
    for (int o = 1; o < 64; o <<= 1) v = fmaxf(v, __shfl_xor(v, o));
    return v;
}

namespace pg8 {
#define PG8_LAS __attribute__((address_space(3)))
typedef unsigned short bf16_t;
typedef short bf16x8 __attribute__((ext_vector_type(8)));
typedef float f32x4 __attribute__((ext_vector_type(4)));
typedef unsigned u32x4 __attribute__((ext_vector_type(4)));
constexpr int BM = 256, BK = 64, HALF = 128, HTB = HALF * BK * 2  , STAGE_BYTES = 8 * HTB, NXCD = 8, WGM = 8;

__host__ __device__ __forceinline__ int lds_byte(int r, int c) { const int st = (r >> 4) * 2 + (c >> 5), rr = r & 15, cc = c & 31, ob = rr * 64 + cc * 2; return st * 1024 + (ob ^ (((ob >> 9) & 1) << 5)); }
__host__ __device__ __forceinline__ void stage_rc(int b, int& R, int& C) { const int st = b / 1024, sb = b % 1024, swz = sb ^ (((sb >> 9) & 1) << 5); R = (st >> 1) * 16 + swz / 64; C = (st & 1) * 32 + (swz % 64) / 2; }
__host__ __device__ __forceinline__ int perm32(int rho) { const int n = rho >> 4, i = rho & 15; return 8 * (i >> 2) + 4 * n + (i & 3); }

struct Unit { int pm, pn; };
struct Gemm { const bf16_t* A; const bf16_t* Bt; int M, N, K; };

struct StaticOrder {
    int nM, nN, nwg, G, c;
    __host__ __device__ void init(int M, int N, int G_, int c_) { nM = M / BM; nN = N / BM; nwg = nM * nN; G = G_; c = c_; }
    __host__ __device__ bool next(int i, Unit& u) const {
        const long L = (long)i * G + c; if (L >= nwg) return false;
        int wgid = (int)L; { const int q = nwg / NXCD, r = nwg % NXCD, xcd = wgid % NXCD, off = wgid / NXCD; wgid = (xcd < r ? xcd * (q + 1) : r * (q + 1) + (xcd - r) * q) + off; }
        const int nig = WGM * nN, gid = wgid / nig, fm = gid * WGM, gsz = (nM - fm) < WGM ? (nM - fm) : WGM;
        u.pm = fm + ((wgid % nig) % gsz); u.pn = (wgid % nig) / gsz; return true;
    }
    __device__ __forceinline__ void a_ready(const Unit&) const {}
    __device__ __forceinline__ void done(const Unit&) const {}
};

__device__ __forceinline__ void row_inv8(const float* ssq, int row0, int fq, float (&inv)[2][4]) {
#pragma unroll
    for (int ai = 0; ai < 2; ++ai)
#pragma unroll
        for (int m = 0; m < 4; ++m) {
            const f32x4* p = (const f32x4*)(ssq + (size_t)(row0 + ai * HALF + m * 16) * 32) + 2 * fq;
            const f32x4 a = p[0], b = p[1];
            float s = ((a[0] + a[1]) + (a[2] + a[3])) + ((b[0] + b[1]) + (b[2] + b[3]));
            s += __shfl_xor(s, 16); s += __shfl_xor(s, 32);
            inv[ai][m] = rsqrtf(s * (1.0f / DM) + RMS_EPS);
        }
}
struct EpiInProj {
    static constexpr bool PERM = false, APERM = false, AFTER_DRAIN = false;
    const float* ssq; bf16* R1;
    __device__ __forceinline__ void operator()(const f32x4 (&acc)[2][2][4][2], const Unit& u, int wr, int wc, int fr, int fq) const {
        const int row0 = u.pm * BM + wr * 64 + fr;
        float inv[2][4]; row_inv8(ssq, row0, fq, inv);
        int mode, ld, colb; bf16* base;
        if (u.pn < 20) { const int t = u.pn >> 2; base = R1 + (size_t)t * MTOK * 1024; ld = 1024; colb = (u.pn & 3) * 256; mode = t < 3 ? 0 : 1; }
        else { const int t = (u.pn - 20) >> 3; base = R1 + (size_t)5 * MTOK * 1024 + (size_t)t * MTOK * 2048; ld = 2048; colb = ((u.pn - 20) & 7) * 256; mode = 2; }
#pragma unroll
        for (int ai = 0; ai < 2; ++ai)
#pragma unroll
            for (int m = 0; m < 4; ++m) { bf16* rowp = base + (size_t)(row0 + ai * HALF + m * 16) * ld + colb + wc * 32 + 4 * fq;
#pragma unroll
                for (int bj = 0; bj < 2; ++bj)
#pragma unroll
                    for (int n = 0; n < 2; ++n) { f32x4 v = acc[ai][bj][m][n] * inv[ai][m];
                        if (mode == 1) { v[0] = gelu_tanh(v[0]); v[1] = gelu_tanh(v[1]); v[2] = gelu_tanh(v[2]); v[3] = gelu_tanh(v[3]); }
                        else if (mode == 2) { v[0] = sigmoid_f(v[0]); v[1] = sigmoid_f(v[1]); v[2] = sigmoid_f(v[2]); v[3] = sigmoid_f(v[3]); }
                        u32x2 w; w.x = cvt_pk_bf16(v[0], v[1]); w.y = cvt_pk_bf16(v[2], v[3]);
                        *(u32x2*)(rowp + bj * HALF + n * 16) = w; } }
    }
};
struct EpiBranchA {
    static constexpr bool PERM = false, APERM = false, AFTER_DRAIN = false;
    const bf16* SA; float* T;
    __device__ __forceinline__ void operator()(const f32x4 (&acc)[2][2][4][2], const Unit& u, int wr, int wc, int fr, int fq) const {
        const int row0 = u.pm * BM + wr * 64 + fr, col0 = u.pn * BM + wc * 32 + 4 * fq;
#pragma unroll
        for (int ai = 0; ai < 2; ++ai)
#pragma unroll
            for (int m = 0; m < 4; ++m) { const size_t off = (size_t)(row0 + ai * HALF + m * 16) * DM + col0;
#pragma unroll
                for (int bj = 0; bj < 2; ++bj)
#pragma unroll
                    for (int n = 0; n < 2; ++n) { const u32x2 g = *(const u32x2*)(SA + off + bj * HALF + n * 16);
                        const f32x4 gv = {bf_lo(g.x), bf_hi(g.x), bf_lo(g.y), bf_hi(g.y)};
                        *(f32x4*)(T + off + bj * HALF + n * 16) = acc[ai][bj][m][n] * gv; } }
    }
};
struct EpiBranchB {
    static constexpr bool PERM = false, APERM = false, AFTER_DRAIN = false;
    const bf16* SB; const float* T; bf16* MG;
    __device__ __forceinline__ void operator()(const f32x4 (&acc)[2][2][4][2], const Unit& u, int wr, int wc, int fr, int fq) const {
        const int row0 = u.pm * BM + wr * 64 + fr, col0 = u.pn * BM + wc * 32 + 4 * fq;
#pragma unroll
        for (int ai = 0; ai < 2; ++ai)
#pragma unroll
            for (int m = 0; m < 4; ++m) { const size_t off = (size_t)(row0 + ai * HALF + m * 16) * DM + col0;
#pragma unroll
                for (int bj = 0; bj < 2; ++bj)
#pragma unroll
                    for (int n = 0; n < 2; ++n) { const u32x2 g = *(const u32x2*)(SB + off + bj * HALF + n * 16);
                        const f32x4 gv = {bf_lo(g.x), bf_hi(g.x), bf_lo(g.y), bf_hi(g.y)};
                        const f32x4 t = *(const f32x4*)(T + off + bj * HALF + n * 16);
                        const f32x4 v = t + acc[ai][bj][m][n] * gv;
                        u32x2 w; w.x = cvt_pk_bf16(v[0], v[1]); w.y = cvt_pk_bf16(v[2], v[3]);
                        *(u32x2*)(MG + off + bj * HALF + n * 16) = w; } }
    }
};
struct EpiResid {
    static constexpr bool PERM = false, APERM = false, AFTER_DRAIN = false;
    const float* xin; float* xout;
    __device__ __forceinline__ void operator()(const f32x4 (&acc)[2][2][4][2], const Unit& u, int wr, int wc, int fr, int fq) const {
        const int row0 = u.pm * BM + wr * 64 + fr, col0 = u.pn * BM + wc * 32 + 4 * fq;
#pragma unroll
        for (int ai = 0; ai < 2; ++ai)
#pragma unroll
            for (int m = 0; m < 4; ++m) { const size_t off = (size_t)(row0 + ai * HALF + m * 16) * DM + col0;
#pragma unroll
                for (int bj = 0; bj < 2; ++bj)
#pragma unroll
                    for (int n = 0; n < 2; ++n) { const f32x4 b = *(const f32x4*)(xin + off + bj * HALF + n * 16);
                        *(f32x4*)(xout + off + bj * HALF + n * 16) = b + acc[ai][bj][m][n]; } }
    }
};
struct EpiUp1 {
    static constexpr bool PERM = false, APERM = false, AFTER_DRAIN = false;
    const float* ssq; bf16* AR; bf16* BR;
    __device__ __forceinline__ void operator()(const f32x4 (&acc)[2][2][4][2], const Unit& u, int wr, int wc, int fr, int fq) const {
        const int row0 = u.pm * BM + wr * 64 + fr, ch0 = u.pn * HALF + wc * 32 + 4 * fq;
        float inv[2][4]; row_inv8(ssq, row0, fq, inv);
#pragma unroll
        for (int ai = 0; ai < 2; ++ai)
#pragma unroll
            for (int m = 0; m < 4; ++m) { const size_t off = (size_t)(row0 + ai * HALF + m * 16) * DFF + ch0;
#pragma unroll
                for (int bj = 0; bj < 2; ++bj)
#pragma unroll
                    for (int n = 0; n < 2; ++n) { const f32x4 v = acc[ai][bj][m][n] * inv[ai][m];
                        u32x2 w; w.x = cvt_pk_bf16(v[0], v[1]); w.y = cvt_pk_bf16(v[2], v[3]);
                        *(u32x2*)((bj ? BR : AR) + off + n * 16) = w; } }
    }
};

template <class Epi, class Sched, bool ALIGN_EPI = false, bool SP2 = false>
__device__ __forceinline__ void gemm_phase(PG8_LAS unsigned char* lds, const Gemm g, const Sched& S, const Epi& E, int tid_in) {
    const int tid = tid_in, wid = __builtin_amdgcn_readfirstlane(tid >> 6), lane = tid & 63, wr = wid >> 2, wc = wid & 3, fr = lane & 15, fq = lane >> 4;
    const int K = g.K, nt = K / BK;
    unsigned voffA[2], voffB[2];
#pragma unroll
    for (int i = 0; i < 2; ++i) { int R, C; stage_rc(tid * 16 + i * 8192, R, C); const int Rb = Epi::PERM ? ((R & ~31) + perm32(R & 31)) : R;
        const int Ra = Epi::APERM ? (128 * ((R >> 6) & 1) + 8 * (R & 15) + ((R >> 4) & 3)) : R; voffA[i] = (unsigned)(Ra * K + C) * 2u; voffB[i] = (unsigned)(Rb * K + C) * 2u; }
    const size_t kstep = (size_t)(BK * 2);
    const size_t hstep = (size_t)HALF * K * 2;
    const size_t tstep = 2 * hstep; const size_t hstepA = Epi::APERM ? (size_t)4 * K * 2 : hstep;
    const unsigned ldsw = (unsigned)wid * 1024u;
    const int aoff = lds_byte(wr * 64 + fr, fq * 8), boff = lds_byte(wc * 32 + fr, fq * 8);
#define PG8_SA(b, h) (((b) * 2 + (h)) * HTB)
#define PG8_SB(b, h) ((4 + (b) * 2 + (h)) * HTB)
#define PG8_STAGE(bufoff, gbase, voff) do { _Pragma("unroll") for (int _i = 0; _i < 2; ++_i) \
        __builtin_amdgcn_global_load_lds((const unsigned*)((const char*)(gbase) + (voff)[_i]), (PG8_LAS unsigned*)(lds + (bufoff) + ldsw + _i * 8192), 16, 0, 0); } while (0)
#define PG8_LDA(dst, b, h) do { _Pragma("unroll") for (int m = 0; m < 4; ++m) _Pragma("unroll") for (int k = 0; k < 2; ++k) dst[m][k] = *(const PG8_LAS bf16x8*)(lds + PG8_SA(b, h) + aoff + m * 2048 + k * 1024); } while (0)
#define PG8_LDB(dst, b, h) do { _Pragma("unroll") for (int n = 0; n < 2; ++n) _Pragma("unroll") for (int k = 0; k < 2; ++k) dst[n][k] = *(const PG8_LAS bf16x8*)(lds + PG8_SB(b, h) + boff + n * 2048 + k * 1024); } while (0)
#define PG8_MMA(ai, bj, At, Bt) do { __builtin_amdgcn_s_setprio(1); _Pragma("unroll") for (int m = 0; m < 4; ++m) _Pragma("unroll") for (int n = 0; n < 2; ++n) _Pragma("unroll") for (int k = 0; k < 2; ++k) \
        acc[ai][bj][m][n] = __builtin_amdgcn_mfma_f32_16x16x32_bf16(Bt[n][k], At[m][k], acc[ai][bj][m][n], 0, 0, 0); __builtin_amdgcn_s_setprio(0); } while (0)
#define PG8_WAIT_V(n) asm volatile("s_waitcnt vmcnt(" #n ")" ::: "memory")
#define PG8_WAIT_L(n) asm volatile("s_waitcnt lgkmcnt(" #n ")" ::: "memory")
#define PG8_BAR __builtin_amdgcn_s_barrier()
#define PG8_SCHED __builtin_amdgcn_sched_barrier(0)
    Unit cur, nxt; int ui = 0;
    if (!S.next(0, cur)) return;
    f32x4 acc[2][2][4][2];
#pragma unroll
    for (int a = 0; a < 2; ++a)
#pragma unroll
        for (int b = 0; b < 2; ++b)
#pragma unroll
            for (int m = 0; m < 4; ++m)
#pragma unroll
                for (int n = 0; n < 2; ++n) acc[a][b][m][n] = (f32x4){0.f, 0.f, 0.f, 0.f};
    bf16x8 At[4][2], B0[2][2], B1[2][2];
    const char* cA = (const char*)g.A + (size_t)cur.pm * tstep; const char* cB = (const char*)g.Bt + (size_t)cur.pn * tstep;
    S.a_ready(cur);
    if constexpr (SP2) {
        PG8_STAGE(PG8_SB(0, 0), cB, voffB); PG8_STAGE(PG8_SB(0, 1), cB + hstep, voffB); PG8_STAGE(PG8_SA(0, 0), cA, voffA); PG8_STAGE(PG8_SA(0, 1), cA + hstepA, voffA);
        if (wr == 1) PG8_BAR;
        PG8_WAIT_V(2); PG8_BAR;
        PG8_STAGE(PG8_SB(1, 0), cB + kstep, voffB); PG8_STAGE(PG8_SA(1, 0), cA + kstep, voffA); PG8_STAGE(PG8_SB(1, 1), cB + hstep + kstep, voffB);
        PG8_WAIT_V(6); PG8_BAR;
    } else {
        PG8_STAGE(PG8_SB(0, 0), cB, voffB); PG8_STAGE(PG8_SA(0, 0), cA, voffA); PG8_STAGE(PG8_SB(0, 1), cB + hstep, voffB); PG8_STAGE(PG8_SA(0, 1), cA + hstepA, voffA);
        if (wr == 1) PG8_BAR;
        PG8_WAIT_V(4); PG8_BAR;
        PG8_STAGE(PG8_SB(1, 0), cB + kstep, voffB); PG8_STAGE(PG8_SA(1, 0), cA + kstep, voffA); PG8_STAGE(PG8_SB(1, 1), cB + hstep + kstep, voffB);
        PG8_WAIT_V(6); PG8_BAR;
    }
    for (;;) {
        const bool has_next = S.next(ui + 1, nxt);
        const char* nA = has_next ? (const char*)g.A + (size_t)nxt.pm * tstep : cA; const char* nB = has_next ? (const char*)g.Bt + (size_t)nxt.pn * tstep : cB;
        for (int t = 0; t < nt; t += 2) {
            const bool last = (t == nt - 2);
            const char* a1 = cA + (size_t)(t + 1) * kstep;
            const char* a2 = last ? nA : cA + (size_t)(t + 2) * kstep; const char* b2 = last ? nB : cB + (size_t)(t + 2) * kstep;
            const char* a3 = a2 + kstep; const char* b3 = b2 + kstep;
            if (last && has_next) S.a_ready(nxt);
            if constexpr (SP2) {
            PG8_LDB(B0, 0, 0); PG8_LDB(B1, 0, 1); PG8_SCHED; PG8_LDA(At, 0, 0); PG8_STAGE(PG8_SA(1, 1), a1 + hstepA, voffA);
            PG8_WAIT_V(8); PG8_WAIT_L(0); PG8_BAR; PG8_MMA(0, 0, At, B0); PG8_MMA(0, 1, At, B1); PG8_BAR; PG8_SCHED;
            PG8_LDA(At, 0, 1); PG8_STAGE(PG8_SB(0, 0), b2, voffB); PG8_STAGE(PG8_SB(0, 1), b2 + hstep, voffB); PG8_STAGE(PG8_SA(0, 0), a2, voffA);
            PG8_WAIT_V(8); PG8_WAIT_L(0); PG8_BAR; PG8_MMA(1, 0, At, B0); PG8_MMA(1, 1, At, B1); PG8_BAR; PG8_SCHED;
            PG8_LDB(B0, 1, 0); PG8_LDB(B1, 1, 1); PG8_SCHED; PG8_LDA(At, 1, 0); PG8_STAGE(PG8_SA(0, 1), a2 + hstepA, voffA);
            PG8_WAIT_V(8); PG8_WAIT_L(0); PG8_BAR; PG8_MMA(0, 0, At, B0); PG8_MMA(0, 1, At, B1); PG8_BAR; PG8_SCHED;
            PG8_LDA(At, 1, 1); PG8_STAGE(PG8_SB(1, 0), b3, voffB); PG8_STAGE(PG8_SB(1, 1), b3 + hstep, voffB); PG8_STAGE(PG8_SA(1, 0), a3, voffA);
            PG8_WAIT_V(8); PG8_WAIT_L(0); PG8_BAR; PG8_MMA(1, 0, At, B0); PG8_MMA(1, 1, At, B1); PG8_BAR; PG8_SCHED;
            } else {
            PG8_LDB(B0, 0, 0); PG8_SCHED; PG8_LDA(At, 0, 0); PG8_STAGE(PG8_SA(1, 1), a1 + hstepA, voffA);
            PG8_WAIT_L(8); PG8_BAR; PG8_WAIT_L(0); PG8_MMA(0, 0, At, B0); PG8_BAR; PG8_SCHED;
            PG8_LDB(B1, 0, 1); PG8_STAGE(PG8_SB(0, 0), b2, voffB);
            PG8_BAR; PG8_WAIT_L(0); PG8_MMA(0, 1, At, B1); PG8_BAR;
            PG8_LDA(At, 0, 1); PG8_STAGE(PG8_SA(0, 0), a2, voffA);
            PG8_BAR; PG8_WAIT_L(0); PG8_MMA(1, 0, At, B0); PG8_BAR; PG8_SCHED;
            PG8_STAGE(PG8_SB(0, 1), b2 + hstep, voffB);
            PG8_WAIT_V(6); PG8_BAR; PG8_MMA(1, 1, At, B1); PG8_BAR;
            PG8_LDB(B0, 1, 0); PG8_SCHED; PG8_LDA(At, 1, 0); PG8_STAGE(PG8_SA(0, 1), a2 + hstepA, voffA);
            PG8_WAIT_L(8); PG8_BAR; PG8_WAIT_L(0); PG8_MMA(0, 0, At, B0); PG8_BAR; PG8_SCHED;
            PG8_LDB(B1, 1, 1); PG8_STAGE(PG8_SB(1, 0), b3, voffB);
            PG8_BAR; PG8_WAIT_L(0); PG8_MMA(0, 1, At, B1); PG8_BAR;
            PG8_LDA(At, 1, 1); PG8_STAGE(PG8_SA(1, 0), a3, voffA);
            PG8_BAR; PG8_WAIT_L(0); PG8_MMA(1, 0, At, B0); PG8_BAR; PG8_SCHED;
            PG8_STAGE(PG8_SB(1, 1), b3 + hstep, voffB);
            PG8_WAIT_V(6); PG8_BAR; PG8_MMA(1, 1, At, B1); PG8_BAR;
            }
        }
        if constexpr (ALIGN_EPI) { if (wr == 0) PG8_BAR; }
        if constexpr (!Epi::AFTER_DRAIN) { E(acc, cur, wr, wc, fr, fq); S.done(cur); }
        if (!has_next) break;
#pragma unroll
        for (int a = 0; a < 2; ++a)
#pragma unroll
            for (int b = 0; b < 2; ++b)
#pragma unroll
                for (int m = 0; m < 4; ++m)
#pragma unroll
                    for (int n = 0; n < 2; ++n) acc[a][b][m][n] = (f32x4){0.f, 0.f, 0.f, 0.f};
        cur = nxt; cA = nA; cB = nB; ++ui;
        if constexpr (ALIGN_EPI) { if (wr == 1) PG8_BAR; }
    }
    PG8_WAIT_V(0);
    if constexpr (!ALIGN_EPI) { if (wr == 0) PG8_BAR; }
    PG8_BAR;
    if constexpr (Epi::AFTER_DRAIN) { E.fused(acc, cur, wr, wc, fr, fq, lds, wid, lane); S.done(cur); }
#undef PG8_SA
#undef PG8_SB
#undef PG8_STAGE
#undef PG8_LDA
#undef PG8_LDB
#undef PG8_MMA
#undef PG8_WAIT_V
#undef PG8_WAIT_L
#undef PG8_BAR
#undef PG8_SCHED
}
}

namespace fa {
constexpr int D = 128, LDQ = 1024, NW = 8, QBLK = 32, KVBLK = 64, QB = NW * QBLK;
constexpr int SHM_V = KVBLK * D * 2, SHM_K = KVBLK * D * 2;
constexpr int LDS_ATT = 2 * SHM_V + 2 * SHM_K + NW * 64 * 4;
constexpr int TAB_OFF = 69632;
constexpr float SCALE = 0.08838834764831845f, THR = 8.f;
constexpr bool WSKIP = false;
typedef short bf16x8 __attribute__((ext_vector_type(8)));
typedef short s16x4 __attribute__((ext_vector_type(4)));
typedef float f32x16 __attribute__((ext_vector_type(16)));
typedef float f32x4 __attribute__((ext_vector_type(4)));
typedef unsigned u32x4 __attribute__((ext_vector_type(4)));
template <class A, class Bt> struct same_t { static constexpr bool v = false; };
template <class A> struct same_t<A, A> { static constexpr bool v = true; };

#define KSWZ(row, colB) ((row) * 256 + ((colB) ^ (((row) & 7) << 4)))
#define SBAR() __builtin_amdgcn_sched_barrier(0)
__device__ __forceinline__ int v_st(int k, int c) { const int kk = (k & ~0xC) | ((k & 4) << 1) | ((k & 8) >> 1); return ((kk >> 3) * 4 + (c >> 5)) * 512 + ((kk & 7) * 32 + (c & 31)) * 2; }
__device__ __forceinline__ int v_rd_base(int lane) { return ((lane & 3) << 3) | (((lane >> 2) & 3) << 6) | (((lane >> 4) & 1) << 5) | (((lane >> 5) & 1) << 8); }
constexpr int v_rd_off(int d0, int ks, int half) { return d0 * 512 + ks * 4096 + half * 2048; }
__device__ __forceinline__ int crow(int r, int hi) { return (r & 3) + 8 * (r >> 2) + 4 * hi; }
__device__ __forceinline__ unsigned cvtpk(float lo, float hi) {
    unsigned r; asm volatile("v_cvt_pk_bf16_f32 %0, %1, %2" : "=v"(r) : "v"(lo), "v"(hi)); return r;
}
__device__ __forceinline__ bf16x8 pack8(f32x4 a, f32x4 b) {
    u32x4 w = {cvtpk(a[0], a[1]), cvtpk(a[2], a[3]), cvtpk(b[0], b[1]), cvtpk(b[2], b[3])};
    return *reinterpret_cast<bf16x8*>(&w);
}
template <class T> __device__ __forceinline__ bf16x8 load8(const T* p) {
    if constexpr (same_t<T, float>::v) { return pack8(*(const f32x4*)p, *(const f32x4*)(p + 4)); }
    else { return *reinterpret_cast<const bf16x8*>(p); }
}
__device__ __forceinline__ void mask_tile(f32x16& p0, f32x16& p1, int dq, unsigned W) {
    const float NEG = -__builtin_inff();
#pragma unroll
    for (int r = 0; r < 16; ++r) {
        const int c = (r & 3) + 8 * (r >> 2);
        if ((unsigned)(dq - c) >= W) p0[r] = NEG;
        if ((unsigned)(dq - c - 32) >= W) p1[r] = NEG;
    }
}
__device__ __forceinline__ void partialSM(f32x16& p0, f32x16& p1, float& m_reg, float& mn, float& alpha) {
    float pmax = p0[0]; for (int r = 1; r < 16; ++r) pmax = fmaxf(pmax, p0[r]); for (int r = 0; r < 16; ++r) pmax = fmaxf(pmax, p1[r]);
    { auto rr = __builtin_amdgcn_permlane32_swap(__float_as_uint(pmax), __float_as_uint(pmax), false, false);
      pmax = fmaxf(__uint_as_float(rr[0]), __uint_as_float(rr[1])); }
    constexpr float C2 = 1.4426950408889634f * SCALE;
    if (__builtin_expect(__all((pmax - m_reg) * SCALE <= THR), 1)) { mn = m_reg; alpha = 1.f; }
    else { mn = fmaxf(m_reg, pmax); alpha = __builtin_amdgcn_exp2f((m_reg - mn) * C2); m_reg = mn; }
    const float mnL = -mn * C2;
    for (int r = 0; r < 16; ++r) p0[r] = fmaf(p0[r], C2, mnL); for (int r = 0; r < 16; ++r) p1[r] = fmaf(p1[r], C2, mnL);
    for (int r = 0; r < 16; ++r) p0[r] = __builtin_amdgcn_exp2f(p0[r]);
}
__device__ __forceinline__ void finishSM(f32x16& p0, f32x16& p1, float alpha, float& l_reg, bf16x8& pa0, bf16x8& pa1, bf16x8& pa2, bf16x8& pa3) {
    for (int r = 0; r < 16; ++r) p1[r] = __builtin_amdgcn_exp2f(p1[r]);
    float ps = 0; for (int r = 0; r < 16; ++r) ps += p0[r]; for (int r = 0; r < 16; ++r) ps += p1[r];
    { auto rr = __builtin_amdgcn_permlane32_swap(__float_as_uint(ps), __float_as_uint(ps), false, false);
      ps = __uint_as_float(rr[0]) + __uint_as_float(rr[1]); }
    l_reg = l_reg * alpha + ps;
#define PK4(P, B_, OUT) do { unsigned a0 = cvtpk(P[B_+0], P[B_+1]), a1 = cvtpk(P[B_+2], P[B_+3]);                          \
        unsigned b0 = cvtpk(P[B_+4], P[B_+5]), b1 = cvtpk(P[B_+6], P[B_+7]);                                             \
        auto r0 = __builtin_amdgcn_permlane32_swap(a0, b0, false, false); auto r1 = __builtin_amdgcn_permlane32_swap(a1, b1, false, false); \
        u32x4 w = {r0[0], r1[0], r0[1], r1[1]}; OUT = *reinterpret_cast<bf16x8*>(&w); } while (0)
    PK4(p0, 0, pa0); PK4(p0, 8, pa1); PK4(p1, 0, pa2); PK4(p1, 8, pa3);
#undef PK4
}
template <int KB, bool SK>
__device__ __forceinline__ void qkt(f32x16& p0, f32x16& p1, const char* K_lds, int r32, int hi, const bf16x8* qr, bool act, const __attribute__((address_space(3))) float* tb) {
    if (SK && !act) { const float NEG = -__builtin_inff();
#pragma unroll
        for (int r = 0; r < 16; ++r) { p0[r] = NEG; p1[r] = NEG; } return; }
#pragma unroll
    for (int j_ = 0; j_ < 4; ++j_) { const f32x4 b0_ = *(const __attribute__((address_space(3))) f32x4*)(tb + 8 * j_), b1_ = *(const __attribute__((address_space(3))) f32x4*)(tb + 32 + 8 * j_);
        p0[4 * j_] = b0_[0]; p0[4 * j_ + 1] = b0_[1]; p0[4 * j_ + 2] = b0_[2]; p0[4 * j_ + 3] = b0_[3]; p1[4 * j_] = b1_[0]; p1[4 * j_ + 1] = b1_[1]; p1[4 * j_ + 2] = b1_[2]; p1[4 * j_ + 3] = b1_[3]; }
    const char* kb[4];
#pragma unroll
    for (int dd = 0; dd < 4; ++dd) kb[dd] = K_lds + KB * SHM_K + KSWZ(r32, (dd * 16 + hi * 8) * 2);
#pragma unroll
    for (int d0 = 0; d0 < 8; ++d0) { const char* a = kb[d0 & 3] + (d0 >> 2) * 128;
        bf16x8 b0 = *reinterpret_cast<const bf16x8*>(a);
        bf16x8 b1 = *reinterpret_cast<const bf16x8*>(a + 32 * 256);
        p0 = __builtin_amdgcn_mfma_f32_32x32x16_bf16(b0, qr[d0], p0, 0, 0, 0);
        p1 = __builtin_amdgcn_mfma_f32_32x32x16_bf16(b1, qr[d0], p1, 0, 0, 0); }
}
template <int VB, bool SK>
__device__ __forceinline__ void pv_tile(f32x16* o, int vb0, bf16x8 pa0, bf16x8 pa1, bf16x8 pa2, bf16x8 pa3, bool act) {
    if (SK && !act) return;
#define TRRD(dst, off) asm volatile("ds_read_b64_tr_b16 %0, %1 offset:%2" : "=&v"(dst) : "v"(vb0), "i"(off) : "memory")
#define PV_D0(d0) do { s16x4 l0, l1, l2, l3, h0, h1, h2, h3; constexpr int b_ = VB * SHM_V + v_rd_off(d0, 0, 0);     \
        TRRD(l0, b_); TRRD(h0, b_ + 2048); TRRD(l1, b_ + 4096); TRRD(h1, b_ + 6144); TRRD(l2, b_ + 8192); TRRD(h2, b_ + 10240); TRRD(l3, b_ + 12288); TRRD(h3, b_ + 14336); \
        asm volatile("s_waitcnt lgkmcnt(0)" ::: "memory"); SBAR();                 \
        o[d0] = __builtin_amdgcn_mfma_f32_32x32x16_bf16(pa0, (bf16x8){l0[0], l0[1], l0[2], l0[3], h0[0], h0[1], h0[2], h0[3]}, o[d0], 0, 0, 0);   \
        o[d0] = __builtin_amdgcn_mfma_f32_32x32x16_bf16(pa1, (bf16x8){l1[0], l1[1], l1[2], l1[3], h1[0], h1[1], h1[2], h1[3]}, o[d0], 0, 0, 0);   \
        o[d0] = __builtin_amdgcn_mfma_f32_32x32x16_bf16(pa2, (bf16x8){l2[0], l2[1], l2[2], l2[3], h2[0], h2[1], h2[2], h2[3]}, o[d0], 0, 0, 0);   \
        o[d0] = __builtin_amdgcn_mfma_f32_32x32x16_bf16(pa3, (bf16x8){l3[0], l3[1], l3[2], l3[3], h3[0], h3[1], h3[2], h3[3]}, o[d0], 0, 0, 0); } while (0)
    PV_D0(0); PV_D0(1); PV_D0(2); PV_D0(3);
#undef PV_D0
#undef TRRD
}
template <class TIn, class TOut> struct BlockRef { const TIn* Q; const TIn* K; const TIn* V; TOut* O; int P0; };
template <class TIn> struct Seam {
    bf16x8 qr[8];
    bf16x8 st_v0, st_v1, st_k0, st_k1; f32x4 sf0, sf1, sf2, sf3;
    f32x4 tq[16];
};
__device__ __forceinline__ int swa_jlo(int P0, int W) { const int lowk = P0 - W + 1; return lowk > 0 ? lowk / KVBLK : 0; }
#define ROW(p, k0, rr) ((p) + (unsigned)(((k0) + (rr)) * LDQ + sc))
#define VMW() asm volatile("s_waitcnt vmcnt(0)" ::: "memory")
#define VMWN(n) asm volatile("s_waitcnt vmcnt(%0)" :: "i"(n) : "memory")
#define SLOAD_H(Kp, Vp, k0) do { S.st_v0 = load8<TIn>(ROW(Vp, k0, sr)); S.st_v1 = load8<TIn>(ROW(Vp, k0, 32 + sr));              \
                         S.st_k0 = load8<TIn>(ROW(Kp, k0, sr)); S.st_k1 = load8<TIn>(ROW(Kp, k0, 32 + sr)); } while (0)
#define SWRITE_HK(bf) do { *(bf16x8*)(K_lds + (bf) * SHM_K + kws) = S.st_k0; *(bf16x8*)(K_lds + (bf) * SHM_K + kws + 32 * 256) = S.st_k1; } while (0)
#define SWRITE_HV(bf) do { *(bf16x8*)(V_lds + (bf) * SHM_V + vst0) = S.st_v0; *(bf16x8*)(V_lds + (bf) * SHM_V + vst1) = S.st_v1; } while (0)
#define SWRITE_H(bf) do { SWRITE_HV(bf); SWRITE_HK(bf); } while (0)
#define SLOAD_F(p, k0) do { S.sf0 = *(const f32x4*)ROW(p, k0, sr); S.sf1 = *(const f32x4*)(ROW(p, k0, sr) + 4);                \
                            S.sf2 = *(const f32x4*)ROW(p, k0, 32 + sr); S.sf3 = *(const f32x4*)(ROW(p, k0, 32 + sr) + 4); } while (0)
#define SWRITE_KF(bf) do { *(bf16x8*)(K_lds + (bf) * SHM_K + kws) = pack8(S.sf0, S.sf1); *(bf16x8*)(K_lds + (bf) * SHM_K + kws + 32 * 256) = pack8(S.sf2, S.sf3); } while (0)
#define SWRITE_VF(bf) do { *(bf16x8*)(V_lds + (bf) * SHM_V + vst0) = pack8(S.sf0, S.sf1); *(bf16x8*)(V_lds + (bf) * SHM_V + vst1) = pack8(S.sf2, S.sf3); } while (0)
template <class TIn, class TOut>
__device__ __forceinline__ void causal_swa_prime(const BlockRef<TIn, TOut>& cur, int W, char* lds, Seam<TIn>& S, int tid_in) {
    constexpr bool F32 = same_t<TIn, float>::v;
    const int tid = tid_in, wid = __builtin_amdgcn_readfirstlane(tid >> 6), lane = tid & 63, r32 = lane & 31, hi = lane >> 5;
    const int sr = tid >> 4, sc = (tid & 15) * 8, kws = KSWZ(sr, sc * 2); char* K_lds = lds + 2 * SHM_V;
    const int kb0 = swa_jlo(cur.P0, W) * KVBLK;
    for (int d0 = 0; d0 < 8; ++d0) S.qr[d0] = load8<TIn>(cur.Q + (unsigned)((wid * QBLK + r32) * LDQ + d0 * 16 + hi * 8));
    if constexpr (F32) { SLOAD_F((const float*)cur.K, kb0); VMW(); SWRITE_KF(0); SBAR(); SLOAD_F((const float*)cur.V, kb0); }
    else { SLOAD_H(cur.K, cur.V, kb0); VMW(); SWRITE_HK(0); }
    __syncthreads();
}
template <class TIn, class TOut>
__device__ __forceinline__ void causal_swa_block(const BlockRef<TIn, TOut>& cur, const BlockRef<TIn, TOut>& nxt, int skv, int W, char* lds, Seam<TIn>& S, int tid_in) {
    constexpr bool F32 = same_t<TIn, float>::v;
    const int tid = tid_in, wid = __builtin_amdgcn_readfirstlane(tid >> 6), lane = tid & 63, r32 = lane & 31, hi = lane >> 5;
    const int j_lo = swa_jlo(cur.P0, W);
    int j_hi = (cur.P0 + QB - 1) / KVBLK + 1; if (j_hi > skv / KVBLK) j_hi = skv / KVBLK;
    const int NT = j_hi - j_lo;
    const int kbn = swa_jlo(nxt.P0, W) * KVBLK;
    const int qlo = cur.P0 + wid * QBLK, qm = qlo + r32 - 4 * hi;
    char* V_lds = lds; char* K_lds = lds + 2 * SHM_V;
    float* ws = (float*)(lds + 2 * SHM_V + 2 * SHM_K) + wid * 64; float* li_l = ws, * al_l = ws + 32;
    float m_reg = -1e30f, l_reg = 0; f32x16 o[4] = {};
    const int sr = tid >> 4, sc = (tid & 15) * 8, vst0 = v_st(sr, sc), vst1 = v_st(32 + sr, sc), kws = KSWZ(sr, sc * 2);
    const int vb0 = (int)(uintptr_t)V_lds + v_rd_base(lane);
    const TIn* Kh = cur.K; const TIn* Vh = cur.V;
#define RESC(a) do { if (__any((a) < 1.f)) { if (hi == 0) al_l[r32] = (a); asm volatile("s_waitcnt lgkmcnt(0)" ::: "memory");              \
                     for (int d_ = 0; d_ < 4; ++d_) for (int r = 0; r < 16; ++r) o[d_][r] *= al_l[crow(r, hi)]; } } while (0)
#define KBASE(t) ((j_lo + (t)) * KVBLK)
    const __attribute__((address_space(3))) float* tabh = (const __attribute__((address_space(3))) float*)(lds + TAB_OFF) + 4 * hi;
#define BIAS(P0_, P1_, t) do { const __attribute__((address_space(3))) float* tb_ = tabh + KBASE(t); _Pragma("unroll") for (int j_ = 0; j_ < 4; ++j_) { const f32x4 b0_ = *(const __attribute__((address_space(3))) f32x4*)(tb_ + 8 * j_), b1_ = *(const __attribute__((address_space(3))) f32x4*)(tb_ + 32 + 8 * j_); \
        P0_[4 * j_] += b0_[0]; P0_[4 * j_ + 1] += b0_[1]; P0_[4 * j_ + 2] += b0_[2]; P0_[4 * j_ + 3] += b0_[3]; P1_[4 * j_] += b1_[0]; P1_[4 * j_ + 1] += b1_[1]; P1_[4 * j_ + 2] += b1_[2]; P1_[4 * j_ + 3] += b1_[3]; } } while (0)
#define ACT(t) (KBASE(t) <= qlo + QBLK - 1 && KBASE(t) + KVBLK - 1 >= qlo - W + 1)
#define MASKT(P0_, P1_, t) do { const int kb_ = KBASE(t); if ((!SK || ACT(t)) && (kb_ + KVBLK - 1 > qlo || kb_ <= qlo + QBLK - 1 - W)) mask_tile(P0_, P1_, qm - kb_, (unsigned)W); } while (0)
    constexpr int NQL = F32 ? 16 : 8;
    constexpr bool SK = WSKIP && !F32;
#define SEAM_K0() do { VMWN(NQL); if constexpr (F32) { SWRITE_KF(0); SBAR(); SLOAD_F((const float*)nxt.V, kbn); } else { SWRITE_HK(0); } SBAR(); } while (0)
    f32x16 pA0, pA1, pB0, pB1; float mnA, mnB, alA, alB; bf16x8 pa0, pa1, pa2, pa3;
    if constexpr (F32) { VMW(); SWRITE_VF(0); SBAR(); } else { SWRITE_HV(0); SBAR(); }
    if (NT > 1) { if constexpr (F32) SLOAD_F((const float*)Kh, KBASE(1)); else SLOAD_H(Kh, Vh, KBASE(1)); }
    SBAR(); qkt<0, SK>(pA0, pA1, K_lds, r32, hi, S.qr, ACT(0), tabh + KBASE(0));
    if constexpr (F32) { if (NT > 1) { VMW(); SWRITE_KF(1); SBAR(); SLOAD_F((const float*)Vh, KBASE(1)); } }
    MASKT(pA0, pA1, 0); partialSM(pA0, pA1, m_reg, mnA, alA);
    if (NT > 1) { VMW(); if constexpr (F32) { SWRITE_VF(1); SBAR(); if (NT > 2) SLOAD_F((const float*)Kh, KBASE(2)); } else SWRITE_H(1); }
    __syncthreads();
#define HALF_STEP(PX0, PX1, mnX, alX, PY0, PY1, alY, t, KB, VB, SB) do {                                                      \
        SBAR(); qkt<KB, SK>(PX0, PX1, K_lds, r32, hi, S.qr, ACT(t), tabh + KBASE(t));                                             \
        finishSM(PY0, PY1, alY, l_reg, pa0, pa1, pa2, pa3); SBAR();                                                           \
        if ((t) + 1 < NT) { if constexpr (F32) { VMW(); SWRITE_KF(SB); SBAR(); SLOAD_F((const float*)Vh, KBASE((t) + 1)); }  \
                            else { SLOAD_H(Kh, Vh, KBASE((t) + 1)); } SBAR(); }                                               \
        pv_tile<VB, SK>(o, vb0, pa0, pa1, pa2, pa3, ACT((t) - 1)); MASKT(PX0, PX1, (t)); partialSM(PX0, PX1, m_reg, mnX, alX);                                        \
        __syncthreads();                                                                                                      \
        if ((t) + 1 < NT) { VMW(); if constexpr (F32) { SWRITE_VF(SB); SBAR(); if ((t) + 2 < NT) SLOAD_F((const float*)Kh, KBASE((t) + 2)); } \
                            else { SWRITE_H(SB); } }                                                                          \
        RESC(alX); __syncthreads(); } while (0)
    for (int t = 1; t + 1 < NT; t += 2) {
        HALF_STEP(pB0, pB1, mnB, alB, pA0, pA1, alA, t, 1, 0, 0);
        HALF_STEP(pA0, pA1, mnA, alA, pB0, pB1, alB, t + 1, 0, 1, 1);
    }
    const bool even = (NT & 1) == 0;
    if (even) { SBAR(); qkt<1, SK>(pB0, pB1, K_lds, r32, hi, S.qr, ACT(NT - 1), tabh + KBASE(NT - 1)); SBAR(); }
#define QROW(e) (nxt.Q + (size_t)(wid * QBLK + r32) * LDQ + ((e) >> 1) * 16 + hi * 8 + ((e) & 1) * 4)
    if constexpr (F32) { SLOAD_F((const float*)nxt.K, kbn); SBAR();
#pragma unroll
        for (int e = 0; e < 8; ++e) S.tq[e] = *(const f32x4*)QROW(e); }
    else { SLOAD_H(nxt.K, nxt.V, kbn); SBAR();
#pragma unroll
        for (int d0 = 0; d0 < 8; ++d0) S.qr[d0] = load8<TIn>(nxt.Q + (unsigned)((wid * QBLK + r32) * LDQ + d0 * 16 + hi * 8)); }
    SBAR();
    finishSM(pA0, pA1, alA, l_reg, pa0, pa1, pa2, pa3); SBAR();
    if constexpr (F32) {
#pragma unroll
        for (int e = 8; e < 16; ++e) S.tq[e] = *(const f32x4*)QROW(e); SBAR(); }
#undef QROW
    pv_tile<0, SK>(o, vb0, pa0, pa1, pa2, pa3, ACT(even ? NT - 2 : NT - 1));
    if (even) { MASKT(pB0, pB1, NT - 1); partialSM(pB0, pB1, m_reg, mnB, alB); __syncthreads(); RESC(alB);
        finishSM(pB0, pB1, alB, l_reg, pa0, pa1, pa2, pa3); SBAR(); pv_tile<1, SK>(o, vb0, pa0, pa1, pa2, pa3, ACT(NT - 1)); }
    SBAR(); SEAM_K0();
    if (hi == 0) li_l[r32] = l_reg; asm volatile("s_waitcnt lgkmcnt(0)" ::: "memory");
    float rli[16];
#pragma unroll
    for (int r = 0; r < 16; ++r) rli[r] = __builtin_amdgcn_rcpf(li_l[crow(r, hi)]);
    TOut* Ow = cur.O + (unsigned)((wid * QBLK) * LDQ);
#pragma unroll
    for (int r = 0; r < 16; ++r) { const int orow = crow(r, hi);
#pragma unroll
        for (int d0 = 0; d0 < 4; ++d0) { const float v = o[d0][r] * rli[r];
            if constexpr (same_t<TOut, float>::v) { Ow[(size_t)orow * LDQ + d0 * 32 + r32] = v; }
            else { const float vn = __shfl_xor(v, 1);
                   if ((r32 & 1) == 0) *(unsigned*)(Ow + (unsigned)(orow * LDQ + d0 * 32 + r32)) = cvtpk(v, vn); } } }
    if constexpr (F32) {
#pragma unroll
        for (int d0 = 0; d0 < 8; ++d0) S.qr[d0] = pack8(S.tq[2 * d0], S.tq[2 * d0 + 1]); }
    __syncthreads();
#undef RESC
#undef KBASE
#undef BIAS
#undef ACT
#undef MASKT
#undef SEAM_K0
#undef HALF_STEP
}
#undef ROW
#undef VMW
#undef VMWN
#undef SLOAD_H
#undef SWRITE_HK
#undef SWRITE_HV
#undef SWRITE_H
#undef SLOAD_F
#undef SWRITE_KF
#undef SWRITE_VF


}

constexpr size_t MiB = (size_t)1 << 20;
constexpr size_t WS_CTL = 0, CTL_ZERO_BYTES = 1 * MiB;
constexpr size_t WS_WF = 1 * MiB;
constexpr size_t WS_SSQ = 2 * MiB;
constexpr size_t WS_CL = 4 * MiB;
constexpr size_t WS_TOT = 5 * MiB;
constexpr size_t WS_W = 8 * MiB, W_LAYER = 118 * MiB;
constexpr size_t W_IN = 0, W_A = 36 * MiB, W_B = 40 * MiB, W_OUT = 44 * MiB, W_UP = 52 * MiB, W_DOWN = 96 * MiB;
constexpr size_t WS_X = 480 * MiB;
constexpr size_t WS_XB = 608 * MiB;
constexpr size_t WS_R1 = 672 * MiB;
constexpr size_t WS_YA = 960 * MiB, WS_YB = 992 * MiB, WS_MG = 1024 * MiB;
constexpr size_t WS_G = 1088 * MiB;
constexpr size_t WS_END = 1264 * MiB;
constexpr int CW_BAR = 4096;

constexpr int LDS_BYTES = 160 * 1024;
constexpr int MISC_OFF = LDS_BYTES - 256, ARGS_OFF = LDS_BYTES - 512;

#define XB_TMO      128
#define XB_XCNT(j)  (256  + 64 * (j))
#define XB_XSUB(j)  (1280 + 64 * (j))
#define XB_XGEN(j)  (2304 + 64 * (j))
#define XB_TOP      3328
#define XB_TOPGEN   3392
#define XCD_BAR_WORDS 3456
#define XB_SPIN_CAP (1u << 18)

__device__ __forceinline__ unsigned xb_ld(unsigned* p)              { return __hip_atomic_load(p, __ATOMIC_RELAXED, __HIP_MEMORY_SCOPE_AGENT); }
__device__ __forceinline__ unsigned xb_add(unsigned* p, unsigned v) { return __hip_atomic_fetch_add(p, v, __ATOMIC_RELAXED, __HIP_MEMORY_SCOPE_AGENT); }
__device__ __forceinline__ unsigned xb_xcc_id() { return (unsigned)__builtin_amdgcn_s_getreg((3 << 11) | 20) & 0xFu; }
#define XB_SPIN(cond, bar) do { unsigned _sp = 0; while (cond) { __builtin_amdgcn_s_sleep(1); \
    if ((++_sp & 255u) == 0u) { if (xb_ld(&(bar)[XB_TMO])) break; if (_sp > XB_SPIN_CAP) { atomicAdd(&(bar)[XB_TMO], 1u); break; } } } } while (0)

struct XcdBarrier {
    unsigned* bar; unsigned x;
    volatile LAS unsigned* st;
};

__device__ __forceinline__ XcdBarrier xcd_barrier_post(unsigned* bar, volatile LAS unsigned* st) {
    XcdBarrier b; b.bar = bar; b.x = xb_xcc_id(); b.st = st;
    if (threadIdx.x == 0) (void)xb_add(&bar[XB_XCNT(b.x)], 1u);
    return b;
}
__device__ __forceinline__ void xcd_barrier_complete(unsigned* bar, unsigned x, unsigned& nloc, unsigned& nx) {
    const unsigned G = gridDim.x * gridDim.y * gridDim.z;
    unsigned sum, cnt, mine, sp = 0u;
    for (;;) {
        sum = 0u; cnt = 0u; mine = 0u;
#pragma unroll
        for (unsigned j = 0; j < 16; ++j) { const unsigned c = xb_ld(&bar[XB_XCNT(j)]); sum += c; cnt += (c > 0u) ? 1u : 0u; mine = (j == x) ? c : mine; }
        if (sum == G) break;
        __builtin_amdgcn_s_sleep(1);
        if ((++sp & 255u) == 0u) { if (xb_ld(&bar[XB_TMO])) break; if (sp > XB_SPIN_CAP) { atomicAdd(&bar[XB_TMO], 1u); break; } }
    }
    nloc = mine > 0u ? mine : 1u; nx = cnt > 0u ? cnt : 1u;
}

__device__ __forceinline__ void xcd_barrier(const XcdBarrier& b) {
    asm volatile("s_waitcnt vmcnt(0)" ::: "memory");
    __syncthreads();
    if (threadIdx.x == 0) {
        unsigned* bar = b.bar;
        __builtin_amdgcn_s_waitcnt(0);
        unsigned nloc = b.st[0], nx = b.st[1];
        if (nloc == 0u) { xcd_barrier_complete(bar, b.x, nloc, nx); b.st[0] = nloc; b.st[1] = nx; }
        const unsigned old = xb_add(&bar[XB_XSUB(b.x)], 1u);
        const unsigned gen = old / nloc;
        if (old + 1u == (gen + 1u) * nloc) {
            __builtin_amdgcn_fence(__ATOMIC_RELEASE, "agent");
            asm volatile("s_waitcnt vmcnt(0)" ::: "memory");
            const unsigned og = xb_add(&bar[XB_TOP], 1u);
            const unsigned tg = og / nx;
            if (og + 1u == (tg + 1u) * nx) xb_add(&bar[XB_TOPGEN], 1u);
            else XB_SPIN(xb_ld(&bar[XB_TOPGEN]) == tg, bar);
            __builtin_amdgcn_fence(__ATOMIC_ACQUIRE, "agent");
            xb_add(&bar[XB_XGEN(b.x)], 1u);
            asm volatile("s_waitcnt vmcnt(0)" ::: "memory");
        } else {
            XB_SPIN(xb_ld(&bar[XB_XGEN(b.x)]) == gen, bar);
            __builtin_amdgcn_fence(__ATOMIC_ACQUIRE, "agent");
            asm volatile("s_waitcnt vmcnt(0)" ::: "memory");
        }
    }
    __syncthreads();
}

struct Args { const float* in[16]; float* out; unsigned char* ws; int ph_lo, ph_hi; };
enum { IN_X = 0, IN_GMIX, IN_WIN, IN_BF, IN_GSGU, IN_WSP, IN_BSP, IN_WA, IN_WB, IN_WOUT, IN_GFFN, IN_WUP, IN_CW, IN_CB, IN_WDOWN, IN_GFIN };

__device__ __forceinline__ void tr_tile(const float* src, int ldS, int srcCol0, const float* gain, bf16* dst, int K, int dstRow0, int k0, float* T, int tid) {
    const int kr = tid >> 5, c4 = tid & 31;
    f32x4 v[4]; float g[4];
#pragma unroll
    for (int i = 0; i < 4; ++i) { const int k = k0 + kr + 16 * i; v[i] = *(const f32x4*)(src + (size_t)k * ldS + srcCol0 + 4 * c4); g[i] = gain ? gain[k] : 1.0f; }
#pragma unroll
    for (int i = 0; i < 4; ++i) { float* t = T + (kr + 16 * i) * 129 + 4 * c4; t[0] = v[i][0] * g[i]; t[1] = v[i][1] * g[i]; t[2] = v[i][2] * g[i]; t[3] = v[i][3] * g[i]; }
    __syncthreads();
#pragma unroll
    for (int i = 0; i < 2; ++i) { const int idx = tid + 512 * i, n = idx >> 3, kc = idx & 7; const float* t = T + (8 * kc) * 129 + n;
        u32x4 w; w.x = cvt_pk_bf16(t[0], t[129]); w.y = cvt_pk_bf16(t[2 * 129], t[3 * 129]); w.z = cvt_pk_bf16(t[4 * 129], t[5 * 129]); w.w = cvt_pk_bf16(t[6 * 129], t[7 * 129]);
        *(u32x4*)(dst + (size_t)(dstRow0 + n) * K + k0 + 8 * kc) = w; }
    __syncthreads();
}
__device__ __forceinline__ void ph_rowstats(const float* src, bf16* xb, float* ssq, int gw, int ngw, int lane) {
    for (int row = gw; row < MTOK; row += ngw) {
        const f32x4* p = (const f32x4*)(src + (size_t)row * DM) + lane; f32x4 v[8]; float s = 0.f;
#pragma unroll
        for (int j = 0; j < 8; ++j) { v[j] = p[64 * j]; s += (v[j][0] * v[j][0] + v[j][1] * v[j][1]) + (v[j][2] * v[j][2] + v[j][3] * v[j][3]); }
        s = wave_sum(s);
        u32x2* o = (u32x2*)(xb + (size_t)row * DM) + lane;
#pragma unroll
        for (int j = 0; j < 8; ++j) { u32x2 w; w.x = cvt_pk_bf16(v[j][0], v[j][1]); w.y = cvt_pk_bf16(v[j][2], v[j][3]); o[64 * j] = w; }
        if (lane < 32) ssq[(size_t)row * 32 + lane] = lane == 0 ? s : 0.f;
    }
}
__device__ __forceinline__ void ph_prologue(const Args& a, unsigned char* lds, int tid, int lane, int wave, int bx, int G) {
    unsigned char* ws = a.ws; float* T = (float*)lds;
    constexpr int J_IN = 32 * 72, J_A = 16 * 16, J_OUT = 32 * 16, J_UP = 32 * 88, J_DOWN = 88 * 16, J_LAYER = J_IN + 2 * J_A + J_OUT + J_UP + J_DOWN;
    for (int j = bx; j < DEPTH * J_LAYER; j += G) {
        const int l = j / J_LAYER; int r = j % J_LAYER; bf16* wl = (bf16*)(ws + WS_W + (size_t)l * W_LAYER);
        if (r < J_IN) { const int tn = r % 72, kt = r / 72; tr_tile(a.in[IN_WIN] + (size_t)l * DM * INW, INW, tn * 128 < 3072 ? tn * 128 : tn * 128 + 8, a.in[IN_GMIX] + l * DM, (bf16*)((unsigned char*)wl + W_IN), DM, tn * 128, kt * 64, T, tid); continue; } r -= J_IN;
        if (r < J_A) { const int tn = r % 16, kt = r / 16; tr_tile(a.in[IN_WA] + (size_t)l * FW * DM, DM, tn * 128, nullptr, (bf16*)((unsigned char*)wl + W_A), FW, tn * 128, kt * 64, T, tid); continue; } r -= J_A;
        if (r < J_A) { const int tn = r % 16, kt = r / 16; tr_tile(a.in[IN_WB] + (size_t)l * SW * DM, DM, tn * 128, nullptr, (bf16*)((unsigned char*)wl + W_B), SW, tn * 128, kt * 64, T, tid); continue; } r -= J_A;
        if (r < J_OUT) { const int tn = r % 16, kt = r / 16; tr_tile(a.in[IN_WOUT] + (size_t)l * DM * DM, DM, tn * 128, nullptr, (bf16*)((unsigned char*)wl + W_OUT), DM, tn * 128, kt * 64, T, tid); continue; } r -= J_OUT;
        if (r < J_UP) { const int tn = r % 88, kt = r / 88; tr_tile(a.in[IN_WUP] + (size_t)l * DM * NUP, NUP, (tn & 1) * DFF + (tn >> 1) * 128, a.in[IN_GFFN] + l * DM, (bf16*)((unsigned char*)wl + W_UP), DM, tn * 128, kt * 64, T, tid); continue; } r -= J_UP;
        { const int tn = r % 16, kt = r / 16; tr_tile(a.in[IN_WDOWN] + (size_t)l * DFF * DM, DM, tn * 128, nullptr, (bf16*)((unsigned char*)wl + W_DOWN), DFF, tn * 128, kt * 64, T, tid); }
    }
    float* wf = (float*)(ws + WS_WF);
    for (int i = bx * 512 + tid; i < DEPTH * NH * DM; i += G * 512) { const int k = i % DM, h = (i / DM) % NH, l = i / (DM * NH);
        wf[i] = a.in[IN_WIN][((size_t)l * DM + k) * INW + 3 * FW + h] * a.in[IN_GMIX][l * DM + k]; }
    ph_rowstats(a.in[IN_X], (bf16*)(ws + WS_XB), (float*)(ws + WS_SSQ), bx * 8 + wave, G * 8, lane);
}

__device__ __forceinline__ void f_unit(const Args& a, int l, int chunk, unsigned char* lds, int tid, int lane, int wave) {
    unsigned char* ws = a.ws; const bf16* xb = (const bf16*)(ws + WS_XB); const float* wf = (const float*)(ws + WS_WF) + (size_t)l * NH * DM; const float* ssq = (const float*)(ws + WS_SSQ);
    float* part = (float*)lds;
    float* lf = (float*)(lds + 16384);
    { const int tl = (wave & 3) * 64 + lane, kh = wave >> 2;
      const bf16* xr = xb + (size_t)(chunk * 256 + tl) * DM + kh * 1024; const float* wk = wf + kh * 1024;
      float f[8];
#pragma unroll
      for (int h = 0; h < 8; ++h) f[h] = 0.f;
      for (int k8 = 0; k8 < 128; ++k8) { const u32x4 w = *(const u32x4*)(xr + 8 * k8);
          const float xv[8] = {bf_lo(w.x), bf_hi(w.x), bf_lo(w.y), bf_hi(w.y), bf_lo(w.z), bf_hi(w.z), bf_lo(w.w), bf_hi(w.w)};
#pragma unroll
          for (int h = 0; h < 8; ++h) {
#pragma unroll
              for (int j = 0; j < 8; ++j) f[h] += xv[j] * wk[h * DM + 8 * k8 + j]; } }
#pragma unroll
      for (int h = 0; h < 8; ++h) part[(kh * 256 + tl) * 8 + h] = f[h]; }
    __syncthreads();
    if (tid < 256) { const int row = chunk * 256 + tid; const f32x4* p = (const f32x4*)(ssq + (size_t)row * 32); float s = 0.f;
#pragma unroll
        for (int j = 0; j < 8; ++j) { const f32x4 q = p[j]; s += (q[0] + q[1]) + (q[2] + q[3]); }
        const float inv = rsqrtf(s * (1.0f / DM) + RMS_EPS);
#pragma unroll
        for (int h = 0; h < 8; ++h) lf[tid * 8 + h] = log_sigmoid_f((part[tid * 8 + h] + part[(256 + tid) * 8 + h]) * inv + a.in[IN_BF][l * NH + h]); }
    __syncthreads();
    if (tid < 8) { float run = 0.f; for (int t = 0; t < 256; ++t) { run += lf[t * 8 + tid]; lf[t * 8 + tid] = run; }
        ((float*)(ws + WS_TOT))[chunk * 8 + tid] = run; }
    __syncthreads();
    { float* cl = (float*)(ws + WS_CL); const int b = chunk >> 4, c16 = chunk & 15;
      for (int i = tid; i < 2048; i += 512) { const int tl = i & 255, h = i >> 8; cl[((size_t)(b * NH + h)) * SEQ + c16 * 256 + tl] = lf[tl * 8 + h]; } }
    __syncthreads();
}

__device__ __forceinline__ void attn_table(const float* cl, const float* tot, char* lds, int bh, int tid) {
    float* tab = (float*)(lds + fa::TAB_OFF); const int b = bh >> 3, h = bh & 7;
    __syncthreads();
    for (int i = tid; i < SEQ; i += 512) { const int ch = i >> 8; float pre = 0.f; for (int j = 0; j < ch; ++j) pre += tot[(b * 16 + j) * 8 + h];
        tab[i] = -(cl[(size_t)bh * SEQ + i] + pre) * 11.313708498984761f; }
    __syncthreads();
}
__device__ __forceinline__ fa::BlockRef<bf16, bf16> attn_ref(const bf16* Qb, const bf16* Kb, const bf16* Vb, bf16* Ob, int bh, int qb) {
    const int b = bh >> 3, h = bh & 7; const size_t rq = (size_t)(b * SEQ + qb * 256) * 1024 + h * HD, rk = (size_t)(b * SEQ) * 1024 + h * HD;
    fa::BlockRef<bf16, bf16> r; r.Q = Qb + rq; r.O = Ob + rq; r.K = Kb + rk; r.V = Vb + rk; r.P0 = qb * 256; return r;
}
__device__ __forceinline__ void attn_fast(unsigned char* ws, unsigned char* ldsg, int tid, int bx, int G) {
    char* lds = (char*)ldsg;
    const bf16* Qb = (const bf16*)(ws + WS_R1); const bf16* Kb = Qb + (size_t)MTOK * 1024; const bf16* Vb = Kb + (size_t)MTOK * 1024; bf16* Ob = (bf16*)(ws + WS_YA);
    const float* cl = (const float*)(ws + WS_CL); const float* tot = (const float*)(ws + WS_TOT);
    const int total = NB * NH * 8, stride = G, W = SEQ;
    int L = bx;
    if (L < total) {
#define FA_DEC(L_, bh_, x_) do { bh_ = (((L_) >> 6) << 3) + ((L_) & 7); x_ = ((L_) >> 3) & 7; } while (0)
        int bh, x, pass = 0; FA_DEC(L, bh, x);
        fa::BlockRef<bf16, bf16> cur = attn_ref(Qb, Kb, Vb, Ob, bh, x);
        attn_table(cl, tot, lds, bh, tid);
        fa::Seam<bf16> S;
        fa::causal_swa_prime<bf16, bf16>(cur, W, lds, S, tid);
        for (;;) {
            const bool more_pass = pass == 0, more_item = L + stride < total, last = !more_pass && !more_item;
            int bhn = bh, xn = x, passn = pass + 1, Ln = L;
            if (!more_pass) { passn = 0; Ln = more_item ? L + stride : L; FA_DEC(Ln, bhn, xn); }
            const fa::BlockRef<bf16, bf16> nxt = last ? cur : attn_ref(Qb, Kb, Vb, Ob, bhn, passn ? 15 - xn : xn);
            fa::causal_swa_block<bf16, bf16>(cur, nxt, SEQ, W, lds, S, tid);
            if (last) break;
            if (bhn != bh) attn_table(cl, tot, lds, bhn, tid);
            cur = nxt; bh = bhn; x = xn; pass = passn; L = Ln;
        }
#undef FA_DEC
    }
    __syncthreads();
}

__device__ __forceinline__ void sgu_simple(const Args& a, int l, unsigned char* lds, int tid, int lane, int wave, int bx, int G) {
    unsigned char* ws = a.ws; const bf16* GU = (const bf16*)(ws + WS_R1) + (size_t)3 * MTOK * 1024; const bf16* GV = GU + (size_t)MTOK * 1024; bf16* YB = (bf16*)(ws + WS_YB);
    float* vn = (float*)lds; float* Wl = (float*)(lds + 65536); float* inv = (float*)(lds + 131072);
    const float* gs = a.in[IN_GSGU] + l * SW; const float* wsp = a.in[IN_WSP] + (size_t)l * NG * SCH * SCH; const float* bsp = a.in[IN_BSP] + (size_t)l * NG * SCH;
    for (int unit = bx; unit < (MTOK / SCH) * NG; unit += G) {
        const int n = unit >> 3, g = unit & 7, tok0 = n * SCH;
        __syncthreads();
        for (int i = 0; i < 16; ++i) { const int s = wave * 16 + i; const bf16* r = GV + (size_t)(tok0 + s) * SW + lane * 16; float ss = 0.f;
#pragma unroll
            for (int q = 0; q < 2; ++q) { const u32x4 w = *(const u32x4*)(r + 8 * q); const float e[8] = {bf_lo(w.x), bf_hi(w.x), bf_lo(w.y), bf_hi(w.y), bf_lo(w.z), bf_hi(w.z), bf_lo(w.w), bf_hi(w.w)};
#pragma unroll
                for (int j = 0; j < 8; ++j) ss += e[j] * e[j]; }
            ss = wave_sum(ss); if (lane == 0) inv[s] = rsqrtf(ss * (1.0f / SW) + RMS_EPS); }
        __syncthreads();
        for (int i = tid; i < SCH * GD; i += 512) { const int s = i >> 7, c = i & 127;
            vn[i] = bf2f(GV[(size_t)(tok0 + s) * SW + g * GD + c]) * inv[s] * gs[g * GD + c];
            Wl[i] = wsp[(size_t)g * SCH * SCH + i]; }
        __syncthreads();
        { const int c = tid & 127, tq = tid >> 7;
          for (int t = tq; t < SCH; t += 4) { float acc = 0.f; for (int s = 0; s <= t; ++s) acc += Wl[t * SCH + s] * vn[s * GD + c];
              const size_t o = (size_t)(tok0 + t) * SW + g * GD + c;
              YB[o] = f2bf((acc + bsp[g * SCH + t]) * bf2f(GU[o])); } }
    }
    __syncthreads();
}

__device__ __forceinline__ void conv_simple(const Args& a, int l, int tid, int bx, int G) {
    unsigned char* ws = a.ws; const bf16* AR = (const bf16*)(ws + WS_R1); bf16* Gb = (bf16*)(ws + WS_G);
    const float* cw = a.in[IN_CW] + (size_t)l * 3 * DFF; const float* cb = a.in[IN_CB] + (size_t)l * DFF;
    constexpr int NCG = DFF / 8;
    for (size_t i = (size_t)bx * 512 + tid; i < (size_t)MTOK * NCG; i += (size_t)G * 512) {
        const int row = (int)(i / NCG), cg = (int)(i % NCG), s = row & (SEQ - 1); const size_t o = (size_t)row * DFF + 8 * cg;
        const u32x4 z = {0u, 0u, 0u, 0u};
        const u32x4 a0 = *(const u32x4*)(AR + o), a1 = s >= 1 ? *(const u32x4*)(AR + o - DFF) : z, a2 = s >= 2 ? *(const u32x4*)(AR + o - 2 * DFF) : z, bb = *(const u32x4*)(Gb + o);
        const float x0[8] = {bf_lo(a0.x), bf_hi(a0.x), bf_lo(a0.y), bf_hi(a0.y), bf_lo(a0.z), bf_hi(a0.z), bf_lo(a0.w), bf_hi(a0.w)};
        const float x1[8] = {bf_lo(a1.x), bf_hi(a1.x), bf_lo(a1.y), bf_hi(a1.y), bf_lo(a1.z), bf_hi(a1.z), bf_lo(a1.w), bf_hi(a1.w)};
        const float x2[8] = {bf_lo(a2.x), bf_hi(a2.x), bf_lo(a2.y), bf_hi(a2.y), bf_lo(a2.z), bf_hi(a2.z), bf_lo(a2.w), bf_hi(a2.w)};
        const float bv[8] = {bf_lo(bb.x), bf_hi(bb.x), bf_lo(bb.y), bf_hi(bb.y), bf_lo(bb.z), bf_hi(bb.z), bf_lo(bb.w), bf_hi(bb.w)};
        float r[8];
#pragma unroll
        for (int j = 0; j < 8; ++j) { const int c = 8 * cg + j; const float v = cb[c] + cw[c] * x2[j] + cw[DFF + c] * x1[j] + cw[2 * DFF + c] * x0[j]; r[j] = gelu_tanh(v) * bv[j]; }
        u32x4 w; w.x = cvt_pk_bf16(r[0], r[1]); w.y = cvt_pk_bf16(r[2], r[3]); w.z = cvt_pk_bf16(r[4], r[5]); w.w = cvt_pk_bf16(r[6], r[7]);
        *(u32x4*)(Gb + o) = w;
    }
}
__device__ __forceinline__ void ph_final(const Args& a, int gw, int ngw, int lane) {
    const float* x = (const float*)(a.ws + WS_X); const f32x4* gf = (const f32x4*)a.in[IN_GFIN] + lane;
    for (int row = gw; row < MTOK; row += ngw) {
        const f32x4* p = (const f32x4*)(x + (size_t)row * DM) + lane; f32x4 v[8]; float s = 0.f;
#pragma unroll
        for (int j = 0; j < 8; ++j) { v[j] = p[64 * j]; s += (v[j][0] * v[j][0] + v[j][1] * v[j][1]) + (v[j][2] * v[j][2] + v[j][3] * v[j][3]); }
        s = wave_sum(s); const float inv = rsqrtf(s * (1.0f / DM) + RMS_EPS);
        f32x4* o = (f32x4*)(a.out + (size_t)row * DM) + lane;
#pragma unroll
        for (int j = 0; j < 8; ++j) o[64 * j] = (v[j] * inv) * gf[64 * j];
    }
}

constexpr int PH_PER_LAYER = 9, N_PHASES = 2 + DEPTH * PH_PER_LAYER;
#define PHASE_BEGIN() int tid = threadIdx.x; asm volatile("" : "+v"(tid)); const int lane = tid & 63, wave = __builtin_amdgcn_readfirstlane(tid >> 6); \
    int bx = blockIdx.x; asm volatile("" : "+s"(bx)); int G = gridDim.x; asm volatile("" : "+s"(G)); \
    Args A; _Pragma("unroll") for (int i_ = 0; i_ < 16; ++i_) A.in[i_] = (const float*)(GAS const float*)ldarg(ARGL, i_); \
    A.out = (float*)(GAS float*)ldarg(ARGL, 16); A.ws = (unsigned char*)(GAS unsigned char*)ldarg(ARGL, 17); A.ph_lo = 0; A.ph_hi = 0; \
    unsigned char* ws = A.ws; (void)lane; (void)wave; (void)ws; (void)bx; (void)G
__device__ __forceinline__ unsigned long long ldarg(volatile LAS unsigned long long* t, int i) {
    const unsigned long long v = t[i]; const unsigned lo = __builtin_amdgcn_readfirstlane((unsigned)v), hi = __builtin_amdgcn_readfirstlane((unsigned)(v >> 32));
    return ((unsigned long long)hi << 32) | lo;
}
__global__ void __launch_bounds__(512, 2) fwd_kernel(Args args) {
    extern __shared__ __attribute__((aligned(16))) unsigned char lds[];
    volatile LAS unsigned* MISC = (volatile LAS unsigned*)((LAS unsigned char*)lds + MISC_OFF);
    volatile LAS unsigned long long* ARGL = (volatile LAS unsigned long long*)((LAS unsigned char*)lds + ARGS_OFF);
    if (threadIdx.x < 64) MISC[threadIdx.x] = 0u;
    { unsigned long long v_ = 0ull;
#pragma unroll
      for (int i_ = 0; i_ < 16; ++i_) if ((int)threadIdx.x == i_) v_ = (unsigned long long)args.in[i_];
      if (threadIdx.x == 16) v_ = (unsigned long long)args.out; if (threadIdx.x == 17) v_ = (unsigned long long)args.ws;
      if (threadIdx.x < 18) ARGL[threadIdx.x] = v_; }
    __syncthreads();
    const int lo = args.ph_lo, hi = args.ph_hi;
    unsigned* ctl = (unsigned*)(args.ws + WS_CTL);
    XcdBarrier bar; bar.bar = ctl + CW_BAR; bar.x = 0; bar.st = nullptr;
    if (hi - lo > 1) bar = xcd_barrier_post(ctl + CW_BAR, MISC + 8);
#define IN(k) (lo <= (k) && (k) < hi)
#ifndef ONLY_J
#define ONLY_J -1
#endif
#define INL(j) ((ONLY_J < 0 || ONLY_J == (j)) && IN(pb + (j)))
#define SEAM(k) do { if (lo <= (k) && (k) + 1 < hi) { XcdBarrier b_ = bar; { GAS unsigned* p_ = (GAS unsigned*)b_.bar; asm volatile("" : "+s"(p_)); b_.bar = (unsigned*)p_; } xcd_barrier(b_); } } while (0)
    LAS unsigned char* ring = (LAS unsigned char*)lds;

    if (IN(0)) { PHASE_BEGIN(); ph_prologue(A, lds, tid, lane, wave, bx, G); SEAM(0); }

    for (int l = 0; l < DEPTH; ++l) {
        const int pb = 1 + l * PH_PER_LAYER;
        if (INL(0)) { PHASE_BEGIN();
            for (int ch = bx; ch < MTOK / 256; ch += G) f_unit(A, l, ch, lds, tid, lane, wave);
            const unsigned char* wl = ws + WS_W + (size_t)l * W_LAYER;
            pg8::Gemm g{(const bf16*)(ws + WS_XB), (const bf16*)(wl + W_IN), MTOK, NIN, DM}; pg8::StaticOrder S; S.init(MTOK, NIN, G, bx);
            pg8::EpiInProj E{(const float*)(ws + WS_SSQ), (bf16*)(ws + WS_R1)};
            pg8::gemm_phase<pg8::EpiInProj, pg8::StaticOrder, true, true>(ring, g, S, E, tid);
            SEAM(pb + 0);
        }
        if (INL(1)) { PHASE_BEGIN(); attn_fast(ws, lds, tid, bx, G); sgu_simple(A, l, lds, tid, lane, wave, bx, G); SEAM(pb + 1); }
        if (INL(2)) { PHASE_BEGIN();
            const unsigned char* wl = ws + WS_W + (size_t)l * W_LAYER;
            float* T = (float*)(ws + WS_R1); bf16* R1 = (bf16*)(ws + WS_R1);
            { pg8::Gemm g{(const bf16*)(ws + WS_YA), (const bf16*)(wl + W_A), MTOK, DM, FW}; pg8::StaticOrder S; S.init(MTOK, DM, G, bx);
              pg8::EpiBranchA E{R1 + (size_t)5 * MTOK * 1024, T};
              pg8::gemm_phase<pg8::EpiBranchA, pg8::StaticOrder, true, true>(ring, g, S, E, tid); }
            { pg8::Gemm g{(const bf16*)(ws + WS_YB), (const bf16*)(wl + W_B), MTOK, DM, SW}; pg8::StaticOrder S; S.init(MTOK, DM, G, bx);
              pg8::EpiBranchB E{R1 + (size_t)5 * MTOK * 1024 + (size_t)MTOK * 2048, T, (bf16*)(ws + WS_MG)};
              pg8::gemm_phase<pg8::EpiBranchB, pg8::StaticOrder, true, true>(ring, g, S, E, tid); }
            SEAM(pb + 2);
        }
        if (INL(3)) { PHASE_BEGIN();
            const unsigned char* wl = ws + WS_W + (size_t)l * W_LAYER; float* XR = (float*)(ws + WS_X);
            pg8::Gemm g{(const bf16*)(ws + WS_MG), (const bf16*)(wl + W_OUT), MTOK, DM, DM}; pg8::StaticOrder S; S.init(MTOK, DM, G, bx);
            pg8::EpiResid E{l == 0 ? A.in[IN_X] : (const float*)XR, XR};
            pg8::gemm_phase<pg8::EpiResid, pg8::StaticOrder, true, true>(ring, g, S, E, tid);
            SEAM(pb + 3);
        }
        if (INL(4)) { PHASE_BEGIN(); ph_rowstats((const float*)(ws + WS_X), (bf16*)(ws + WS_XB), (float*)(ws + WS_SSQ), bx * 8 + wave, G * 8, lane); SEAM(pb + 4); }
        if (INL(5)) { PHASE_BEGIN();
            const unsigned char* wl = ws + WS_W + (size_t)l * W_LAYER;
            pg8::Gemm g{(const bf16*)(ws + WS_XB), (const bf16*)(wl + W_UP), MTOK, NUP, DM}; pg8::StaticOrder S; S.init(MTOK, NUP, G, bx);
            pg8::EpiUp1 E{(const float*)(ws + WS_SSQ), (bf16*)(ws + WS_R1), (bf16*)(ws + WS_G)};
            pg8::gemm_phase<pg8::EpiUp1, pg8::StaticOrder, true, true>(ring, g, S, E, tid);
            SEAM(pb + 5);
        }
        if (INL(6)) { PHASE_BEGIN(); conv_simple(A, l, tid, bx, G); SEAM(pb + 6); }
        if (INL(7)) { PHASE_BEGIN();
            const unsigned char* wl = ws + WS_W + (size_t)l * W_LAYER; float* XR = (float*)(ws + WS_X);
            pg8::Gemm g{(const bf16*)(ws + WS_G), (const bf16*)(wl + W_DOWN), MTOK, DM, DFF}; pg8::StaticOrder S; S.init(MTOK, DM, G, bx);
            pg8::EpiResid E{(const float*)XR, XR};
            pg8::gemm_phase<pg8::EpiResid, pg8::StaticOrder, true, true>(ring, g, S, E, tid);
            SEAM(pb + 7);
        }
        if (INL(8)) { PHASE_BEGIN(); ph_rowstats((const float*)(ws + WS_X), (bf16*)(ws + WS_XB), (float*)(ws + WS_SSQ), bx * 8 + wave, G * 8, lane); SEAM(pb + 8); }
    }
    if (IN(N_PHASES - 1)) { PHASE_BEGIN(); ph_final(A, bx * 8 + wave, G * 8, lane); }
#undef IN
#undef INL
#undef SEAM
}

#ifndef MK_LAUNCH_PER_PHASE
#define MK_LAUNCH_PER_PHASE 0
#endif
extern "C" void kernel_launch(void* const* d_in, const int* in_sizes, int n_in, void* d_out, int out_size, void* d_ws, size_t ws_size, hipStream_t stream) {
    static int grid = 0;
    if (grid == 0) {
        if (n_in != 16 || in_sizes[0] != MTOK * DM || out_size != MTOK * DM || ws_size < WS_END) { fprintf(stderr, "kernel_launch: unexpected shapes (n_in %d, in0 %d, out %d, ws %zu)\n", n_in, n_in > 0 ? in_sizes[0] : -1, out_size, ws_size); grid = -1; return; }
        int dev = 0, cus = 0, per_cu = 0;
        if (hipGetDevice(&dev) != hipSuccess || hipDeviceGetAttribute(&cus, hipDeviceAttributeMultiprocessorCount, dev) != hipSuccess) { grid = -1; return; }
        if (hipFuncSetAttribute((const void*)fwd_kernel, hipFuncAttributeMaxDynamicSharedMemorySize, LDS_BYTES) != hipSuccess) { fprintf(stderr, "kernel_launch: hipFuncSetAttribute failed\n"); grid = -1; return; }
        if (hipOccupancyMaxActiveBlocksPerMultiprocessor(&per_cu, (const void*)fwd_kernel, 512, LDS_BYTES) != hipSuccess || per_cu < 1) { fprintf(stderr, "kernel_launch: occupancy query reports %d\n", per_cu); }
        (void)hipGetLastError();
        grid = cus;
    }
    if (grid < 0) return;
    (void)hipMemsetAsync((char*)d_ws + WS_CTL, 0, CTL_ZERO_BYTES, stream);
    Args a; memset(&a, 0, sizeof(a));
    for (int i = 0; i < 16; ++i) a.in[i] = (const float*)d_in[i];
    a.out = (float*)d_out; a.ws = (unsigned char*)d_ws;
#if MK_LAUNCH_PER_PHASE
    for (int p = 0; p < N_PHASES; ++p) { a.ph_lo = p; a.ph_hi = p + 1; hipLaunchKernelGGL(fwd_kernel, dim3(grid), dim3(512), LDS_BYTES, stream, a); }
#else
    a.ph_lo = 0; a.ph_hi = N_PHASES; hipLaunchKernelGGL(fwd_kernel, dim3(grid), dim3(512), LDS_BYTES, stream, a);
#endif
}
```

```cpp
#include <hip/hip_runtime.h>
#include <cstdio>
#include <cstdint>
#include <cstring>

#define LAS __attribute__((address_space(3)))
#define GAS __attribute__((address_space(1)))
typedef unsigned short bf16;
typedef short bf16x8 __attribute__((ext_vector_type(8)));
typedef float f32x4 __attribute__((ext_vector_type(4)));
typedef float f32x2 __attribute__((ext_vector_type(2)));
typedef unsigned u32x4 __attribute__((ext_vector_type(4)));
typedef unsigned u32x2 __attribute__((ext_vector_type(2)));

constexpr int DM = 2048, NB = 4, SEQ = 4096, DEPTH = 4, MTOK = NB * SEQ;
constexpr int FW = 1024, NH = 8, HD = 128, SW = 1024, NG = 8, GD = 128, SCH = 128, DFF = 5632, INW = 9224, NIN = 9216, NUP = 2 * DFF;
constexpr float RMS_EPS = 1e-6f;
constexpr float ATT_SCALE = 0.08838834764831845f;

__device__ __forceinline__ float bf_lo(unsigned w) { return __uint_as_float(w << 16); }
__device__ __forceinline__ float bf_hi(unsigned w) { return __uint_as_float(w & 0xffff0000u); }
__device__ __forceinline__ float bf2f(bf16 b) { return __uint_as_float(((unsigned)b) << 16); }
__device__ __forceinline__ unsigned cvt_pk_bf16(float lo, float hi) { unsigned r; asm volatile("v_cvt_pk_bf16_f32 %0, %1, %2" : "=v"(r) : "v"(lo), "v"(hi)); return r; }
__device__ __forceinline__ bf16 f2bf(float f) { return (bf16)(cvt_pk_bf16(f, 0.f) & 0xffffu); }
__device__ __forceinline__ float gelu_tanh(float x) {
    const float u = x * (0.7978845608028654f + 0.035677408136300125f * x * x);
    const float e = __builtin_amdgcn_exp2f(-2.8853900817779268f * u);
    return x * __builtin_amdgcn_rcpf(1.0f + e);
}
__device__ __forceinline__ float sigmoid_f(float x) { return __builtin_amdgcn_rcpf(1.0f + __builtin_amdgcn_exp2f(-1.4426950408889634f * x)); }
__device__ __forceinline__ float log_sigmoid_f(float z) { return fminf(z, 0.f) - log1pf(__expf(-fabsf(z))); }
__device__ __forceinline__ float wave_sum(float v) {
#pragma unroll
    for (int o = 1; o < 64; o <<= 1) v += __shfl_xor(v, o);
    return v;
}
__device__ __forceinline__ float wave_max(float v) {
#pragma unroll
    for (int o = 1; o < 64; o <<= 1) v = fmaxf(v, __shfl_xor(v, o));
    return v;
}

namespace pg8 {
#define PG8_LAS __attribute__((address_space(3)))
typedef unsigned short bf16_t;
typedef short bf16x8 __attribute__((ext_vector_type(8)));
typedef float f32x4 __attribute__((ext_vector_type(4)));
typedef unsigned u32x4 __attribute__((ext_vector_type(4)));
constexpr int BM = 256, BK = 64, HALF = 128, HTB = HALF * BK * 2  , STAGE_BYTES = 8 * HTB, NXCD = 8, WGM = 8;

__host__ __device__ __forceinline__ int lds_byte(int r, int c) { const int st = (r >> 4) * 2 + (c >> 5), rr = r & 15, cc = c & 31, ob = rr * 64 + cc * 2; return st * 1024 + (ob ^ (((ob >> 9) & 1) << 5)); }
__host__ __device__ __forceinline__ void stage_rc(int b, int& R, int& C) { const int st = b / 1024, sb = b % 1024, swz = sb ^ (((sb >> 9) & 1) << 5); R = (st >> 1) * 16 + swz / 64; C = (st & 1) * 32 + (swz % 64) / 2; }
__host__ __device__ __forceinline__ int perm32(int rho) { const int n = rho >> 4, i = rho & 15; return 8 * (i >> 2) + 4 * n + (i & 3); }

struct Unit { int pm, pn; };
struct Gemm { const bf16_t* A; const bf16_t* Bt; int M, N, K; };

struct StaticOrder {
    int nM, nN, nwg, G, c;
    __host__ __device__ void init(int M, int N, int G_, int c_) { nM = M / BM; nN = N / BM; nwg = nM * nN; G = G_; c = c_; }
    __host__ __device__ bool next(int i, Unit& u) const {
        const long L = (long)i * G + c; if (L >= nwg) return false;
        int wgid = (int)L; { const int q = nwg / NXCD, r = nwg % NXCD, xcd = wgid % NXCD, off = wgid / NXCD; wgid = (xcd < r ? xcd * (q + 1) : r * (q + 1) + (xcd - r) * q) + off; }
        const int nig = WGM * nN, gid = wgid / nig, fm = gid * WGM, gsz = (nM - fm) < WGM ? (nM - fm) : WGM;
        u.pm = fm + ((wgid % nig) % gsz); u.pn = (wgid % nig) / gsz; return true;
    }
    __device__ __forceinline__ void a_ready(const Unit&) const {}
    __device__ __forceinline__ void done(const Unit&) const {}
};

__device__ __forceinline__ void row_inv8(const float* ssq, int row0, int fq, float (&inv)[2][4]) {
#pragma unroll
    for (int ai = 0; ai < 2; ++ai)
#pragma unroll
        for (int m = 0; m < 4; ++m) {
            const f32x4* p = (const f32x4*)(ssq + (size_t)(row0 + ai * HALF + m * 16) * 32) + 2 * fq;
            const f32x4 a = p[0], b = p[1];
            float s = ((a[0] + a[1]) + (a[2] + a[3])) + ((b[0] + b[1]) + (b[2] + b[3]));
            s += __shfl_xor(s, 16); s += __shfl_xor(s, 32);
            inv[ai][m] = rsqrtf(s * (1.0f / DM) + RMS_EPS);
        }
}
struct EpiInProj {
    static constexpr bool PERM = false, APERM = false, AFTER_DRAIN = false;
    const float* ssq; bf16* R1;
    __device__ __forceinline__ void operator()(const f32x4 (&acc)[2][2][4][2], const Unit& u, int wr, int wc, int fr, int fq) const {
        const int row0 = u.pm * BM + wr * 64 + fr;
        float inv[2][4]; row_inv8(ssq, row0, fq, inv);
        int mode, ld, colb; bf16* base;
        if (u.pn < 20) { const int t = u.pn >> 2; base = R1 + (size_t)t * MTOK * 1024; ld = 1024; colb = (u.pn & 3) * 256; mode = t < 3 ? 0 : 1; }
        else { const int t = (u.pn - 20) >> 3; base = R1 + (size_t)5 * MTOK * 1024 + (size_t)t * MTOK * 2048; ld = 2048; colb = ((u.pn - 20) & 7) * 256; mode = 2; }
#pragma unroll
        for (int ai = 0; ai < 2; ++ai)
#pragma unroll
            for (int m = 0; m < 4; ++m) { bf16* rowp = base + (size_t)(row0 + ai * HALF + m * 16) * ld + colb + wc * 32 + 4 * fq;
#pragma unroll
                for (int bj = 0; bj < 2; ++bj)
#pragma unroll
                    for (int n = 0; n < 2; ++n) { f32x4 v = acc[ai][bj][m][n] * inv[ai][m];
                        if (mode == 1) { v[0] = gelu_tanh(v[0]); v[1] = gelu_tanh(v[1]); v[2] = gelu_tanh(v[2]); v[3] = gelu_tanh(v[3]); }
                        else if (mode == 2) { v[0] = sigmoid_f(v[0]); v[1] = sigmoid_f(v[1]); v[2] = sigmoid_f(v[2]); v[3] = sigmoid_f(v[3]); }
                        u32x2 w; w.x = cvt_pk_bf16(v[0], v[1]); w.y = cvt_pk_bf16(v[2], v[3]);
                        *(u32x2*)(rowp + bj * HALF + n * 16) = w; } }
    }
};
struct EpiBranchA {
    static constexpr bool PERM = false, APERM = false, AFTER_DRAIN = false;
    const bf16* SA; float* T;
    __device__ __forceinline__ void operator()(const f32x4 (&acc)[2][2][4][2], const Unit& u, int wr, int wc, int fr, int fq) const {
        const int row0 = u.pm * BM + wr * 64 + fr, col0 = u.pn * BM + wc * 32 + 4 * fq;
#pragma unroll
        for (int ai = 0; ai < 2; ++ai)
#pragma unroll
            for (int m = 0; m < 4; ++m) { const size_t off = (size_t)(row0 + ai * HALF + m * 16) * DM + col0;
#pragma unroll
                for (int bj = 0; bj < 2; ++bj)
#pragma unroll
                    for (int n = 0; n < 2; ++n) { const u32x2 g = *(const u32x2*)(SA + off + bj * HALF + n * 16);
                        const f32x4 gv = {bf_lo(g.x), bf_hi(g.x), bf_lo(g.y), bf_hi(g.y)};
                        *(f32x4*)(T + off + bj * HALF + n * 16) = acc[ai][bj][m][n] * gv; } }
    }
};
struct EpiBranchB {
    static constexpr bool PERM = false, APERM = false, AFTER_DRAIN = false;
    const bf16* SB; const float* T; bf16* MG;
    __device__ __forceinline__ void operator()(const f32x4 (&acc)[2][2][4][2], const Unit& u, int wr, int wc, int fr, int fq) const {
        const int row0 = u.pm * BM + wr * 64 + fr, col0 = u.pn * BM + wc * 32 + 4 * fq;
#pragma unroll
        for (int ai = 0; ai < 2; ++ai)
#pragma unroll
            for (int m = 0; m < 4; ++m) { const size_t off = (size_t)(row0 + ai * HALF + m * 16) * DM + col0;
#pragma unroll
                for (int bj = 0; bj < 2; ++bj)
#pragma unroll
                    for (int n = 0; n < 2; ++n) { const u32x2 g = *(const u32x2*)(SB + off + bj * HALF + n * 16);
                        const f32x4 gv = {bf_lo(g.x), bf_hi(g.x), bf_lo(g.y), bf_hi(g.y)};
                        const f32x4 t = *(const f32x4*)(T + off + bj * HALF + n * 16);
                        const f32x4 v = t + acc[ai][bj][m][n] * gv;
                        u32x2 w; w.x = cvt_pk_bf16(v[0], v[1]); w.y = cvt_pk_bf16(v[2], v[3]);
                        *(u32x2*)(MG + off + bj * HALF + n * 16) = w; } }
    }
};
struct EpiResid {
    static constexpr bool PERM = false, APERM = false, AFTER_DRAIN = false;
    const float* xin; float* xout;
    __device__ __forceinline__ void operator()(const f32x4 (&acc)[2][2][4][2], const Unit& u, int wr, int wc, int fr, int fq) const {
        const int row0 = u.pm * BM + wr * 64 + fr, col0 = u.pn * BM + wc * 32 + 4 * fq;
#pragma unroll
        for (int ai = 0; ai < 2; ++ai)
#pragma unroll
            for (int m = 0; m < 4; ++m) { const size_t off = (size_t)(row0 + ai * HALF + m * 16) * DM + col0;
#pragma unroll
                for (int bj = 0; bj < 2; ++bj)
#pragma unroll
                    for (int n = 0; n < 2; ++n) { const f32x4 b = *(const f32x4*)(xin + off + bj * HALF + n * 16);
                        *(f32x4*)(xout + off + bj * HALF + n * 16) = b + acc[ai][bj][m][n]; } }
    }
};
struct EpiUp1 {
    static constexpr bool PERM = false, APERM = false, AFTER_DRAIN = false;
    const float* ssq; bf16* AR; bf16* BR;
    __device__ __forceinline__ void operator()(const f32x4 (&acc)[2][2][4][2], const Unit& u, int wr, int wc, int fr, int fq) const {
        const int row0 = u.pm * BM + wr * 64 + fr, ch0 = u.pn * HALF + wc * 32 + 4 * fq;
        float inv[2][4]; row_inv8(ssq, row0, fq, inv);
#pragma unroll
        for (int ai = 0; ai < 2; ++ai)
#pragma unroll
            for (int m = 0; m < 4; ++m) { const size_t off = (size_t)(row0 + ai * HALF + m * 16) * DFF + ch0;
#pragma unroll
                for (int bj = 0; bj < 2; ++bj)
#pragma unroll
                    for (int n = 0; n < 2; ++n) { const f32x4 v = acc[ai][bj][m][n] * inv[ai][m];
                        u32x2 w; w.x = cvt_pk_bf16(v[0], v[1]); w.y = cvt_pk_bf16(v[2], v[3]);
                        *(u32x2*)((bj ? BR : AR) + off + n * 16) = w; } }
    }
};
struct EpiResidStats {
    static constexpr bool PERM = false, APERM = false, AFTER_DRAIN = false;
    const float* xin; float* xout; bf16* xb; float* ssq;
    __device__ __forceinline__ void operator()(const f32x4 (&acc)[2][2][4][2], const Unit& u, int wr, int wc, int fr, int fq) const {
        const int row0 = u.pm * BM + wr * 64 + fr, col0 = u.pn * BM + wc * 32 + 4 * fq;
#pragma unroll
        for (int ai = 0; ai < 2; ++ai)
#pragma unroll
            for (int m = 0; m < 4; ++m) { const int row = row0 + ai * HALF + m * 16; const size_t off = (size_t)row * DM + col0; float s = 0.f;
#pragma unroll
                for (int bj = 0; bj < 2; ++bj)
#pragma unroll
                    for (int n = 0; n < 2; ++n) { const f32x4 b = *(const f32x4*)(xin + off + bj * HALF + n * 16); const f32x4 v = b + acc[ai][bj][m][n];
                        *(f32x4*)(xout + off + bj * HALF + n * 16) = v;
                        u32x2 w; w.x = cvt_pk_bf16(v[0], v[1]); w.y = cvt_pk_bf16(v[2], v[3]); *(u32x2*)(xb + off + bj * HALF + n * 16) = w;
                        s += (v[0] * v[0] + v[1] * v[1]) + (v[2] * v[2] + v[3] * v[3]); }
                s += __shfl_xor(s, 16); s += __shfl_xor(s, 32);
                if (fq == 0) ssq[(size_t)row * 32 + u.pn * 4 + wc] = s; }
    }
};
__device__ __forceinline__ float dpp_row_shr1(float old, float src) { return __int_as_float(__builtin_amdgcn_update_dpp(__float_as_int(old), __float_as_int(src), 0x111, 0xf, 0xf, false)); }
struct EpiUpConv {
    static constexpr bool PERM = true, APERM = true, AFTER_DRAIN = false;
    const float* ssq; bf16* G; const float* cw; const float* cb; float* sideA; float* sideH; PG8_LAS float* halo;
    __device__ __forceinline__ void operator()(const f32x4 (&acc)[2][2][4][2], const Unit& u, int wr, int wc, int fr, int fq) const {
        const int tok0 = u.pm * BM + 128 * wr + 8 * fr, ch0 = u.pn * HALF + wc * 32 + 8 * fq;
        float inv[8];
#pragma unroll
        for (int j = 0; j < 8; ++j) { const f32x4* p = (const f32x4*)(ssq + (size_t)(tok0 + j) * 32) + 2 * fq; const f32x4 a = p[0], b = p[1];
            float s = ((a[0] + a[1]) + (a[2] + a[3])) + ((b[0] + b[1]) + (b[2] + b[3])); s += __shfl_xor(s, 16); s += __shfl_xor(s, 32); inv[j] = rsqrtf(s * (1.0f / DM) + RMS_EPS); }
        PG8_LAS float* hp = halo + (wc * 4 + fq) * 16;
        if (wr == 0 && fr == 15) {
#pragma unroll
            for (int n = 0; n < 2; ++n) { const f32x4 a6 = acc[1][0][2][n] * inv[6], a7 = acc[1][0][3][n] * inv[7];
                *(PG8_LAS f32x4*)(hp + n * 8) = (f32x4){a6[0], a7[0], a6[1], a7[1]}; *(PG8_LAS f32x4*)(hp + n * 8 + 4) = (f32x4){a6[2], a7[2], a6[3], a7[3]}; } }
        asm volatile("s_waitcnt lgkmcnt(0)" ::: "memory"); __builtin_amdgcn_s_barrier(); asm volatile("" ::: "memory");
        f32x4 h0[2], h1[2];
#pragma unroll
        for (int n = 0; n < 2; ++n) { h0[n] = (f32x4){0.f, 0.f, 0.f, 0.f}; h1[n] = h0[n]; if (wr == 1) { h0[n] = *(PG8_LAS f32x4*)(hp + n * 8); h1[n] = *(PG8_LAS f32x4*)(hp + n * 8 + 4); } }
        const bool first = (wr == 0 && fr == 0), lastl = (wr == 1 && fr == 15);
        unsigned pk[8][4];
#pragma unroll
        for (int n = 0; n < 2; ++n) {
            const f32x4 w0 = *(const f32x4*)(cw + ch0 + 4 * n), w1 = *(const f32x4*)(cw + DFF + ch0 + 4 * n), w2 = *(const f32x4*)(cw + 2 * DFF + ch0 + 4 * n), cbv = *(const f32x4*)(cb + ch0 + 4 * n);
            float g[8][4];
#pragma unroll
            for (int i = 0; i < 4; ++i) {
                float a[8], b[8];
#pragma unroll
                for (int j = 0; j < 8; ++j) { a[j] = acc[j >> 2][0][j & 3][n][i] * inv[j]; b[j] = acc[j >> 2][1][j & 3][n][i] * inv[j]; }
                const float hm2 = i < 2 ? h0[n][2 * i] : h1[n][2 * (i - 2)], hm1 = i < 2 ? h0[n][2 * i + 1] : h1[n][2 * (i - 2) + 1];
                const float xm1 = dpp_row_shr1(hm1, a[7]), xm2 = dpp_row_shr1(hm2, a[6]);
                g[0][i] = gelu_tanh(cbv[i] + w0[i] * xm2 + w1[i] * xm1 + w2[i] * a[0]) * b[0];
                g[1][i] = gelu_tanh(cbv[i] + w0[i] * xm1 + w1[i] * a[0] + w2[i] * a[1]) * b[1];
#pragma unroll
                for (int j = 2; j < 8; ++j) g[j][i] = gelu_tanh(cbv[i] + w0[i] * a[j - 2] + w1[i] * a[j - 1] + w2[i] * a[j]) * b[j];
                if (lastl) { sideA[((size_t)u.pm * 2 + 0) * DFF + ch0 + 4 * n + i] = a[6]; sideA[((size_t)u.pm * 2 + 1) * DFF + ch0 + 4 * n + i] = a[7]; }
                if (first) { float* sh = sideH + (size_t)u.pm * 4 * DFF + ch0 + 4 * n + i; sh[0] = a[0]; sh[DFF] = a[1]; sh[2 * DFF] = b[0]; sh[3 * DFF] = b[1]; }
            }
#pragma unroll
            for (int j = 0; j < 8; ++j) { pk[j][2 * n] = cvt_pk_bf16(g[j][0], g[j][1]); pk[j][2 * n + 1] = cvt_pk_bf16(g[j][2], g[j][3]); }
        }
#pragma unroll
        for (int j = 0; j < 8; ++j) if (!(first && j < 2)) { u32x4 w; w.x = pk[j][0]; w.y = pk[j][1]; w.z = pk[j][2]; w.w = pk[j][3]; *(u32x4*)(G + (size_t)(tok0 + j) * DFF + ch0) = w; }
    }
};
struct EpiInProj2 {
    static constexpr bool PERM = true, APERM = true, AFTER_DRAIN = false;
    const float* ssq; bf16* R1; float* ssqv;
    __device__ __forceinline__ void operator()(const f32x4 (&acc)[2][2][4][2], const Unit& u, int wr, int wc, int fr, int fq) const {
        const int tok0 = u.pm * BM + 128 * wr + 8 * fr, cq = wc * 32 + 8 * fq;
        float inv[8];
#pragma unroll
        for (int j = 0; j < 8; ++j) { const f32x4* p = (const f32x4*)(ssq + (size_t)(tok0 + j) * 32) + 2 * fq; const f32x4 a = p[0], b = p[1];
            float s = ((a[0] + a[1]) + (a[2] + a[3])) + ((b[0] + b[1]) + (b[2] + b[3])); s += __shfl_xor(s, 16); s += __shfl_xor(s, 32); inv[j] = rsqrtf(s * (1.0f / DM) + RMS_EPS); }
        if (u.pn >= 16 && u.pn < 20) {
            bf16* gvt = R1 + (size_t)4 * MTOK * 1024 + ((size_t)(tok0 >> 7) * SW + (u.pn - 16) * 256 + cq) * SCH + (tok0 & 127);
            float ss[8];
#pragma unroll
            for (int j = 0; j < 8; ++j) ss[j] = 0.f;
#pragma unroll
            for (int bj = 0; bj < 2; ++bj)
#pragma unroll
                for (int n = 0; n < 2; ++n)
#pragma unroll
                    for (int i = 0; i < 4; ++i) { float v[8];
#pragma unroll
                        for (int j = 0; j < 8; ++j) { v[j] = gelu_tanh(acc[j >> 2][bj][j & 3][n][i] * inv[j]); ss[j] += v[j] * v[j]; }
                        u32x4 w; w.x = cvt_pk_bf16(v[0], v[1]); w.y = cvt_pk_bf16(v[2], v[3]); w.z = cvt_pk_bf16(v[4], v[5]); w.w = cvt_pk_bf16(v[6], v[7]);
                        *(u32x4*)(gvt + (size_t)(bj * HALF + 4 * n + i) * SCH) = w; }
#pragma unroll
            for (int j = 0; j < 8; ++j) { float s = ss[j]; s += __shfl_xor(s, 16); s += __shfl_xor(s, 32); if (fq == 0) ssqv[(size_t)(tok0 + j) * 16 + (u.pn - 16) * 4 + wc] = s; }
            return;
        }
        int mode, ld, colb; bf16* base;
        if (u.pn < 16) { const int t = u.pn >> 2; base = R1 + (size_t)t * MTOK * 1024; ld = 1024; colb = (u.pn & 3) * 256; mode = t < 3 ? 0 : 1; }
        else { const int t = (u.pn - 20) >> 3; base = R1 + (size_t)5 * MTOK * 1024 + (size_t)t * MTOK * 2048; ld = 2048; colb = ((u.pn - 20) & 7) * 256; mode = 2; }
#pragma unroll
        for (int j = 0; j < 8; ++j) { bf16* rowp = base + (size_t)(tok0 + j) * ld + colb + cq;
#pragma unroll
            for (int bj = 0; bj < 2; ++bj) { f32x4 v0 = acc[j >> 2][bj][j & 3][0] * inv[j], v1 = acc[j >> 2][bj][j & 3][1] * inv[j];
                if (mode == 1) { v0[0] = gelu_tanh(v0[0]); v0[1] = gelu_tanh(v0[1]); v0[2] = gelu_tanh(v0[2]); v0[3] = gelu_tanh(v0[3]); v1[0] = gelu_tanh(v1[0]); v1[1] = gelu_tanh(v1[1]); v1[2] = gelu_tanh(v1[2]); v1[3] = gelu_tanh(v1[3]); }
                else if (mode == 2) { v0[0] = sigmoid_f(v0[0]); v0[1] = sigmoid_f(v0[1]); v0[2] = sigmoid_f(v0[2]); v0[3] = sigmoid_f(v0[3]); v1[0] = sigmoid_f(v1[0]); v1[1] = sigmoid_f(v1[1]); v1[2] = sigmoid_f(v1[2]); v1[3] = sigmoid_f(v1[3]); }
                u32x4 w; w.x = cvt_pk_bf16(v0[0], v0[1]); w.y = cvt_pk_bf16(v0[2], v0[3]); w.z = cvt_pk_bf16(v1[0], v1[1]); w.w = cvt_pk_bf16(v1[2], v1[3]);
                *(u32x4*)(rowp + bj * HALF) = w; } }
    }
};

template <class Epi, class Sched, bool ALIGN_EPI = false, bool SP2 = false>
__device__ __forceinline__ void gemm_phase(PG8_LAS unsigned char* lds, const Gemm g, const Sched& S, const Epi& E, int tid_in) {
    const int tid = tid_in, wid = __builtin_amdgcn_readfirstlane(tid >> 6), lane = tid & 63, wr = wid >> 2, wc = wid & 3, fr = lane & 15, fq = lane >> 4;
    const int K = g.K, nt = K / BK;
    unsigned voffA[2], voffB[2];
#pragma unroll
    for (int i = 0; i < 2; ++i) { int R, C; stage_rc(tid * 16 + i * 8192, R, C); const int Rb = Epi::PERM ? ((R & ~31) + perm32(R & 31)) : R;
        const int Ra = Epi::APERM ? (128 * ((R >> 6) & 1) + 8 * (R & 15) + ((R >> 4) & 3)) : R; voffA[i] = (unsigned)(Ra * K + C) * 2u; voffB[i] = (unsigned)(Rb * K + C) * 2u; }
    const size_t kstep = (size_t)(BK * 2);
    const size_t hstep = (size_t)HALF * K * 2;
    const size_t tstep = 2 * hstep; const size_t hstepA = Epi::APERM ? (size_t)4 * K * 2 : hstep;
    const unsigned ldsw = (unsigned)wid * 1024u;
    const int aoff = lds_byte(wr * 64 + fr, fq * 8), boff = lds_byte(wc * 32 + fr, fq * 8);
#define PG8_SA(b, h) (((b) * 2 + (h)) * HTB)
#define PG8_SB(b, h) ((4 + (b) * 2 + (h)) * HTB)
#define PG8_STAGE(bufoff, gbase, voff) do { _Pragma("unroll") for (int _i = 0; _i < 2; ++_i) \
        __builtin_amdgcn_global_load_lds((const unsigned*)((const char*)(gbase) + (voff)[_i]), (PG8_LAS unsigned*)(lds + (bufoff) + ldsw + _i * 8192), 16, 0, 0); } while (0)
#define PG8_LDA(dst, b, h) do { _Pragma("unroll") for (int m = 0; m < 4; ++m) _Pragma("unroll") for (int k = 0; k < 2; ++k) dst[m][k] = *(const PG8_LAS bf16x8*)(lds + PG8_SA(b, h) + aoff + m * 2048 + k * 1024); } while (0)
#define PG8_LDB(dst, b, h) do { _Pragma("unroll") for (int n = 0; n < 2; ++n) _Pragma("unroll") for (int k = 0; k < 2; ++k) dst[n][k] = *(const PG8_LAS bf16x8*)(lds + PG8_SB(b, h) + boff + n * 2048 + k * 1024); } while (0)
#define PG8_MMA(ai, bj, At, Bt) do { __builtin_amdgcn_s_setprio(1); _Pragma("unroll") for (int m = 0; m < 4; ++m) _Pragma("unroll") for (int n = 0; n < 2; ++n) _Pragma("unroll") for (int k = 0; k < 2; ++k) \
        acc[ai][bj][m][n] = __builtin_amdgcn_mfma_f32_16x16x32_bf16(Bt[n][k], At[m][k], acc[ai][bj][m][n], 0, 0, 0); __builtin_amdgcn_s_setprio(0); } while (0)
#define PG8_WAIT_V(n) asm volatile("s_waitcnt vmcnt(" #n ")" ::: "memory")
#define PG8_WAIT_L(n) asm volatile("s_waitcnt lgkmcnt(" #n ")" ::: "memory")
#define PG8_BAR __builtin_amdgcn_s_barrier()
#define PG8_SCHED __builtin_amdgcn_sched_barrier(0)
    Unit cur, nxt; int ui = 0;
    if (!S.next(0, cur)) return;
    f32x4 acc[2][2][4][2];
#pragma unroll
    for (int a = 0; a < 2; ++a)
#pragma unroll
        for (int b = 0; b < 2; ++b)
#pragma unroll
            for (int m = 0; m < 4; ++m)
#pragma unroll
                for (int n = 0; n < 2; ++n) acc[a][b][m][n] = (f32x4){0.f, 0.f, 0.f, 0.f};
    bf16x8 At[4][2], B0[2][2], B1[2][2];
    const char* cA = (const char*)g.A + (size_t)cur.pm * tstep; const char* cB = (const char*)g.Bt + (size_t)cur.pn * tstep;
    S.a_ready(cur);
    if constexpr (SP2) {
        PG8_STAGE(PG8_SB(0, 0), cB, voffB); PG8_STAGE(PG8_SB(0, 1), cB + hstep, voffB); PG8_STAGE(PG8_SA(0, 0), cA, voffA); PG8_STAGE(PG8_SA(0, 1), cA + hstepA, voffA);
        if (wr == 1) PG8_BAR;
        PG8_WAIT_V(2); PG8_BAR;
        PG8_STAGE(PG8_SB(1, 0), cB + kstep, voffB); PG8_STAGE(PG8_SA(1, 0), cA + kstep, voffA); PG8_STAGE(PG8_SB(1, 1), cB + hstep + kstep, voffB);
        PG8_WAIT_V(6); PG8_BAR;
    } else {
        PG8_STAGE(PG8_SB(0, 0), cB, voffB); PG8_STAGE(PG8_SA(0, 0), cA, voffA); PG8_STAGE(PG8_SB(0, 1), cB + hstep, voffB); PG8_STAGE(PG8_SA(0, 1), cA + hstepA, voffA);
        if (wr == 1) PG8_BAR;
        PG8_WAIT_V(4); PG8_BAR;
        PG8_STAGE(PG8_SB(1, 0), cB + kstep, voffB); PG8_STAGE(PG8_SA(1, 0), cA + kstep, voffA); PG8_STAGE(PG8_SB(1, 1), cB + hstep + kstep, voffB);
        PG8_WAIT_V(6); PG8_BAR;
    }
    for (;;) {
        const bool has_next = S.next(ui + 1, nxt);
        const char* nA = has_next ? (const char*)g.A + (size_t)nxt.pm * tstep : cA; const char* nB = has_next ? (const char*)g.Bt + (size_t)nxt.pn * tstep : cB;
        for (int t = 0; t < nt; t += 2) {
            const bool last = (t == nt - 2);
            const char* a1 = cA + (size_t)(t + 1) * kstep;
            const char* a2 = last ? nA : cA + (size_t)(t + 2) * kstep; const char* b2 = last ? nB : cB + (size_t)(t + 2) * kstep;
            const char* a3 = a2 + kstep; const char* b3 = b2 + kstep;
            if (last && has_next) S.a_ready(nxt);
            if constexpr (SP2) {
            PG8_LDB(B0, 0, 0); PG8_LDB(B1, 0, 1); PG8_SCHED; PG8_LDA(At, 0, 0); PG8_STAGE(PG8_SA(1, 1), a1 + hstepA, voffA);
            PG8_WAIT_V(8); PG8_WAIT_L(0); PG8_BAR; PG8_MMA(0, 0, At, B0); PG8_MMA(0, 1, At, B1); PG8_BAR; PG8_SCHED;
            PG8_LDA(At, 0, 1); PG8_STAGE(PG8_SB(0, 0), b2, voffB); PG8_STAGE(PG8_SB(0, 1), b2 + hstep, voffB); PG8_STAGE(PG8_SA(0, 0), a2, voffA);
            PG8_WAIT_V(8); PG8_WAIT_L(0); PG8_BAR; PG8_MMA(1, 0, At, B0); PG8_MMA(1, 1, At, B1); PG8_BAR; PG8_SCHED;
            PG8_LDB(B0, 1, 0); PG8_LDB(B1, 1, 1); PG8_SCHED; PG8_LDA(At, 1, 0); PG8_STAGE(PG8_SA(0, 1), a2 + hstepA, voffA);
            PG8_WAIT_V(8); PG8_WAIT_L(0); PG8_BAR; PG8_MMA(0, 0, At, B0); PG8_MMA(0, 1, At, B1); PG8_BAR; PG8_SCHED;
            PG8_LDA(At, 1, 1); PG8_STAGE(PG8_SB(1, 0), b3, voffB); PG8_STAGE(PG8_SB(1, 1), b3 + hstep, voffB); PG8_STAGE(PG8_SA(1, 0), a3, voffA);
            PG8_WAIT_V(8); PG8_WAIT_L(0); PG8_BAR; PG8_MMA(1, 0, At, B0); PG8_MMA(1, 1, At, B1); PG8_BAR; PG8_SCHED;
            } else {
            PG8_LDB(B0, 0, 0); PG8_SCHED; PG8_LDA(At, 0, 0); PG8_STAGE(PG8_SA(1, 1), a1 + hstepA, voffA);
            PG8_WAIT_L(8); PG8_BAR; PG8_WAIT_L(0); PG8_MMA(0, 0, At, B0); PG8_BAR; PG8_SCHED;
            PG8_LDB(B1, 0, 1); PG8_STAGE(PG8_SB(0, 0), b2, voffB);
            PG8_BAR; PG8_WAIT_L(0); PG8_MMA(0, 1, At, B1); PG8_BAR;
            PG8_LDA(At, 0, 1); PG8_STAGE(PG8_SA(0, 0), a2, voffA);
            PG8_BAR; PG8_WAIT_L(0); PG8_MMA(1, 0, At, B0); PG8_BAR; PG8_SCHED;
            PG8_STAGE(PG8_SB(0, 1), b2 + hstep, voffB);
            PG8_WAIT_V(6); PG8_BAR; PG8_MMA(1, 1, At, B1); PG8_BAR;
            PG8_LDB(B0, 1, 0); PG8_SCHED; PG8_LDA(At, 1, 0); PG8_STAGE(PG8_SA(0, 1), a2 + hstepA, voffA);
            PG8_WAIT_L(8); PG8_BAR; PG8_WAIT_L(0); PG8_MMA(0, 0, At, B0); PG8_BAR; PG8_SCHED;
            PG8_LDB(B1, 1, 1); PG8_STAGE(PG8_SB(1, 0), b3, voffB);
            PG8_BAR; PG8_WAIT_L(0); PG8_MMA(0, 1, At, B1); PG8_BAR;
            PG8_LDA(At, 1, 1); PG8_STAGE(PG8_SA(1, 0), a3, voffA);
            PG8_BAR; PG8_WAIT_L(0); PG8_MMA(1, 0, At, B0); PG8_BAR; PG8_SCHED;
            PG8_STAGE(PG8_SB(1, 1), b3 + hstep, voffB);
            PG8_WAIT_V(6); PG8_BAR; PG8_MMA(1, 1, At, B1); PG8_BAR;
            }
        }
        if constexpr (ALIGN_EPI) { if (wr == 0) PG8_BAR; }
        if constexpr (!Epi::AFTER_DRAIN) { E(acc, cur, wr, wc, fr, fq); S.done(cur); }
        if (!has_next) break;
#pragma unroll
        for (int a = 0; a < 2; ++a)
#pragma unroll
            for (int b = 0; b < 2; ++b)
#pragma unroll
                for (int m = 0; m < 4; ++m)
#pragma unroll
                    for (int n = 0; n < 2; ++n) acc[a][b][m][n] = (f32x4){0.f, 0.f, 0.f, 0.f};
        cur = nxt; cA = nA; cB = nB; ++ui;
        if constexpr (ALIGN_EPI) { if (wr == 1) PG8_BAR; }
    }
    PG8_WAIT_V(0);
    if constexpr (!ALIGN_EPI) { if (wr == 0) PG8_BAR; }
    PG8_BAR;
    if constexpr (Epi::AFTER_DRAIN) { E.fused(acc, cur, wr, wc, fr, fq, lds, wid, lane); S.done(cur); }
#undef PG8_SA
#undef PG8_SB
#undef PG8_STAGE
#undef PG8_LDA
#undef PG8_LDB
#undef PG8_MMA
#undef PG8_WAIT_V
#undef PG8_WAIT_L
#undef PG8_BAR
#undef PG8_SCHED
}
}

namespace fa {
constexpr int D = 128, LDQ = 1024, NW = 8, QBLK = 32, KVBLK = 64, QB = NW * QBLK;
constexpr int SHM_V = KVBLK * D * 2, SHM_K = KVBLK * D * 2;
constexpr int LDS_ATT = 2 * SHM_V + 2 * SHM_K + NW * 64 * 4;
constexpr int TAB_OFF = 69632;
constexpr float SCALE = 0.08838834764831845f, THR = 8.f;
constexpr bool WSKIP = false;
typedef short bf16x8 __attribute__((ext_vector_type(8)));
typedef short s16x4 __attribute__((ext_vector_type(4)));
typedef float f32x16 __attribute__((ext_vector_type(16)));
typedef float f32x4 __attribute__((ext_vector_type(4)));
typedef unsigned u32x4 __attribute__((ext_vector_type(4)));
template <class A, class Bt> struct same_t { static constexpr bool v = false; };
template <class A> struct same_t<A, A> { static constexpr bool v = true; };

#define KSWZ(row, colB) ((row) * 256 + ((colB) ^ (((row) & 7) << 4)))
#define SBAR() __builtin_amdgcn_sched_barrier(0)
__device__ __forceinline__ int v_st(int k, int c) { const int kk = (k & ~0xC) | ((k & 4) << 1) | ((k & 8) >> 1); return ((kk >> 3) * 4 + (c >> 5)) * 512 + ((kk & 7) * 32 + (c & 31)) * 2; }
__device__ __forceinline__ int v_rd_base(int lane) { return ((lane & 3) << 3) | (((lane >> 2) & 3) << 6) | (((lane >> 4) & 1) << 5) | (((lane >> 5) & 1) << 8); }
constexpr int v_rd_off(int d0, int ks, int half) { return d0 * 512 + ks * 4096 + half * 2048; }
__device__ __forceinline__ int crow(int r, int hi) { return (r & 3) + 8 * (r >> 2) + 4 * hi; }
__device__ __forceinline__ unsigned cvtpk(float lo, float hi) {
    unsigned r; asm volatile("v_cvt_pk_bf16_f32 %0, %1, %2" : "=v"(r) : "v"(lo), "v"(hi)); return r;
}
__device__ __forceinline__ bf16x8 pack8(f32x4 a, f32x4 b) {
    u32x4 w = {cvtpk(a[0], a[1]), cvtpk(a[2], a[3]), cvtpk(b[0], b[1]), cvtpk(b[2], b[3])};
    return *reinterpret_cast<bf16x8*>(&w);
}
template <class T> __device__ __forceinline__ bf16x8 load8(const T* p) {
    if constexpr (same_t<T, float>::v) { return pack8(*(const f32x4*)p, *(const f32x4*)(p + 4)); }
    else { return *reinterpret_cast<const bf16x8*>(p); }
}
__device__ __forceinline__ void mask_tile(f32x16& p0, f32x16& p1, int dq, unsigned W) {
    const float NEG = -__builtin_inff();
#pragma unroll
    for (int r = 0; r < 16; ++r) {
        const int c = (r & 3) + 8 * (r >> 2);
        if ((unsigned)(dq - c) >= W) p0[r] = NEG;
        if ((unsigned)(dq - c - 32) >= W) p1[r] = NEG;
    }
}
__device__ __forceinline__ void partialSM(f32x16& p0, f32x16& p1, float& m_reg, float& mn, float& alpha) {
    float pmax = p0[0]; for (int r = 1; r < 16; ++r) pmax = fmaxf(pmax, p0[r]); for (int r = 0; r < 16; ++r) pmax = fmaxf(pmax, p1[r]);
    { auto rr = __builtin_amdgcn_permlane32_swap(__float_as_uint(pmax), __float_as_uint(pmax), false, false);
      pmax = fmaxf(__uint_as_float(rr[0]), __uint_as_float(rr[1])); }
    constexpr float C2 = 1.4426950408889634f * SCALE;
    if (__builtin_expect(__all((pmax - m_reg) * SCALE <= THR), 1)) { mn = m_reg; alpha = 1.f; }
    else { mn = fmaxf(m_reg, pmax); alpha = __builtin_amdgcn_exp2f((m_reg - mn) * C2); m_reg = mn; }
    const float mnL = -mn * C2;
    for (int r = 0; r < 16; ++r) p0[r] = fmaf(p0[r], C2, mnL); for (int r = 0; r < 16; ++r) p1[r] = fmaf(p1[r], C2, mnL);
    for (int r = 0; r < 16; ++r) p0[r] = __builtin_amdgcn_exp2f(p0[r]);
}
__device__ __forceinline__ void finishSM(f32x16& p0, f32x16& p1, float alpha, float& l_reg, bf16x8& pa0, bf16x8& pa1, bf16x8& pa2, bf16x8& pa3) {
    for (int r = 0; r < 16; ++r) p1[r] = __builtin_amdgcn_exp2f(p1[r]);
    float ps = 0; for (int r = 0; r < 16; ++r) ps += p0[r]; for (int r = 0; r < 16; ++r) ps += p1[r];
    { auto rr = __builtin_amdgcn_permlane32_swap(__float_as_uint(ps), __float_as_uint(ps), false, false);
      ps = __uint_as_float(rr[0]) + __uint_as_float(rr[1]); }
    l_reg = l_reg * alpha + ps;
#define PK4(P, B_, OUT) do { unsigned a0 = cvtpk(P[B_+0], P[B_+1]), a1 = cvtpk(P[B_+2], P[B_+3]);                          \
        unsigned b0 = cvtpk(P[B_+4], P[B_+5]), b1 = cvtpk(P[B_+6], P[B_+7]);                                             \
        auto r0 = __builtin_amdgcn_permlane32_swap(a0, b0, false, false); auto r1 = __builtin_amdgcn_permlane32_swap(a1, b1, false, false); \
        u32x4 w = {r0[0], r1[0], r0[1], r1[1]}; OUT = *reinterpret_cast<bf16x8*>(&w); } while (0)
    PK4(p0, 0, pa0); PK4(p0, 8, pa1); PK4(p1, 0, pa2); PK4(p1, 8, pa3);
#undef PK4
}
template <int KB, bool SK>
__device__ __forceinline__ void qkt(f32x16& p0, f32x16& p1, const char* K_lds, int r32, int hi, const bf16x8* qr, bool act, const __attribute__((address_space(3))) float* tb) {
    if (SK && !act) { const float NEG = -__builtin_inff();
#pragma unroll
        for (int r = 0; r < 16; ++r) { p0[r] = NEG; p1[r] = NEG; } return; }
#pragma unroll
    for (int j_ = 0; j_ < 4; ++j_) { const f32x4 b0_ = *(const __attribute__((address_space(3))) f32x4*)(tb + 8 * j_), b1_ = *(const __attribute__((address_space(3))) f32x4*)(tb + 32 + 8 * j_);
        p0[4 * j_] = b0_[0]; p0[4 * j_ + 1] = b0_[1]; p0[4 * j_ + 2] = b0_[2]; p0[4 * j_ + 3] = b0_[3]; p1[4 * j_] = b1_[0]; p1[4 * j_ + 1] = b1_[1]; p1[4 * j_ + 2] = b1_[2]; p1[4 * j_ + 3] = b1_[3]; }
    const char* kb[4];
#pragma unroll
    for (int dd = 0; dd < 4; ++dd) kb[dd] = K_lds + KB * SHM_K + KSWZ(r32, (dd * 16 + hi * 8) * 2);
#pragma unroll
    for (int d0 = 0; d0 < 8; ++d0) { const char* a = kb[d0 & 3] + (d0 >> 2) * 128;
        bf16x8 b0 = *reinterpret_cast<const bf16x8*>(a);
        bf16x8 b1 = *reinterpret_cast<const bf16x8*>(a + 32 * 256);
        p0 = __builtin_amdgcn_mfma_f32_32x32x16_bf16(b0, qr[d0], p0, 0, 0, 0);
        p1 = __builtin_amdgcn_mfma_f32_32x32x16_bf16(b1, qr[d0], p1, 0, 0, 0); }
}
template <int VB, bool SK>
__device__ __forceinline__ void pv_tile(f32x16* o, int vb0, bf16x8 pa0, bf16x8 pa1, bf16x8 pa2, bf16x8 pa3, bool act) {
    if (SK && !act) return;
#define TRRD(dst, off) asm volatile("ds_read_b64_tr_b16 %0, %1 offset:%2" : "=&v"(dst) : "v"(vb0), "i"(off) : "memory")
#define PV_D0(d0) do { s16x4 l0, l1, l2, l3, h0, h1, h2, h3; constexpr int b_ = VB * SHM_V + v_rd_off(d0, 0, 0);     \
        TRRD(l0, b_); TRRD(h0, b_ + 2048); TRRD(l1, b_ + 4096); TRRD(h1, b_ + 6144); TRRD(l2, b_ + 8192); TRRD(h2, b_ + 10240); TRRD(l3, b_ + 12288); TRRD(h3, b_ + 14336); \
        asm volatile("s_waitcnt lgkmcnt(0)" ::: "memory"); SBAR();                 \
        o[d0] = __builtin_amdgcn_mfma_f32_32x32x16_bf16(pa0, (bf16x8){l0[0], l0[1], l0[2], l0[3], h0[0], h0[1], h0[2], h0[3]}, o[d0], 0, 0, 0);   \
        o[d0] = __builtin_amdgcn_mfma_f32_32x32x16_bf16(pa1, (bf16x8){l1[0], l1[1], l1[2], l1[3], h1[0], h1[1], h1[2], h1[3]}, o[d0], 0, 0, 0);   \
        o[d0] = __builtin_amdgcn_mfma_f32_32x32x16_bf16(pa2, (bf16x8){l2[0], l2[1], l2[2], l2[3], h2[0], h2[1], h2[2], h2[3]}, o[d0], 0, 0, 0);   \
        o[d0] = __builtin_amdgcn_mfma_f32_32x32x16_bf16(pa3, (bf16x8){l3[0], l3[1], l3[2], l3[3], h3[0], h3[1], h3[2], h3[3]}, o[d0], 0, 0, 0); } while (0)
    PV_D0(0); PV_D0(1); PV_D0(2); PV_D0(3);
#undef PV_D0
#undef TRRD
}
template <class TIn, class TOut> struct BlockRef { const TIn* Q; const TIn* K; const TIn* V; TOut* O; int P0; };
template <class TIn> struct Seam {
    bf16x8 qr[8];
    bf16x8 st_v0, st_v1, st_k0, st_k1; f32x4 sf0, sf1, sf2, sf3;
    f32x4 tq[16];
};
__device__ __forceinline__ int swa_jlo(int P0, int W) { const int lowk = P0 - W + 1; return lowk > 0 ? lowk / KVBLK : 0; }
#define ROW(p, k0, rr) ((p) + (unsigned)(((k0) + (rr)) * LDQ + sc))
#define VMW() asm volatile("s_waitcnt vmcnt(0)" ::: "memory")
#define VMWN(n) asm volatile("s_waitcnt vmcnt(%0)" :: "i"(n) : "memory")
#define SLOAD_H(Kp, Vp, k0) do { S.st_v0 = load8<TIn>(ROW(Vp, k0, sr)); S.st_v1 = load8<TIn>(ROW(Vp, k0, 32 + sr));              \
                         S.st_k0 = load8<TIn>(ROW(Kp, k0, sr)); S.st_k1 = load8<TIn>(ROW(Kp, k0, 32 + sr)); } while (0)
#define SWRITE_HK(bf) do { *(bf16x8*)(K_lds + (bf) * SHM_K + kws) = S.st_k0; *(bf16x8*)(K_lds + (bf) * SHM_K + kws + 32 * 256) = S.st_k1; } while (0)
#define SWRITE_HV(bf) do { *(bf16x8*)(V_lds + (bf) * SHM_V + vst0) = S.st_v0; *(bf16x8*)(V_lds + (bf) * SHM_V + vst1) = S.st_v1; } while (0)
#define SWRITE_H(bf) do { SWRITE_HV(bf); SWRITE_HK(bf); } while (0)
#define SLOAD_F(p, k0) do { S.sf0 = *(const f32x4*)ROW(p, k0, sr); S.sf1 = *(const f32x4*)(ROW(p, k0, sr) + 4);                \
                            S.sf2 = *(const f32x4*)ROW(p, k0, 32 + sr); S.sf3 = *(const f32x4*)(ROW(p, k0, 32 + sr) + 4); } while (0)
#define SWRITE_KF(bf) do { *(bf16x8*)(K_lds + (bf) * SHM_K + kws) = pack8(S.sf0, S.sf1); *(bf16x8*)(K_lds + (bf) * SHM_K + kws + 32 * 256) = pack8(S.sf2, S.sf3); } while (0)
#define SWRITE_VF(bf) do { *(bf16x8*)(V_lds + (bf) * SHM_V + vst0) = pack8(S.sf0, S.sf1); *(bf16x8*)(V_lds + (bf) * SHM_V + vst1) = pack8(S.sf2, S.sf3); } while (0)
template <class TIn, class TOut>
__device__ __forceinline__ void causal_swa_prime(const BlockRef<TIn, TOut>& cur, int W, char* lds, Seam<TIn>& S, int tid_in) {
    constexpr bool F32 = same_t<TIn, float>::v;
    const int tid = tid_in, wid = __builtin_amdgcn_readfirstlane(tid >> 6), lane = tid & 63, r32 = lane & 31, hi = lane >> 5;
    const int sr = tid >> 4, sc = (tid & 15) * 8, kws = KSWZ(sr, sc * 2); char* K_lds = lds + 2 * SHM_V;
    const int kb0 = swa_jlo(cur.P0, W) * KVBLK;
    for (int d0 = 0; d0 < 8; ++d0) S.qr[d0] = load8<TIn>(cur.Q + (unsigned)((wid * QBLK + r32) * LDQ + d0 * 16 + hi * 8));
    if constexpr (F32) { SLOAD_F((const float*)cur.K, kb0); VMW(); SWRITE_KF(0); SBAR(); SLOAD_F((const float*)cur.V, kb0); }
    else { SLOAD_H(cur.K, cur.V, kb0); VMW(); SWRITE_HK(0); }
    __syncthreads();
}
template <class TIn, class TOut>
__device__ __forceinline__ void causal_swa_block(const BlockRef<TIn, TOut>& cur, const BlockRef<TIn, TOut>& nxt, int skv, int W, char* lds, Seam<TIn>& S, int tid_in) {
    constexpr bool F32 = same_t<TIn, float>::v;
    const int tid = tid_in, wid = __builtin_amdgcn_readfirstlane(tid >> 6), lane = tid & 63, r32 = lane & 31, hi = lane >> 5;
    const int j_lo = swa_jlo(cur.P0, W);
    int j_hi = (cur.P0 + QB - 1) / KVBLK + 1; if (j_hi > skv / KVBLK) j_hi = skv / KVBLK;
    const int NT = j_hi - j_lo;
    const int kbn = swa_jlo(nxt.P0, W) * KVBLK;
    const int qlo = cur.P0 + wid * QBLK, qm = qlo + r32 - 4 * hi;
    char* V_lds = lds; char* K_lds = lds + 2 * SHM_V;
    float* ws = (float*)(lds + 2 * SHM_V + 2 * SHM_K) + wid * 64; float* li_l = ws, * al_l = ws + 32;
    float m_reg = -1e30f, l_reg = 0; f32x16 o[4] = {};
    const int sr = tid >> 4, sc = (tid & 15) * 8, vst0 = v_st(sr, sc), vst1 = v_st(32 + sr, sc), kws = KSWZ(sr, sc * 2);
    const int vb0 = (int)(uintptr_t)V_lds + v_rd_base(lane);
    const TIn* Kh = cur.K; const TIn* Vh = cur.V;
#define RESC(a) do { if (__any((a) < 1.f)) { if (hi == 0) al_l[r32] = (a); asm volatile("s_waitcnt lgkmcnt(0)" ::: "memory");              \
                     for (int d_ = 0; d_ < 4; ++d_) for (int r = 0; r < 16; ++r) o[d_][r] *= al_l[crow(r, hi)]; } } while (0)
#define KBASE(t) ((j_lo + (t)) * KVBLK)
    const __attribute__((address_space(3))) float* tabh = (const __attribute__((address_space(3))) float*)(lds + TAB_OFF) + 4 * hi;
#define BIAS(P0_, P1_, t) do { const __attribute__((address_space(3))) float* tb_ = tabh + KBASE(t); _Pragma("unroll") for (int j_ = 0; j_ < 4; ++j_) { const f32x4 b0_ = *(const __attribute__((address_space(3))) f32x4*)(tb_ + 8 * j_), b1_ = *(const __attribute__((address_space(3))) f32x4*)(tb_ + 32 + 8 * j_); \
        P0_[4 * j_] += b0_[0]; P0_[4 * j_ + 1] += b0_[1]; P0_[4 * j_ + 2] += b0_[2]; P0_[4 * j_ + 3] += b0_[3]; P1_[4 * j_] += b1_[0]; P1_[4 * j_ + 1] += b1_[1]; P1_[4 * j_ + 2] += b1_[2]; P1_[4 * j_ + 3] += b1_[3]; } } while (0)
#define ACT(t) (KBASE(t) <= qlo + QBLK - 1 && KBASE(t) + KVBLK - 1 >= qlo - W + 1)
#define MASKT(P0_, P1_, t) do { const int kb_ = KBASE(t); if ((!SK || ACT(t)) && (kb_ + KVBLK - 1 > qlo || kb_ <= qlo + QBLK - 1 - W)) mask_tile(P0_, P1_, qm - kb_, (unsigned)W); } while (0)
    constexpr int NQL = F32 ? 16 : 8;
    constexpr bool SK = WSKIP && !F32;
#define SEAM_K0() do { VMWN(NQL); if constexpr (F32) { SWRITE_KF(0); SBAR(); SLOAD_F((const float*)nxt.V, kbn); } else { SWRITE_HK(0); } SBAR(); } while (0)
    f32x16 pA0, pA1, pB0, pB1; float mnA, mnB, alA, alB; bf16x8 pa0, pa1, pa2, pa3;
    if constexpr (F32) { VMW(); SWRITE_VF(0); SBAR(); } else { SWRITE_HV(0); SBAR(); }
    if (NT > 1) { if constexpr (F32) SLOAD_F((const float*)Kh, KBASE(1)); else SLOAD_H(Kh, Vh, KBASE(1)); }
    SBAR(); qkt<0, SK>(pA0, pA1, K_lds, r32, hi, S.qr, ACT(0), tabh + KBASE(0));
    if constexpr (F32) { if (NT > 1) { VMW(); SWRITE_KF(1); SBAR(); SLOAD_F((const float*)Vh, KBASE(1)); } }
    MASKT(pA0, pA1, 0); partialSM(pA0, pA1, m_reg, mnA, alA);
    if (NT > 1) { VMW(); if constexpr (F32) { SWRITE_VF(1); SBAR(); if (NT > 2) SLOAD_F((const float*)Kh, KBASE(2)); } else SWRITE_H(1); }
    __syncthreads();
#define HALF_STEP(PX0, PX1, mnX, alX, PY0, PY1, alY, t, KB, VB, SB) do {                                                      \
        SBAR(); qkt<KB, SK>(PX0, PX1, K_lds, r32, hi, S.qr, ACT(t), tabh + KBASE(t));                                             \
        finishSM(PY0, PY1, alY, l_reg, pa0, pa1, pa2, pa3); SBAR();                                                           \
        if ((t) + 1 < NT) { if constexpr (F32) { VMW(); SWRITE_KF(SB); SBAR(); SLOAD_F((const float*)Vh, KBASE((t) + 1)); }  \
                            else { SLOAD_H(Kh, Vh, KBASE((t) + 1)); } SBAR(); }                                               \
        pv_tile<VB, SK>(o, vb0, pa0, pa1, pa2, pa3, ACT((t) - 1)); MASKT(PX0, PX1, (t)); partialSM(PX0, PX1, m_reg, mnX, alX);                                        \
        __syncthreads();                                                                                                      \
        if ((t) + 1 < NT) { VMW(); if constexpr (F32) { SWRITE_VF(SB); SBAR(); if ((t) + 2 < NT) SLOAD_F((const float*)Kh, KBASE((t) + 2)); } \
                            else { SWRITE_H(SB); } }                                                                          \
        RESC(alX); __syncthreads(); } while (0)
    for (int t = 1; t + 1 < NT; t += 2) {
        HALF_STEP(pB0, pB1, mnB, alB, pA0, pA1, alA, t, 1, 0, 0);
        HALF_STEP(pA0, pA1, mnA, alA, pB0, pB1, alB, t + 1, 0, 1, 1);
    }
    const bool even = (NT & 1) == 0;
    if (even) { SBAR(); qkt<1, SK>(pB0, pB1, K_lds, r32, hi, S.qr, ACT(NT - 1), tabh + KBASE(NT - 1)); SBAR(); }
#define QROW(e) (nxt.Q + (size_t)(wid * QBLK + r32) * LDQ + ((e) >> 1) * 16 + hi * 8 + ((e) & 1) * 4)
    if constexpr (F32) { SLOAD_F((const float*)nxt.K, kbn); SBAR();
#pragma unroll
        for (int e = 0; e < 8; ++e) S.tq[e] = *(const f32x4*)QROW(e); }
    else { SLOAD_H(nxt.K, nxt.V, kbn); SBAR();
#pragma unroll
        for (int d0 = 0; d0 < 8; ++d0) S.qr[d0] = load8<TIn>(nxt.Q + (unsigned)((wid * QBLK + r32) * LDQ + d0 * 16 + hi * 8)); }
    SBAR();
    finishSM(pA0, pA1, alA, l_reg, pa0, pa1, pa2, pa3); SBAR();
    if constexpr (F32) {
#pragma unroll
        for (int e = 8; e < 16; ++e) S.tq[e] = *(const f32x4*)QROW(e); SBAR(); }
#undef QROW
    pv_tile<0, SK>(o, vb0, pa0, pa1, pa2, pa3, ACT(even ? NT - 2 : NT - 1));
    if (even) { MASKT(pB0, pB1, NT - 1); partialSM(pB0, pB1, m_reg, mnB, alB); __syncthreads(); RESC(alB);
        finishSM(pB0, pB1, alB, l_reg, pa0, pa1, pa2, pa3); SBAR(); pv_tile<1, SK>(o, vb0, pa0, pa1, pa2, pa3, ACT(NT - 1)); }
    SBAR(); SEAM_K0();
    if (hi == 0) li_l[r32] = l_reg; asm volatile("s_waitcnt lgkmcnt(0)" ::: "memory");
    float rli[16];
#pragma unroll
    for (int r = 0; r < 16; ++r) rli[r] = __builtin_amdgcn_rcpf(li_l[crow(r, hi)]);
    TOut* Ow = cur.O + (unsigned)((wid * QBLK) * LDQ);
#pragma unroll
    for (int r = 0; r < 16; ++r) { const int orow = crow(r, hi);
#pragma unroll
        for (int d0 = 0; d0 < 4; ++d0) { const float v = o[d0][r] * rli[r];
            if constexpr (same_t<TOut, float>::v) { Ow[(size_t)orow * LDQ + d0 * 32 + r32] = v; }
            else { const float vn = __shfl_xor(v, 1);
                   if ((r32 & 1) == 0) *(unsigned*)(Ow + (unsigned)(orow * LDQ + d0 * 32 + r32)) = cvtpk(v, vn); } } }
    if constexpr (F32) {
#pragma unroll
        for (int d0 = 0; d0 < 8; ++d0) S.qr[d0] = pack8(S.tq[2 * d0], S.tq[2 * d0 + 1]); }
    __syncthreads();
#undef RESC
#undef KBASE
#undef BIAS
#undef ACT
#undef MASKT
#undef SEAM_K0
#undef HALF_STEP
}
#undef ROW
#undef VMW
#undef VMWN
#undef SLOAD_H
#undef SWRITE_HK
#undef SWRITE_HV
#undef SWRITE_H
#undef SLOAD_F
#undef SWRITE_KF
#undef SWRITE_VF


}

constexpr size_t MiB = (size_t)1 << 20;
constexpr size_t WS_CTL = 0, CTL_ZERO_BYTES = 1 * MiB;
constexpr size_t WS_WF = 1 * MiB;
constexpr size_t WS_SSQ = 2 * MiB;
constexpr size_t WS_CL = 4 * MiB;
constexpr size_t WS_TOT = 5 * MiB;
constexpr size_t WS_SSQV = 6 * MiB;
constexpr size_t WS_WTRIL = 7 * MiB;
constexpr size_t WS_W = 8 * MiB, W_LAYER = 118 * MiB;
constexpr size_t W_IN = 0, W_A = 36 * MiB, W_B = 40 * MiB, W_OUT = 44 * MiB, W_UP = 52 * MiB, W_DOWN = 96 * MiB;
constexpr size_t WS_X = 480 * MiB;
constexpr size_t WS_XB = 608 * MiB;
constexpr size_t WS_R1 = 672 * MiB;
constexpr size_t WS_YA = 960 * MiB, WS_YB = 992 * MiB, WS_MG = 1024 * MiB;
constexpr size_t WS_G = 1088 * MiB;
constexpr size_t WS_SIDEA = WS_R1, WS_SIDEH = WS_R1 + 4 * MiB;
constexpr size_t WS_END = 1264 * MiB;
constexpr int CW_BAR = 4096;

constexpr int LDS_BYTES = 160 * 1024;
constexpr int MISC_OFF = LDS_BYTES - 256, ARGS_OFF = LDS_BYTES - 512, HALO_OFF = 131072;

#define XB_TMO      128
#define XB_XCNT(j)  (256  + 64 * (j))
#define XB_XSUB(j)  (1280 + 64 * (j))
#define XB_XGEN(j)  (2304 + 64 * (j))
#define XB_TOP      3328
#define XB_TOPGEN   3392
#define XCD_BAR_WORDS 3456
#define XB_SPIN_CAP (1u << 18)

__device__ __forceinline__ unsigned xb_ld(unsigned* p)              { return __hip_atomic_load(p, __ATOMIC_RELAXED, __HIP_MEMORY_SCOPE_AGENT); }
__device__ __forceinline__ unsigned xb_add(unsigned* p, unsigned v) { return __hip_atomic_fetch_add(p, v, __ATOMIC_RELAXED, __HIP_MEMORY_SCOPE_AGENT); }
__device__ __forceinline__ unsigned xb_xcc_id() { return (unsigned)__builtin_amdgcn_s_getreg((3 << 11) | 20) & 0xFu; }
#define XB_SPIN(cond, bar) do { unsigned _sp = 0; while (cond) { __builtin_amdgcn_s_sleep(1); \
    if ((++_sp & 255u) == 0u) { if (xb_ld(&(bar)[XB_TMO])) break; if (_sp > XB_SPIN_CAP) { atomicAdd(&(bar)[XB_TMO], 1u); break; } } } } while (0)

struct XcdBarrier {
    unsigned* bar; unsigned x;
    volatile LAS unsigned* st;
};

__device__ __forceinline__ XcdBarrier xcd_barrier_post(unsigned* bar, volatile LAS unsigned* st) {
    XcdBarrier b; b.bar = bar; b.x = xb_xcc_id(); b.st = st;
    if (threadIdx.x == 0) (void)xb_add(&bar[XB_XCNT(b.x)], 1u);
    return b;
}
__device__ __forceinline__ void xcd_barrier_complete(unsigned* bar, unsigned x, unsigned& nloc, unsigned& nx) {
    const unsigned G = gridDim.x * gridDim.y * gridDim.z;
    unsigned sum, cnt, mine, sp = 0u;
    for (;;) {
        sum = 0u; cnt = 0u; mine = 0u;
#pragma unroll
        for (unsigned j = 0; j < 16; ++j) { const unsigned c = xb_ld(&bar[XB_XCNT(j)]); sum += c; cnt += (c > 0u) ? 1u : 0u; mine = (j == x) ? c : mine; }
        if (sum == G) break;
        __builtin_amdgcn_s_sleep(1);
        if ((++sp & 255u) == 0u) { if (xb_ld(&bar[XB_TMO])) break; if (sp > XB_SPIN_CAP) { atomicAdd(&bar[XB_TMO], 1u); break; } }
    }
    nloc = mine > 0u ? mine : 1u; nx = cnt > 0u ? cnt : 1u;
}

__device__ __forceinline__ void xcd_barrier(const XcdBarrier& b, int tid_in) {
    asm volatile("s_waitcnt vmcnt(0)" ::: "memory");
    __syncthreads();
    if (tid_in == 0) {
        unsigned* bar = b.bar;
        __builtin_amdgcn_s_waitcnt(0);
        unsigned nloc = b.st[0], nx = b.st[1];
        if (nloc == 0u) { xcd_barrier_complete(bar, b.x, nloc, nx); b.st[0] = nloc; b.st[1] = nx; }
        const unsigned old = xb_add(&bar[XB_XSUB(b.x)], 1u);
        const unsigned gen = old / nloc;
        if (old + 1u == (gen + 1u) * nloc) {
            __builtin_amdgcn_fence(__ATOMIC_RELEASE, "agent");
            asm volatile("s_waitcnt vmcnt(0)" ::: "memory");
            const unsigned og = xb_add(&bar[XB_TOP], 1u);
            const unsigned tg = og / nx;
            if (og + 1u == (tg + 1u) * nx) xb_add(&bar[XB_TOPGEN], 1u);
            else XB_SPIN(xb_ld(&bar[XB_TOPGEN]) == tg, bar);
            __builtin_amdgcn_fence(__ATOMIC_ACQUIRE, "agent");
            xb_add(&bar[XB_XGEN(b.x)], 1u);
            asm volatile("s_waitcnt vmcnt(0)" ::: "memory");
        } else {
            XB_SPIN(xb_ld(&bar[XB_XGEN(b.x)]) == gen, bar);
            __builtin_amdgcn_fence(__ATOMIC_ACQUIRE, "agent");
            asm volatile("s_waitcnt vmcnt(0)" ::: "memory");
        }
    }
    __syncthreads();
}

struct Args { const float* in[16]; float* out; unsigned char* ws; int ph_lo, ph_hi; };
enum { IN_X = 0, IN_GMIX, IN_WIN, IN_BF, IN_GSGU, IN_WSP, IN_BSP, IN_WA, IN_WB, IN_WOUT, IN_GFFN, IN_WUP, IN_CW, IN_CB, IN_WDOWN, IN_GFIN };

__device__ __forceinline__ void tr_tile(const float* src, int ldS, int srcCol0, const float* gain, bf16* dst, int K, int dstRow0, int k0, float* T, int tid) {
    const int kr = tid >> 5, c4 = tid & 31;
    f32x4 v[4]; float g[4];
#pragma unroll
    for (int i = 0; i < 4; ++i) { const int k = k0 + kr + 16 * i; v[i] = *(const f32x4*)(src + (size_t)k * ldS + srcCol0 + 4 * c4); g[i] = gain ? gain[k] : 1.0f; }
#pragma unroll
    for (int i = 0; i < 4; ++i) { float* t = T + (kr + 16 * i) * 129 + 4 * c4; t[0] = v[i][0] * g[i]; t[1] = v[i][1] * g[i]; t[2] = v[i][2] * g[i]; t[3] = v[i][3] * g[i]; }
    __syncthreads();
#pragma unroll
    for (int i = 0; i < 2; ++i) { const int idx = tid + 512 * i, n = idx >> 3, kc = idx & 7; const float* t = T + (8 * kc) * 129 + n;
        u32x4 w; w.x = cvt_pk_bf16(t[0], t[129]); w.y = cvt_pk_bf16(t[2 * 129], t[3 * 129]); w.z = cvt_pk_bf16(t[4 * 129], t[5 * 129]); w.w = cvt_pk_bf16(t[6 * 129], t[7 * 129]);
        *(u32x4*)(dst + (size_t)(dstRow0 + n) * K + k0 + 8 * kc) = w; }
    __syncthreads();
}
__device__ __forceinline__ void ph_rowstats(const float* src, bf16* xb, float* ssq, int gw, int ngw, int lane) {
    for (int row = gw; row < MTOK; row += ngw) {
        const f32x4* p = (const f32x4*)(src + (size_t)row * DM) + lane; f32x4 v[8]; float s = 0.f;
#pragma unroll
        for (int j = 0; j < 8; ++j) { v[j] = p[64 * j]; s += (v[j][0] * v[j][0] + v[j][1] * v[j][1]) + (v[j][2] * v[j][2] + v[j][3] * v[j][3]); }
        s = wave_sum(s);
        u32x2* o = (u32x2*)(xb + (size_t)row * DM) + lane;
#pragma unroll
        for (int j = 0; j < 8; ++j) { u32x2 w; w.x = cvt_pk_bf16(v[j][0], v[j][1]); w.y = cvt_pk_bf16(v[j][2], v[j][3]); o[64 * j] = w; }
        if (lane < 32) ssq[(size_t)row * 32 + lane] = lane == 0 ? s : 0.f;
    }
}
__device__ __forceinline__ void ph_prologue(const Args& a, unsigned char* lds, int tid, int lane, int wave, int bx, int G) {
    unsigned char* ws = a.ws; float* T = (float*)lds;
    constexpr int J_IN = 32 * 72, J_A = 16 * 16, J_OUT = 32 * 16, J_UP = 32 * 88, J_DOWN = 88 * 16, J_LAYER = J_IN + 2 * J_A + J_OUT + J_UP + J_DOWN;
    for (int j = bx; j < DEPTH * J_LAYER; j += G) {
        const int l = j / J_LAYER; int r = j % J_LAYER; bf16* wl = (bf16*)(ws + WS_W + (size_t)l * W_LAYER);
        if (r < J_IN) { const int tn = r % 72, kt = r / 72; tr_tile(a.in[IN_WIN] + (size_t)l * DM * INW, INW, tn * 128 < 3072 ? tn * 128 : tn * 128 + 8, a.in[IN_GMIX] + l * DM, (bf16*)((unsigned char*)wl + W_IN), DM, tn * 128, kt * 64, T, tid); continue; } r -= J_IN;
        if (r < J_A) { const int tn = r % 16, kt = r / 16; tr_tile(a.in[IN_WA] + (size_t)l * FW * DM, DM, tn * 128, nullptr, (bf16*)((unsigned char*)wl + W_A), FW, tn * 128, kt * 64, T, tid); continue; } r -= J_A;
        if (r < J_A) { const int tn = r % 16, kt = r / 16; tr_tile(a.in[IN_WB] + (size_t)l * SW * DM, DM, tn * 128, nullptr, (bf16*)((unsigned char*)wl + W_B), SW, tn * 128, kt * 64, T, tid); continue; } r -= J_A;
        if (r < J_OUT) { const int tn = r % 16, kt = r / 16; tr_tile(a.in[IN_WOUT] + (size_t)l * DM * DM, DM, tn * 128, nullptr, (bf16*)((unsigned char*)wl + W_OUT), DM, tn * 128, kt * 64, T, tid); continue; } r -= J_OUT;
        if (r < J_UP) { const int tn = r % 88, kt = r / 88; tr_tile(a.in[IN_WUP] + (size_t)l * DM * NUP, NUP, (tn & 1) * DFF + (tn >> 1) * 128, a.in[IN_GFFN] + l * DM, (bf16*)((unsigned char*)wl + W_UP), DM, tn * 128, kt * 64, T, tid); continue; } r -= J_UP;
        { const int tn = r % 16, kt = r / 16; tr_tile(a.in[IN_WDOWN] + (size_t)l * DFF * DM, DM, tn * 128, nullptr, (bf16*)((unsigned char*)wl + W_DOWN), DFF, tn * 128, kt * 64, T, tid); }
    }
    float* wf = (float*)(ws + WS_WF);
    for (int i = bx * 512 + tid; i < DEPTH * NH * DM; i += G * 512) { const int k = i % DM, h = (i / DM) % NH, l = i / (DM * NH);
        wf[i] = a.in[IN_WIN][((size_t)l * DM + k) * INW + 3 * FW + h] * a.in[IN_GMIX][l * DM + k]; }
    { bf16* wt = (bf16*)(ws + WS_WTRIL); const float* wsp = a.in[IN_WSP];
      for (int i = bx * 512 + tid; i < DEPTH * NG * SCH * SCH; i += G * 512) { const int s_ = i & 127, t_ = (i >> 7) & 127; wt[i] = f2bf(s_ <= t_ ? wsp[i] : 0.f); } }
    ph_rowstats(a.in[IN_X], (bf16*)(ws + WS_XB), (float*)(ws + WS_SSQ), bx * 8 + wave, G * 8, lane);
}

__device__ __forceinline__ void f_unit(const Args& a, int l, int chunk, unsigned char* lds, int tid, int lane, int wave) {
    unsigned char* ws = a.ws; const bf16* xb = (const bf16*)(ws + WS_XB); const float* wf = (const float*)(ws + WS_WF) + (size_t)l * NH * DM; const float* ssq = (const float*)(ws + WS_SSQ);
    float* part = (float*)lds;
    float* lf = (float*)(lds + 16384);
    { const int tl = (wave & 3) * 64 + lane, kh = wave >> 2;
      const bf16* xr = xb + (size_t)(chunk * 256 + tl) * DM + kh * 1024; const float* wk = wf + kh * 1024;
      float f[8];
#pragma unroll
      for (int h = 0; h < 8; ++h) f[h] = 0.f;
      for (int k8 = 0; k8 < 128; ++k8) { const u32x4 w = *(const u32x4*)(xr + 8 * k8);
          const float xv[8] = {bf_lo(w.x), bf_hi(w.x), bf_lo(w.y), bf_hi(w.y), bf_lo(w.z), bf_hi(w.z), bf_lo(w.w), bf_hi(w.w)};
#pragma unroll
          for (int h = 0; h < 8; ++h) {
#pragma unroll
              for (int j = 0; j < 8; ++j) f[h] += xv[j] * wk[h * DM + 8 * k8 + j]; } }
#pragma unroll
      for (int h = 0; h < 8; ++h) part[(kh * 256 + tl) * 8 + h] = f[h]; }
    __syncthreads();
    if (tid < 256) { const int row = chunk * 256 + tid; const f32x4* p = (const f32x4*)(ssq + (size_t)row * 32); float s = 0.f;
#pragma unroll
        for (int j = 0; j < 8; ++j) { const f32x4 q = p[j]; s += (q[0] + q[1]) + (q[2] + q[3]); }
        const float inv = rsqrtf(s * (1.0f / DM) + RMS_EPS);
#pragma unroll
        for (int h = 0; h < 8; ++h) lf[tid * 8 + h] = log_sigmoid_f((part[tid * 8 + h] + part[(256 + tid) * 8 + h]) * inv + a.in[IN_BF][l * NH + h]); }
    __syncthreads();
    if (tid < 8) { float run = 0.f; for (int t = 0; t < 256; ++t) { run += lf[t * 8 + tid]; lf[t * 8 + tid] = run; }
        ((float*)(ws + WS_TOT))[chunk * 8 + tid] = run; }
    __syncthreads();
    { float* cl = (float*)(ws + WS_CL); const int b = chunk >> 4, c16 = chunk & 15;
      for (int i = tid; i < 2048; i += 512) { const int tl = i & 255, h = i >> 8; cl[((size_t)(b * NH + h)) * SEQ + c16 * 256 + tl] = lf[tl * 8 + h]; } }
    __syncthreads();
}

__device__ __forceinline__ void attn_table(const float* cl, const float* tot, char* lds, int bh, int tid) {
    float* tab = (float*)(lds + fa::TAB_OFF); const int b = bh >> 3, h = bh & 7;
    __syncthreads();
    for (int i = tid; i < SEQ; i += 512) { const int ch = i >> 8; float pre = 0.f; for (int j = 0; j < ch; ++j) pre += tot[(b * 16 + j) * 8 + h];
        tab[i] = -(cl[(size_t)bh * SEQ + i] + pre) * 11.313708498984761f; }
    __syncthreads();
}
__device__ __forceinline__ fa::BlockRef<bf16, bf16> attn_ref(const bf16* Qb, const bf16* Kb, const bf16* Vb, bf16* Ob, int bh, int qb) {
    const int b = bh >> 3, h = bh & 7; const size_t rq = (size_t)(b * SEQ + qb * 256) * 1024 + h * HD, rk = (size_t)(b * SEQ) * 1024 + h * HD;
    fa::BlockRef<bf16, bf16> r; r.Q = Qb + rq; r.O = Ob + rq; r.K = Kb + rk; r.V = Vb + rk; r.P0 = qb * 256; return r;
}
__device__ __forceinline__ void attn_fast(unsigned char* ws, unsigned char* ldsg, int tid, int bx, int G) {
    char* lds = (char*)ldsg;
    const bf16* Qb = (const bf16*)(ws + WS_R1); const bf16* Kb = Qb + (size_t)MTOK * 1024; const bf16* Vb = Kb + (size_t)MTOK * 1024; bf16* Ob = (bf16*)(ws + WS_YA);
    const float* cl = (const float*)(ws + WS_CL); const float* tot = (const float*)(ws + WS_TOT);
    const int total = NB * NH * 8, stride = G, W = SEQ;
    int L = bx;
    if (L < total) {
#define FA_DEC(L_, bh_, x_) do { bh_ = (((L_) >> 6) << 3) + ((L_) & 7); x_ = ((L_) >> 3) & 7; } while (0)
        int bh, x, pass = 0; FA_DEC(L, bh, x);
        fa::BlockRef<bf16, bf16> cur = attn_ref(Qb, Kb, Vb, Ob, bh, x);
        attn_table(cl, tot, lds, bh, tid);
        fa::Seam<bf16> S;
        fa::causal_swa_prime<bf16, bf16>(cur, W, lds, S, tid);
        for (;;) {
            const bool more_pass = pass == 0, more_item = L + stride < total, last = !more_pass && !more_item;
            int bhn = bh, xn = x, passn = pass + 1, Ln = L;
            if (!more_pass) { passn = 0; Ln = more_item ? L + stride : L; FA_DEC(Ln, bhn, xn); }
            const fa::BlockRef<bf16, bf16> nxt = last ? cur : attn_ref(Qb, Kb, Vb, Ob, bhn, passn ? 15 - xn : xn);
            fa::causal_swa_block<bf16, bf16>(cur, nxt, SEQ, W, lds, S, tid);
            if (last) break;
            if (bhn != bh) attn_table(cl, tot, lds, bhn, tid);
            cur = nxt; bh = bhn; x = xn; pass = passn; L = Ln;
        }
#undef FA_DEC
    }
    __syncthreads();
}

__device__ __forceinline__ void sgu_fast(const Args& a, int l, unsigned char* lds, int tid, int lane, int wave, int bx, int G) {
    unsigned char* ws = a.ws; const bf16* GU = (const bf16*)(ws + WS_R1) + (size_t)3 * MTOK * 1024; const bf16* GVT = GU + (size_t)MTOK * 1024; bf16* YB = (bf16*)(ws + WS_YB);
    const float* ssqv = (const float*)(ws + WS_SSQV); const bf16* Wt = (const bf16*)(ws + WS_WTRIL) + (size_t)l * NG * SCH * SCH;
    const float* gs = a.in[IN_GSGU] + l * SW; const float* bsp = a.in[IN_BSP] + (size_t)l * NG * SCH;
    float* invl = (float*)lds;
    const int r16 = lane & 15, q = lane >> 4, nks = (wave >> 1) + 1;
    for (int unit = bx; unit < (MTOK / SCH) * NG; unit += G) {
        const int n = unit >> 3, g = unit & 7, tok0 = n * SCH;
        __syncthreads();
        if (tid < SCH) { const f32x4* p = (const f32x4*)(ssqv + (size_t)(tok0 + tid) * 16); float s = 0.f;
#pragma unroll
            for (int k = 0; k < 4; ++k) { const f32x4 v = p[k]; s += (v[0] + v[1]) + (v[2] + v[3]); }
            invl[tid] = rsqrtf(s * (1.0f / SW) + RMS_EPS); }
        __syncthreads();
        f32x4 acc[8];
#pragma unroll
        for (int cb = 0; cb < 8; ++cb) acc[cb] = (f32x4){0.f, 0.f, 0.f, 0.f};
        const bf16* wrow = Wt + ((size_t)g * SCH + 16 * wave + r16) * SCH + 8 * q;
        const bf16* vrow = GVT + ((size_t)n * SW + g * GD + r16) * SCH + 8 * q;
        for (int ks = 0; ks < nks; ++ks) {
            const u32x4 wr_ = *(const u32x4*)(wrow + 32 * ks); const f32x4 i0 = *(const f32x4*)(invl + 32 * ks + 8 * q), i1 = *(const f32x4*)(invl + 32 * ks + 8 * q + 4);
            u32x4 wp; wp.x = cvt_pk_bf16(bf_lo(wr_.x) * i0[0], bf_hi(wr_.x) * i0[1]); wp.y = cvt_pk_bf16(bf_lo(wr_.y) * i0[2], bf_hi(wr_.y) * i0[3]);
            wp.z = cvt_pk_bf16(bf_lo(wr_.z) * i1[0], bf_hi(wr_.z) * i1[1]); wp.w = cvt_pk_bf16(bf_lo(wr_.w) * i1[2], bf_hi(wr_.w) * i1[3]);
            const bf16x8 wf = __builtin_bit_cast(bf16x8, wp);
#pragma unroll
            for (int cb = 0; cb < 8; ++cb) { const bf16x8 vf = *(const bf16x8*)(vrow + (size_t)(16 * cb) * SCH + 32 * ks);
                acc[cb] = __builtin_amdgcn_mfma_f32_16x16x32_bf16(vf, wf, acc[cb], 0, 0, 0); }
        }
        const int t = 16 * wave + r16; const float bt = bsp[g * SCH + t]; const size_t orow = (size_t)(tok0 + t) * SW + g * GD + 4 * q;
#pragma unroll
        for (int cb = 0; cb < 8; ++cb) { const f32x4 gn = *(const f32x4*)(gs + g * GD + 16 * cb + 4 * q); const u32x2 gu = *(const u32x2*)(GU + orow + 16 * cb);
            const float o0 = (gn[0] * acc[cb][0] + bt) * bf_lo(gu.x), o1 = (gn[1] * acc[cb][1] + bt) * bf_hi(gu.x), o2 = (gn[2] * acc[cb][2] + bt) * bf_lo(gu.y), o3 = (gn[3] * acc[cb][3] + bt) * bf_hi(gu.y);
            u32x2 w; w.x = cvt_pk_bf16(o0, o1); w.y = cvt_pk_bf16(o2, o3); *(u32x2*)(YB + orow + 16 * cb) = w; }
    }
    __syncthreads();
}

__device__ __forceinline__ void sgu_simple(const Args& a, int l, unsigned char* lds, int tid, int lane, int wave, int bx, int G) {
    unsigned char* ws = a.ws; const bf16* GU = (const bf16*)(ws + WS_R1) + (size_t)3 * MTOK * 1024; const bf16* GV = GU + (size_t)MTOK * 1024; bf16* YB = (bf16*)(ws + WS_YB);
    float* vn = (float*)lds; float* Wl = (float*)(lds + 65536); float* inv = (float*)(lds + 131072);
    const float* gs = a.in[IN_GSGU] + l * SW; const float* wsp = a.in[IN_WSP] + (size_t)l * NG * SCH * SCH; const float* bsp = a.in[IN_BSP] + (size_t)l * NG * SCH;
    for (int unit = bx; unit < (MTOK / SCH) * NG; unit += G) {
        const int n = unit >> 3, g = unit & 7, tok0 = n * SCH;
        __syncthreads();
        for (int i = 0; i < 16; ++i) { const int s = wave * 16 + i; const bf16* r = GV + (size_t)(tok0 + s) * SW + lane * 16; float ss = 0.f;
#pragma unroll
            for (int q = 0; q < 2; ++q) { const u32x4 w = *(const u32x4*)(r + 8 * q); const float e[8] = {bf_lo(w.x), bf_hi(w.x), bf_lo(w.y), bf_hi(w.y), bf_lo(w.z), bf_hi(w.z), bf_lo(w.w), bf_hi(w.w)};
#pragma unroll
                for (int j = 0; j < 8; ++j) ss += e[j] * e[j]; }
            ss = wave_sum(ss); if (lane == 0) inv[s] = rsqrtf(ss * (1.0f / SW) + RMS_EPS); }
        __syncthreads();
        for (int i = tid; i < SCH * GD; i += 512) { const int s = i >> 7, c = i & 127;
            vn[i] = bf2f(GV[(size_t)(tok0 + s) * SW + g * GD + c]) * inv[s] * gs[g * GD + c];
            Wl[i] = wsp[(size_t)g * SCH * SCH + i]; }
        __syncthreads();
        { const int c = tid & 127, tq = tid >> 7;
          for (int t = tq; t < SCH; t += 4) { float acc = 0.f; for (int s = 0; s <= t; ++s) acc += Wl[t * SCH + s] * vn[s * GD + c];
              const size_t o = (size_t)(tok0 + t) * SW + g * GD + c;
              YB[o] = f2bf((acc + bsp[g * SCH + t]) * bf2f(GU[o])); } }
    }
    __syncthreads();
}

__device__ __forceinline__ void conv_simple(const Args& a, int l, int tid, int bx, int G) {
    unsigned char* ws = a.ws; const bf16* AR = (const bf16*)(ws + WS_R1); bf16* Gb = (bf16*)(ws + WS_G);
    const float* cw = a.in[IN_CW] + (size_t)l * 3 * DFF; const float* cb = a.in[IN_CB] + (size_t)l * DFF;
    constexpr int NCG = DFF / 8;
    for (size_t i = (size_t)bx * 512 + tid; i < (size_t)MTOK * NCG; i += (size_t)G * 512) {
        const int row = (int)(i / NCG), cg = (int)(i % NCG), s = row & (SEQ - 1); const size_t o = (size_t)row * DFF + 8 * cg;
        const u32x4 z = {0u, 0u, 0u, 0u};
        const u32x4 a0 = *(const u32x4*)(AR + o), a1 = s >= 1 ? *(const u32x4*)(AR + o - DFF) : z, a2 = s >= 2 ? *(const u32x4*)(AR + o - 2 * DFF) : z, bb = *(const u32x4*)(Gb + o);
        const float x0[8] = {bf_lo(a0.x), bf_hi(a0.x), bf_lo(a0.y), bf_hi(a0.y), bf_lo(a0.z), bf_hi(a0.z), bf_lo(a0.w), bf_hi(a0.w)};
        const float x1[8] = {bf_lo(a1.x), bf_hi(a1.x), bf_lo(a1.y), bf_hi(a1.y), bf_lo(a1.z), bf_hi(a1.z), bf_lo(a1.w), bf_hi(a1.w)};
        const float x2[8] = {bf_lo(a2.x), bf_hi(a2.x), bf_lo(a2.y), bf_hi(a2.y), bf_lo(a2.z), bf_hi(a2.z), bf_lo(a2.w), bf_hi(a2.w)};
        const float bv[8] = {bf_lo(bb.x), bf_hi(bb.x), bf_lo(bb.y), bf_hi(bb.y), bf_lo(bb.z), bf_hi(bb.z), bf_lo(bb.w), bf_hi(bb.w)};
        float r[8];
#pragma unroll
        for (int j = 0; j < 8; ++j) { const int c = 8 * cg + j; const float v = cb[c] + cw[c] * x2[j] + cw[DFF + c] * x1[j] + cw[2 * DFF + c] * x0[j]; r[j] = gelu_tanh(v) * bv[j]; }
        u32x4 w; w.x = cvt_pk_bf16(r[0], r[1]); w.y = cvt_pk_bf16(r[2], r[3]); w.z = cvt_pk_bf16(r[4], r[5]); w.w = cvt_pk_bf16(r[6], r[7]);
        *(u32x4*)(Gb + o) = w;
    }
}
__device__ __forceinline__ void conv_fixup(const Args& a, int l, int tid, int bx, int G) {
    unsigned char* ws = a.ws; bf16* Gb = (bf16*)(ws + WS_G); const float* sideA = (const float*)(ws + WS_SIDEA); const float* sideH = (const float*)(ws + WS_SIDEH);
    const float* cw = a.in[IN_CW] + (size_t)l * 3 * DFF; const float* cb = a.in[IN_CB] + (size_t)l * DFF;
    constexpr int NQ = DFF / 4;
    for (int i = bx * 512 + tid; i < (MTOK / 256) * NQ; i += G * 512) { const int pm = i / NQ, c = 4 * (i % NQ);
        const f32x4 z = {0.f, 0.f, 0.f, 0.f};
        const f32x4 xm2 = (pm & 15) ? *(const f32x4*)(sideA + ((size_t)(pm - 1) * 2 + 0) * DFF + c) : z, xm1 = (pm & 15) ? *(const f32x4*)(sideA + ((size_t)(pm - 1) * 2 + 1) * DFF + c) : z;
        const float* sh = sideH + (size_t)pm * 4 * DFF + c; const f32x4 a0 = *(const f32x4*)sh, a1 = *(const f32x4*)(sh + DFF), b0 = *(const f32x4*)(sh + 2 * DFF), b1 = *(const f32x4*)(sh + 3 * DFF);
        const f32x4 w0 = *(const f32x4*)(cw + c), w1 = *(const f32x4*)(cw + DFF + c), w2 = *(const f32x4*)(cw + 2 * DFF + c), cbv = *(const f32x4*)(cb + c);
        float g0[4], g1[4];
#pragma unroll
        for (int k = 0; k < 4; ++k) { g0[k] = gelu_tanh(cbv[k] + w0[k] * xm2[k] + w1[k] * xm1[k] + w2[k] * a0[k]) * b0[k]; g1[k] = gelu_tanh(cbv[k] + w0[k] * xm1[k] + w1[k] * a0[k] + w2[k] * a1[k]) * b1[k]; }
        u32x2 w; w.x = cvt_pk_bf16(g0[0], g0[1]); w.y = cvt_pk_bf16(g0[2], g0[3]); *(u32x2*)(Gb + (size_t)(pm * 256) * DFF + c) = w;
        w.x = cvt_pk_bf16(g1[0], g1[1]); w.y = cvt_pk_bf16(g1[2], g1[3]); *(u32x2*)(Gb + (size_t)(pm * 256 + 1) * DFF + c) = w;
    }
}
__device__ __forceinline__ void ph_final(const Args& a, int gw, int ngw, int lane) {
    const float* x = (const float*)(a.ws + WS_X); const f32x4* gf = (const f32x4*)a.in[IN_GFIN] + lane;
    for (int row = gw; row < MTOK; row += ngw) {
        const f32x4* p = (const f32x4*)(x + (size_t)row * DM) + lane; f32x4 v[8]; float s = 0.f;
#pragma unroll
        for (int j = 0; j < 8; ++j) { v[j] = p[64 * j]; s += (v[j][0] * v[j][0] + v[j][1] * v[j][1]) + (v[j][2] * v[j][2] + v[j][3] * v[j][3]); }
        s = wave_sum(s); const float inv = rsqrtf(s * (1.0f / DM) + RMS_EPS);
        f32x4* o = (f32x4*)(a.out + (size_t)row * DM) + lane;
#pragma unroll
        for (int j = 0; j < 8; ++j) o[64 * j] = (v[j] * inv) * gf[64 * j];
    }
}

constexpr int PH_PER_LAYER = 7, N_PHASES = 2 + DEPTH * PH_PER_LAYER;
#define PHASE_BEGIN() int wave = wave0; asm volatile("" : "+s"(wave)); const int lane = (int)__builtin_amdgcn_mbcnt_hi(~0u, __builtin_amdgcn_mbcnt_lo(~0u, 0u)); int tid = wave * 64 + lane; asm volatile("" : "+v"(tid)); \
    int bx = blockIdx.x; asm volatile("" : "+s"(bx)); int G = gridDim.x; asm volatile("" : "+s"(G)); \
    Args A; _Pragma("unroll") for (int i_ = 0; i_ < 16; ++i_) A.in[i_] = (const float*)(GAS const float*)ldarg(ARGL, i_); \
    A.out = (float*)(GAS float*)ldarg(ARGL, 16); A.ws = (unsigned char*)(GAS unsigned char*)ldarg(ARGL, 17); A.ph_lo = 0; A.ph_hi = 0; \
    unsigned char* ws = A.ws; (void)lane; (void)wave; (void)ws; (void)bx; (void)G
__device__ __forceinline__ unsigned long long ldarg(volatile LAS unsigned long long* t, int i) {
    const unsigned long long v = t[i]; const unsigned lo = __builtin_amdgcn_readfirstlane((unsigned)v), hi = __builtin_amdgcn_readfirstlane((unsigned)(v >> 32));
    return ((unsigned long long)hi << 32) | lo;
}
__global__ void __launch_bounds__(512, 2) fwd_kernel(Args args) {
    extern __shared__ __attribute__((aligned(16))) unsigned char lds[];
    volatile LAS unsigned* MISC = (volatile LAS unsigned*)((LAS unsigned char*)lds + MISC_OFF);
    volatile LAS unsigned long long* ARGL = (volatile LAS unsigned long long*)((LAS unsigned char*)lds + ARGS_OFF);
    if (threadIdx.x < 64) MISC[threadIdx.x] = 0u;
    { unsigned long long v_ = 0ull;
#pragma unroll
      for (int i_ = 0; i_ < 16; ++i_) if ((int)threadIdx.x == i_) v_ = (unsigned long long)args.in[i_];
      if (threadIdx.x == 16) v_ = (unsigned long long)args.out; if (threadIdx.x == 17) v_ = (unsigned long long)args.ws;
      if (threadIdx.x < 18) ARGL[threadIdx.x] = v_; }
    __syncthreads();
    const int lo = args.ph_lo, hi = args.ph_hi, wave0 = __builtin_amdgcn_readfirstlane(threadIdx.x >> 6);
    unsigned* ctl = (unsigned*)(args.ws + WS_CTL);
    XcdBarrier bar; bar.bar = ctl + CW_BAR; bar.x = 0; bar.st = nullptr;
    if (hi - lo > 1) bar = xcd_barrier_post(ctl + CW_BAR, MISC + 8);
#define IN(k) (lo <= (k) && (k) < hi)
#ifndef ONLY_J
#define ONLY_J -1
#endif
#define INL(j) ((ONLY_J < 0 || ONLY_J == (j)) && IN(pb + (j)))
#ifndef DUP_MASK
#define DUP_MASK 0
#endif
#define REP(bit) for (int rep_ = 0; rep_ < (((DUP_MASK) >> (bit)) & 1) + 1; ++rep_)
#define SEAM(k) do { if (lo <= (k) && (k) + 1 < hi) { XcdBarrier b_ = bar; { GAS unsigned* p_ = (GAS unsigned*)b_.bar; asm volatile("" : "+s"(p_)); b_.bar = (unsigned*)p_; } xcd_barrier(b_, tid); } } while (0)
    LAS unsigned char* ring = (LAS unsigned char*)lds;

    if (IN(0)) { PHASE_BEGIN(); REP(0) ph_prologue(A, lds, tid, lane, wave, bx, G); SEAM(0); }

    for (int l = 0; l < DEPTH; ++l) {
        const int pb = 1 + l * PH_PER_LAYER;
        if (INL(0)) { PHASE_BEGIN();  {
            for (int ch = bx; ch < MTOK / 256; ch += G) f_unit(A, l, ch, lds, tid, lane, wave);
            const unsigned char* wl = ws + WS_W + (size_t)l * W_LAYER;
            pg8::Gemm g{(const bf16*)(ws + WS_XB), (const bf16*)(wl + W_IN), MTOK, NIN, DM}; pg8::StaticOrder S; S.init(MTOK, NIN, G, bx);
            pg8::EpiInProj2 E{(const float*)(ws + WS_SSQ), (bf16*)(ws + WS_R1), (float*)(ws + WS_SSQV)};
            pg8::gemm_phase<pg8::EpiInProj2, pg8::StaticOrder, true, true>(ring, g, S, E, tid); }
            SEAM(pb + 0);
        }
        if (INL(1)) { PHASE_BEGIN(); REP(2) attn_fast(ws, lds, tid, bx, G); REP(3) sgu_fast(A, l, lds, tid, lane, wave, bx, G); SEAM(pb + 1); }
        if (INL(2)) { PHASE_BEGIN();  {
            const unsigned char* wl = ws + WS_W + (size_t)l * W_LAYER;
            float* T = (float*)(ws + WS_R1); bf16* R1 = (bf16*)(ws + WS_R1);
            { pg8::Gemm g{(const bf16*)(ws + WS_YA), (const bf16*)(wl + W_A), MTOK, DM, FW}; pg8::StaticOrder S; S.init(MTOK, DM, G, bx);
              pg8::EpiBranchA E{R1 + (size_t)5 * MTOK * 1024, T};
              pg8::gemm_phase<pg8::EpiBranchA, pg8::StaticOrder, true, true>(ring, g, S, E, tid); }
            { pg8::Gemm g{(const bf16*)(ws + WS_YB), (const bf16*)(wl + W_B), MTOK, DM, SW}; pg8::StaticOrder S; S.init(MTOK, DM, G, bx);
              pg8::EpiBranchB E{R1 + (size_t)5 * MTOK * 1024 + (size_t)MTOK * 2048, T, (bf16*)(ws + WS_MG)};
              pg8::gemm_phase<pg8::EpiBranchB, pg8::StaticOrder, true, true>(ring, g, S, E, tid); } }
            SEAM(pb + 2);
        }
        if (INL(3)) { PHASE_BEGIN();
            const unsigned char* wl = ws + WS_W + (size_t)l * W_LAYER; float* XR = (float*)(ws + WS_X);
            pg8::Gemm g{(const bf16*)(ws + WS_MG), (const bf16*)(wl + W_OUT), MTOK, DM, DM}; pg8::StaticOrder S; S.init(MTOK, DM, G, bx);
            pg8::EpiResidStats E{l == 0 ? A.in[IN_X] : (const float*)XR, XR, (bf16*)(ws + WS_XB), (float*)(ws + WS_SSQ)};
            pg8::gemm_phase<pg8::EpiResidStats, pg8::StaticOrder, true, true>(ring, g, S, E, tid);
            SEAM(pb + 3);
        }
        if (INL(4)) { PHASE_BEGIN();  {
            const unsigned char* wl = ws + WS_W + (size_t)l * W_LAYER;
            pg8::Gemm g{(const bf16*)(ws + WS_XB), (const bf16*)(wl + W_UP), MTOK, NUP, DM}; pg8::StaticOrder S; S.init(MTOK, NUP, G, bx);
            pg8::EpiUpConv E{(const float*)(ws + WS_SSQ), (bf16*)(ws + WS_G), A.in[IN_CW] + (size_t)l * 3 * DFF, A.in[IN_CB] + (size_t)l * DFF, (float*)(ws + WS_SIDEA), (float*)(ws + WS_SIDEH), (LAS float*)(ring + HALO_OFF)};
            pg8::gemm_phase<pg8::EpiUpConv, pg8::StaticOrder, true, true>(ring, g, S, E, tid); }
            SEAM(pb + 4);
        }
        if (INL(5)) { PHASE_BEGIN(); conv_fixup(A, l, tid, bx, G); SEAM(pb + 5); }
        if (INL(6)) { PHASE_BEGIN();
            const unsigned char* wl = ws + WS_W + (size_t)l * W_LAYER; float* XR = (float*)(ws + WS_X);
            pg8::Gemm g{(const bf16*)(ws + WS_G), (const bf16*)(wl + W_DOWN), MTOK, DM, DFF}; pg8::StaticOrder S; S.init(MTOK, DM, G, bx);
            pg8::EpiResidStats E{(const float*)XR, XR, (bf16*)(ws + WS_XB), (float*)(ws + WS_SSQ)};
            pg8::gemm_phase<pg8::EpiResidStats, pg8::StaticOrder, true, true>(ring, g, S, E, tid);
            SEAM(pb + 6);
        }
    }
    if (IN(N_PHASES - 1)) { PHASE_BEGIN(); ph_final(A, bx * 8 + wave, G * 8, lane); }
#undef IN
#undef INL
#undef SEAM
}

#ifndef MK_LAUNCH_PER_PHASE
#define MK_LAUNCH_PER_PHASE 0
#endif
extern "C" void kernel_launch(void* const* d_in, const int* in_sizes, int n_in, void* d_out, int out_size, void* d_ws, size_t ws_size, hipStream_t stream) {
    static int grid = 0;
    if (grid == 0) {
        if (n_in != 16 || in_sizes[0] != MTOK * DM || out_size != MTOK * DM || ws_size < WS_END) { fprintf(stderr, "kernel_launch: unexpected shapes (n_in %d, in0 %d, out %d, ws %zu)\n", n_in, n_in > 0 ? in_sizes[0] : -1, out_size, ws_size); grid = -1; return; }
        int dev = 0, cus = 0, per_cu = 0;
        if (hipGetDevice(&dev) != hipSuccess || hipDeviceGetAttribute(&cus, hipDeviceAttributeMultiprocessorCount, dev) != hipSuccess) { grid = -1; return; }
        if (hipFuncSetAttribute((const void*)fwd_kernel, hipFuncAttributeMaxDynamicSharedMemorySize, LDS_BYTES) != hipSuccess) { fprintf(stderr, "kernel_launch: hipFuncSetAttribute failed\n"); grid = -1; return; }
        if (hipOccupancyMaxActiveBlocksPerMultiprocessor(&per_cu, (const void*)fwd_kernel, 512, LDS_BYTES) != hipSuccess || per_cu < 1) { fprintf(stderr, "kernel_launch: occupancy query reports %d\n", per_cu); }
        (void)hipGetLastError();
        grid = cus;
    }
    if (grid < 0) return;
    (void)hipMemsetAsync((char*)d_ws + WS_CTL, 0, CTL_ZERO_BYTES, stream);
    Args a; memset(&a, 0, sizeof(a));
    for (int i = 0; i < 16; ++i) a.in[i] = (const float*)d_in[i];
    a.out = (float*)d_out; a.ws = (unsigned char*)d_ws;
#if MK_LAUNCH_PER_PHASE
    for (int p = 0; p < N_PHASES; ++p) { a.ph_lo = p; a.ph_hi = p + 1; hipLaunchKernelGGL(fwd_kernel, dim3(grid), dim3(512), LDS_BYTES, stream, a); }
#else
    a.ph_lo = 0; a.ph_hi = N_PHASES; hipLaunchKernelGGL(fwd_kernel, dim3(grid), dim3(512), LDS_BYTES, stream, a);
#endif
}
```

```cpp
#include <hip/hip_runtime.h>
#include <cstdio>
#include <cstdint>
#include <cstring>

#define LAS __attribute__((address_space(3)))
#define GAS __attribute__((address_space(1)))
typedef unsigned short bf16;
typedef short bf16x8 __attribute__((ext_vector_type(8)));
typedef float f32x4 __attribute__((ext_vector_type(4)));
typedef float f32x2 __attribute__((ext_vector_type(2)));
typedef unsigned u32x4 __attribute__((ext_vector_type(4)));
typedef unsigned u32x2 __attribute__((ext_vector_type(2)));

constexpr int DM = 2048, NB = 4, SEQ = 4096, DEPTH = 4, MTOK = NB * SEQ;
constexpr int FW = 1024, NH = 8, HD = 128, SW = 1024, NG = 8, GD = 128, SCH = 128, DFF = 5632, INW = 9224, NIN = 9216, NUP = 2 * DFF;
constexpr float RMS_EPS = 1e-6f;
constexpr float ATT_SCALE = 0.08838834764831845f;

__device__ __forceinline__ float bf_lo(unsigned w) { return __uint_as_float(w << 16); }
__device__ __forceinline__ float bf_hi(unsigned w) { return __uint_as_float(w & 0xffff0000u); }
__device__ __forceinline__ float bf2f(bf16 b) { return __uint_as_float(((unsigned)b) << 16); }
typedef __bf16 bf16x2_n __attribute__((ext_vector_type(2)));
__device__ __forceinline__ unsigned cvt_pk_bf16(float lo, float hi) { const f32x2 v = {lo, hi}; return __builtin_bit_cast(unsigned, __builtin_convertvector(v, bf16x2_n)); }
__device__ __forceinline__ bf16 f2bf(float f) { return (bf16)(cvt_pk_bf16(f, 0.f) & 0xffffu); }
__device__ __forceinline__ float gelu_tanh(float x) {
    const float e = __builtin_amdgcn_exp2f(x * ((x * x) * (-0.10294323956f) + (-2.3022081983308417f)));
    return x * __builtin_amdgcn_rcpf(1.0f + e);
}
__device__ __forceinline__ f32x2 gelu_tanh_pk(f32x2 v) {
    const f32x2 arg = v * ((v * v) * (-0.10294323956f) + (-2.3022081983308417f));
    f32x2 e; e.x = __builtin_amdgcn_exp2f(arg.x); e.y = __builtin_amdgcn_exp2f(arg.y);
    const f32x2 d = e + 1.0f; f32x2 r; r.x = __builtin_amdgcn_rcpf(d.x); r.y = __builtin_amdgcn_rcpf(d.y);
    return v * r;
}
__device__ __forceinline__ float sigmoid_f(float x) { return __builtin_amdgcn_rcpf(1.0f + __builtin_amdgcn_exp2f(-1.4426950408889634f * x)); }
__device__ __forceinline__ float log_sigmoid_f(float z) { return fminf(z, 0.f) - 0.6931471805599453f * __builtin_amdgcn_logf(1.0f + __builtin_amdgcn_exp2f(-1.4426950408889634f * fabsf(z))); }
__device__ __forceinline__ float lane_xor_swz16(float v) { return __int_as_float(__builtin_amdgcn_ds_swizzle(__float_as_int(v), (16 << 10) | 0x1F)); }
__device__ __forceinline__ float sum_xor32(float v) { const auto rr = __builtin_amdgcn_permlane32_swap(__float_as_uint(v), __float_as_uint(v), false, false); return __uint_as_float(rr[0]) + __uint_as_float(rr[1]); }
__device__ __forceinline__ float sum_fq(float s) { s += lane_xor_swz16(s); return sum_xor32(s); }
__device__ __forceinline__ float wave_sum(float v) {
    v += __int_as_float(__builtin_amdgcn_ds_swizzle(__float_as_int(v), (1 << 10) | 0x1F)); v += __int_as_float(__builtin_amdgcn_ds_swizzle(__float_as_int(v), (2 << 10) | 0x1F));
    v += __int_as_float(__builtin_amdgcn_ds_swizzle(__float_as_int(v), (4 << 10) | 0x1F)); v += __int_as_float(__builtin_amdgcn_ds_swizzle(__float_as_int(v), (8 << 10) | 0x1F));
    return sum_fq(v);
}

namespace pg8 {
#define PG8_LAS __attribute__((address_space(3)))
typedef unsigned short bf16_t;
typedef short bf16x8 __attribute__((ext_vector_type(8)));
typedef float f32x4 __attribute__((ext_vector_type(4)));
typedef unsigned u32x4 __attribute__((ext_vector_type(4)));
constexpr int BM = 256, BK = 64, HALF = 128, HTB = HALF * BK * 2  , STAGE_BYTES = 8 * HTB, NXCD = 8, WGM = 8;

__host__ __device__ __forceinline__ int lds_byte(int r, int c) { const int st = (r >> 4) * 2 + (c >> 5), rr = r & 15, cc = c & 31, ob = rr * 64 + cc * 2; return st * 1024 + (ob ^ (((ob >> 9) & 1) << 5)); }
__host__ __device__ __forceinline__ void stage_rc(int b, int& R, int& C) { const int st = b / 1024, sb = b % 1024, swz = sb ^ (((sb >> 9) & 1) << 5); R = (st >> 1) * 16 + swz / 64; C = (st & 1) * 32 + (swz % 64) / 2; }
__host__ __device__ __forceinline__ int perm32(int rho) { const int n = rho >> 4, i = rho & 15; return 8 * (i >> 2) + 4 * n + (i & 3); }

struct Unit { int pm, pn, par; };
struct Gemm { const bf16_t* A; const bf16_t* Bt; int M, N, K; };

struct StaticOrder {
    int nM, nN, nwg, G, c, wgm;
    __host__ __device__ void init(int M, int N, int G_, int c_, int wgm_ = WGM) { nM = M / BM; nN = N / BM; nwg = nM * nN; G = G_; c = c_; wgm = wgm_; }
    __host__ __device__ bool next(int i, Unit& u) const {
        const long L = (long)i * G + c; if (L >= nwg) return false;
        int wgid = (int)L; { const int q = nwg / NXCD, r = nwg % NXCD, xcd = wgid % NXCD, off = wgid / NXCD; wgid = (xcd < r ? xcd * (q + 1) : r * (q + 1) + (xcd - r) * q) + off; }
        const int nig = wgm * nN, gid = wgid / nig, fm = gid * wgm, gsz = (nM - fm) < wgm ? (nM - fm) : wgm;
        u.pm = fm + ((wgid % nig) % gsz); u.pn = (wgid % nig) / gsz; return true;
    }
    __device__ __forceinline__ void a_ready(const Unit&) const {}
    __device__ __forceinline__ void done(const Unit&) const {}
};

__device__ __forceinline__ void row_inv8(const float* ssq, int row0, int fq, float (&inv)[2][4]) {
#pragma unroll
    for (int ai = 0; ai < 2; ++ai)
#pragma unroll
        for (int m = 0; m < 4; ++m) {
            const f32x4* p = (const f32x4*)(ssq + (size_t)(row0 + ai * HALF + m * 16) * 32) + 2 * fq;
            const f32x4 a = p[0], b = p[1];
            float s = ((a[0] + a[1]) + (a[2] + a[3])) + ((b[0] + b[1]) + (b[2] + b[3]));
            s = sum_fq(s);
            inv[ai][m] = rsqrtf(s * (1.0f / DM) + RMS_EPS);
        }
}
struct EpiInProj {
    static constexpr int PROBE_ID = 0;
    static constexpr bool PREP = false, MIDK = false, PERM = false, APERM = false, AFTER_DRAIN = false;
    const float* ssq; bf16* R1;
    __device__ __forceinline__ void operator()(const f32x4 (&acc)[2][2][4][2], const Unit& u, int wr, int wc, int fr, int fq) const {
        const int row0 = u.pm * BM + wr * 64 + fr;
        float inv[2][4]; row_inv8(ssq, row0, fq, inv);
        int mode, ld, colb; bf16* base;
        if (u.pn < 20) { const int t = u.pn >> 2; base = R1 + (size_t)t * MTOK * 1024; ld = 1024; colb = (u.pn & 3) * 256; mode = t < 3 ? 0 : 1; }
        else { const int t = (u.pn - 20) >> 3; base = R1 + (size_t)5 * MTOK * 1024 + (size_t)t * MTOK * 2048; ld = 2048; colb = ((u.pn - 20) & 7) * 256; mode = 2; }
#pragma unroll
        for (int ai = 0; ai < 2; ++ai)
#pragma unroll
            for (int m = 0; m < 4; ++m) { bf16* rowp = base + (size_t)(row0 + ai * HALF + m * 16) * ld + colb + wc * 32 + 4 * fq;
#pragma unroll
                for (int bj = 0; bj < 2; ++bj)
#pragma unroll
                    for (int n = 0; n < 2; ++n) { f32x4 v = acc[ai][bj][m][n] * inv[ai][m];
                        if (mode == 1) { v[0] = gelu_tanh(v[0]); v[1] = gelu_tanh(v[1]); v[2] = gelu_tanh(v[2]); v[3] = gelu_tanh(v[3]); }
                        else if (mode == 2) { v[0] = sigmoid_f(v[0]); v[1] = sigmoid_f(v[1]); v[2] = sigmoid_f(v[2]); v[3] = sigmoid_f(v[3]); }
                        u32x2 w; w.x = cvt_pk_bf16(v[0], v[1]); w.y = cvt_pk_bf16(v[2], v[3]);
                        *(u32x2*)(rowp + bj * HALF + n * 16) = w; } }
    }
};
struct EpiBranchA {
    static constexpr int PROBE_ID = 3;
    static constexpr bool PREP = false, MIDK = false, PERM = false, APERM = false, AFTER_DRAIN = false;
    const bf16* SA; float* T;
    __device__ __forceinline__ void operator()(const f32x4 (&acc)[2][2][4][2], const Unit& u, int wr, int wc, int fr, int fq) const {
        const int row0 = u.pm * BM + wr * 64 + fr, col0 = u.pn * BM + wc * 32 + 4 * fq;
#pragma unroll
        for (int ai = 0; ai < 2; ++ai)
#pragma unroll
            for (int m = 0; m < 4; ++m) { const size_t off = (size_t)(row0 + ai * HALF + m * 16) * DM + col0;
#pragma unroll
                for (int bj = 0; bj < 2; ++bj)
#pragma unroll
                    for (int n = 0; n < 2; ++n) { const u32x2 g = *(const u32x2*)(SA + off + bj * HALF + n * 16);
                        const f32x4 gv = {bf_lo(g.x), bf_hi(g.x), bf_lo(g.y), bf_hi(g.y)};
                        *(f32x4*)(T + off + bj * HALF + n * 16) = acc[ai][bj][m][n] * gv; } }
    }
};
struct EpiBranchB {
    static constexpr int PROBE_ID = 4;
    static constexpr bool PREP = false, MIDK = false, PERM = false, APERM = false, AFTER_DRAIN = false;
    const bf16* SB; const float* T; bf16* MG;
    __device__ __forceinline__ void operator()(const f32x4 (&acc)[2][2][4][2], const Unit& u, int wr, int wc, int fr, int fq) const {
        const int row0 = u.pm * BM + wr * 64 + fr, col0 = u.pn * BM + wc * 32 + 4 * fq;
#pragma unroll
        for (int ai = 0; ai < 2; ++ai)
#pragma unroll
            for (int m = 0; m < 4; ++m) { const size_t off = (size_t)(row0 + ai * HALF + m * 16) * DM + col0;
#pragma unroll
                for (int bj = 0; bj < 2; ++bj)
#pragma unroll
                    for (int n = 0; n < 2; ++n) { const u32x2 g = *(const u32x2*)(SB + off + bj * HALF + n * 16);
                        const f32x4 gv = {bf_lo(g.x), bf_hi(g.x), bf_lo(g.y), bf_hi(g.y)};
                        const f32x4 t = *(const f32x4*)(T + off + bj * HALF + n * 16);
                        const f32x4 v = t + acc[ai][bj][m][n] * gv;
                        u32x2 w; w.x = cvt_pk_bf16(v[0], v[1]); w.y = cvt_pk_bf16(v[2], v[3]);
                        *(u32x2*)(MG + off + bj * HALF + n * 16) = w; } }
    }
};
struct EpiResid {
    static constexpr int PROBE_ID = 0;
    static constexpr bool PREP = false, MIDK = false, PERM = false, APERM = false, AFTER_DRAIN = false;
    const float* xin; float* xout;
    __device__ __forceinline__ void operator()(const f32x4 (&acc)[2][2][4][2], const Unit& u, int wr, int wc, int fr, int fq) const {
        const int row0 = u.pm * BM + wr * 64 + fr, col0 = u.pn * BM + wc * 32 + 4 * fq;
#pragma unroll
        for (int ai = 0; ai < 2; ++ai)
#pragma unroll
            for (int m = 0; m < 4; ++m) { const size_t off = (size_t)(row0 + ai * HALF + m * 16) * DM + col0;
#pragma unroll
                for (int bj = 0; bj < 2; ++bj)
#pragma unroll
                    for (int n = 0; n < 2; ++n) { const f32x4 b = *(const f32x4*)(xin + off + bj * HALF + n * 16);
                        *(f32x4*)(xout + off + bj * HALF + n * 16) = b + acc[ai][bj][m][n]; } }
    }
};
struct EpiUp1 {
    static constexpr int PROBE_ID = 0;
    static constexpr bool PREP = false, MIDK = false, PERM = false, APERM = false, AFTER_DRAIN = false;
    const float* ssq; bf16* AR; bf16* BR;
    __device__ __forceinline__ void operator()(const f32x4 (&acc)[2][2][4][2], const Unit& u, int wr, int wc, int fr, int fq) const {
        const int row0 = u.pm * BM + wr * 64 + fr, ch0 = u.pn * HALF + wc * 32 + 4 * fq;
        float inv[2][4]; row_inv8(ssq, row0, fq, inv);
#pragma unroll
        for (int ai = 0; ai < 2; ++ai)
#pragma unroll
            for (int m = 0; m < 4; ++m) { const size_t off = (size_t)(row0 + ai * HALF + m * 16) * DFF + ch0;
#pragma unroll
                for (int bj = 0; bj < 2; ++bj)
#pragma unroll
                    for (int n = 0; n < 2; ++n) { const f32x4 v = acc[ai][bj][m][n] * inv[ai][m];
                        u32x2 w; w.x = cvt_pk_bf16(v[0], v[1]); w.y = cvt_pk_bf16(v[2], v[3]);
                        *(u32x2*)((bj ? BR : AR) + off + n * 16) = w; } }
    }
};
struct EpiResidStats {
    static constexpr int PROBE_ID = 5;
    static constexpr bool PREP = false, MIDK = false, PERM = false, APERM = false, AFTER_DRAIN = false;
    const float* xin; float* xout; bf16* xb; float* ssq;
    __device__ __forceinline__ void operator()(const f32x4 (&acc)[2][2][4][2], const Unit& u, int wr, int wc, int fr, int fq) const {
        const int row0 = u.pm * BM + wr * 64 + fr, col0 = u.pn * BM + wc * 32 + 4 * fq;
#pragma unroll
        for (int ai = 0; ai < 2; ++ai)
#pragma unroll
            for (int m = 0; m < 4; ++m) { const int row = row0 + ai * HALF + m * 16; const size_t off = (size_t)row * DM + col0; float s = 0.f;
#pragma unroll
                for (int bj = 0; bj < 2; ++bj)
#pragma unroll
                    for (int n = 0; n < 2; ++n) { const f32x4 b = *(const f32x4*)(xin + off + bj * HALF + n * 16); const f32x4 v = b + acc[ai][bj][m][n];
                        *(f32x4*)(xout + off + bj * HALF + n * 16) = v;
                        u32x2 w; w.x = cvt_pk_bf16(v[0], v[1]); w.y = cvt_pk_bf16(v[2], v[3]); *(u32x2*)(xb + off + bj * HALF + n * 16) = w;
                        s += (v[0] * v[0] + v[1] * v[1]) + (v[2] * v[2] + v[3] * v[3]); }
                s = sum_fq(s);
                if (fq == 0) ssq[(size_t)row * 32 + u.pn * 4 + wc] = s; }
    }
};
__device__ __forceinline__ void prep_inv_table(const float* ssq, PG8_LAS float* tbl, const Unit& u, int tid) {
    const int r = tid >> 1; const f32x4* p = (const f32x4*)(ssq + (size_t)(u.pm * BM + r) * 32 + (tid & 1) * 16);
    const f32x4 a = p[0], b = p[1], c = p[2], d = p[3];
    float s = (((a[0] + a[1]) + (a[2] + a[3])) + ((b[0] + b[1]) + (b[2] + b[3]))) + (((c[0] + c[1]) + (c[2] + c[3])) + ((d[0] + d[1]) + (d[2] + d[3])));
    s += __int_as_float(__builtin_amdgcn_update_dpp(0, __float_as_int(s), 0xB1, 0xf, 0xf, true));
    if ((tid & 1) == 0) tbl[u.par * BM + r] = rsqrtf(s * (1.0f / DM) + RMS_EPS);
}
__device__ __forceinline__ float dpp_row_shr1(float old, float src) { return __int_as_float(__builtin_amdgcn_update_dpp(__float_as_int(old), __float_as_int(src), 0x111, 0xf, 0xf, false)); }
struct EpiUpConv {
    static constexpr int PROBE_ID = 2;
    static constexpr bool PREP = true, MIDK = false, PERM = true, APERM = true, AFTER_DRAIN = false;
    const float* ssq; bf16* G; const float* cw; const float* cb; float* sideA; float* sideH; PG8_LAS float* halo;
    __device__ __forceinline__ void prep(const Unit& u, int tid) const { prep_inv_table(ssq, halo + 256, u, tid);
        const int arr = tid >> 7, ch = tid & 127;
        halo[768 + u.par * 512 + tid] = arr < 3 ? cw[(size_t)arr * DFF + u.pn * HALF + ch] : cb[u.pn * HALF + ch]; }
    __device__ __forceinline__ void operator()(const f32x4 (&acc)[2][2][4][2], const Unit& u, int wr, int wc, int fr, int fq) const {
        const int tok0 = u.pm * BM + 128 * wr + 8 * fr, ch0 = u.pn * HALF + wc * 32 + 8 * fq;
        float inv[8];
        { const PG8_LAS float* tp = halo + 256 + u.par * BM + 128 * wr + 8 * fr; const f32x4 i0 = *(const PG8_LAS f32x4*)tp, i1 = *(const PG8_LAS f32x4*)(tp + 4);
          inv[0] = i0[0]; inv[1] = i0[1]; inv[2] = i0[2]; inv[3] = i0[3]; inv[4] = i1[0]; inv[5] = i1[1]; inv[6] = i1[2]; inv[7] = i1[3]; }
        f32x2 W0[4], W1[4], W2[4], CB[4];
        const PG8_LAS float* wt = halo + 768 + u.par * 512 + wc * 32 + 8 * fq;
#pragma unroll
        for (int n = 0; n < 2; ++n) { const f32x4 w0 = *(const PG8_LAS f32x4*)(wt + 4 * n), w1 = *(const PG8_LAS f32x4*)(wt + 128 + 4 * n), w2 = *(const PG8_LAS f32x4*)(wt + 256 + 4 * n), cbv = *(const PG8_LAS f32x4*)(wt + 384 + 4 * n);
            W0[2 * n] = (f32x2){w0[0], w0[1]}; W0[2 * n + 1] = (f32x2){w0[2], w0[3]}; W1[2 * n] = (f32x2){w1[0], w1[1]}; W1[2 * n + 1] = (f32x2){w1[2], w1[3]};
            W2[2 * n] = (f32x2){w2[0], w2[1]}; W2[2 * n + 1] = (f32x2){w2[2], w2[3]}; CB[2 * n] = (f32x2){cbv[0], cbv[1]}; CB[2 * n + 1] = (f32x2){cbv[2], cbv[3]}; }
        f32x2 a6[4], a7[4];
#pragma unroll
        for (int c = 0; c < 4; ++c) { const f32x4 x6 = acc[1][0][2][c >> 1], x7 = acc[1][0][3][c >> 1];
            a6[c] = (f32x2){x6[2 * (c & 1)], x6[2 * (c & 1) + 1]} * inv[6]; a7[c] = (f32x2){x7[2 * (c & 1)], x7[2 * (c & 1) + 1]} * inv[7]; }
        PG8_LAS float* hp = halo + (wc * 4 + fq) * 16;
        if (wr == 0 && fr == 15) { *(PG8_LAS f32x4*)(hp) = (f32x4){a6[0].x, a6[0].y, a6[1].x, a6[1].y}; *(PG8_LAS f32x4*)(hp + 4) = (f32x4){a6[2].x, a6[2].y, a6[3].x, a6[3].y};
            *(PG8_LAS f32x4*)(hp + 8) = (f32x4){a7[0].x, a7[0].y, a7[1].x, a7[1].y}; *(PG8_LAS f32x4*)(hp + 12) = (f32x4){a7[2].x, a7[2].y, a7[3].x, a7[3].y}; }
        asm volatile("s_waitcnt lgkmcnt(0)" ::: "memory"); __builtin_amdgcn_s_barrier(); asm volatile("" ::: "memory");
        f32x4 h6a = {0.f, 0.f, 0.f, 0.f}, h6b = h6a, h7a = h6a, h7b = h6a;
        if (wr == 1) { h6a = *(PG8_LAS f32x4*)(hp); h6b = *(PG8_LAS f32x4*)(hp + 4); h7a = *(PG8_LAS f32x4*)(hp + 8); h7b = *(PG8_LAS f32x4*)(hp + 12); }
        const bool first = (wr == 0 && fr == 0), lastl = (wr == 1 && fr == 15);
        f32x2 p2[4], p1[4];
        p2[0] = (f32x2){dpp_row_shr1(h6a[0], a6[0].x), dpp_row_shr1(h6a[1], a6[0].y)}; p2[1] = (f32x2){dpp_row_shr1(h6a[2], a6[1].x), dpp_row_shr1(h6a[3], a6[1].y)};
        p2[2] = (f32x2){dpp_row_shr1(h6b[0], a6[2].x), dpp_row_shr1(h6b[1], a6[2].y)}; p2[3] = (f32x2){dpp_row_shr1(h6b[2], a6[3].x), dpp_row_shr1(h6b[3], a6[3].y)};
        p1[0] = (f32x2){dpp_row_shr1(h7a[0], a7[0].x), dpp_row_shr1(h7a[1], a7[0].y)}; p1[1] = (f32x2){dpp_row_shr1(h7a[2], a7[1].x), dpp_row_shr1(h7a[3], a7[1].y)};
        p1[2] = (f32x2){dpp_row_shr1(h7b[0], a7[2].x), dpp_row_shr1(h7b[1], a7[2].y)}; p1[3] = (f32x2){dpp_row_shr1(h7b[2], a7[3].x), dpp_row_shr1(h7b[3], a7[3].y)};
        if (lastl) { float* sa = sideA + (size_t)u.pm * 2 * DFF + ch0;
            *(f32x4*)(sa) = (f32x4){a6[0].x, a6[0].y, a6[1].x, a6[1].y}; *(f32x4*)(sa + 4) = (f32x4){a6[2].x, a6[2].y, a6[3].x, a6[3].y};
            *(f32x4*)(sa + DFF) = (f32x4){a7[0].x, a7[0].y, a7[1].x, a7[1].y}; *(f32x4*)(sa + DFF + 4) = (f32x4){a7[2].x, a7[2].y, a7[3].x, a7[3].y}; }
#pragma unroll
        for (int j = 0; j < 8; ++j) {
            f32x2 cur[4], bb[4], g[4];
#pragma unroll
            for (int c = 0; c < 4; ++c) { const f32x4 xa = acc[j >> 2][0][j & 3][c >> 1], xb_ = acc[j >> 2][1][j & 3][c >> 1];
                cur[c] = (f32x2){xa[2 * (c & 1)], xa[2 * (c & 1) + 1]} * inv[j]; bb[c] = (f32x2){xb_[2 * (c & 1)], xb_[2 * (c & 1) + 1]} * inv[j];
                g[c] = gelu_tanh_pk(CB[c] + W0[c] * p2[c] + W1[c] * p1[c] + W2[c] * cur[c]) * bb[c]; }
            if (first && j < 2) { float* sh = sideH + (size_t)u.pm * 4 * DFF + (size_t)j * DFF + ch0;
                *(f32x4*)(sh) = (f32x4){cur[0].x, cur[0].y, cur[1].x, cur[1].y}; *(f32x4*)(sh + 4) = (f32x4){cur[2].x, cur[2].y, cur[3].x, cur[3].y};
                *(f32x4*)(sh + 2 * DFF) = (f32x4){bb[0].x, bb[0].y, bb[1].x, bb[1].y}; *(f32x4*)(sh + 2 * DFF + 4) = (f32x4){bb[2].x, bb[2].y, bb[3].x, bb[3].y}; }
            else { u32x4 w; w.x = cvt_pk_bf16(g[0].x, g[0].y); w.y = cvt_pk_bf16(g[1].x, g[1].y); w.z = cvt_pk_bf16(g[2].x, g[2].y); w.w = cvt_pk_bf16(g[3].x, g[3].y);
                *(u32x4*)(G + (size_t)(tok0 + j) * DFF + ch0) = w; }
#pragma unroll
            for (int c = 0; c < 4; ++c) { p2[c] = p1[c]; p1[c] = cur[c]; }
        }
    }
};
struct EpiInProj2 {
    static constexpr int PROBE_ID = 1;
    static constexpr bool PREP = true, MIDK = false, PERM = true, APERM = true, AFTER_DRAIN = false;
    const float* ssq; bf16* R1; float* ssqv; PG8_LAS float* tbl;
    __device__ __forceinline__ void prep(const Unit& u, int tid) const { prep_inv_table(ssq, tbl, u, tid); }
    __device__ __forceinline__ void operator()(const f32x4 (&acc)[2][2][4][2], const Unit& u, int wr, int wc, int fr, int fq) const {
        const int tok0 = u.pm * BM + 128 * wr + 8 * fr, cq = wc * 32 + 8 * fq;
        float inv[8];
        { const PG8_LAS float* tp = tbl + u.par * BM + 128 * wr + 8 * fr; const f32x4 i0 = *(const PG8_LAS f32x4*)tp, i1 = *(const PG8_LAS f32x4*)(tp + 4);
          inv[0] = i0[0]; inv[1] = i0[1]; inv[2] = i0[2]; inv[3] = i0[3]; inv[4] = i1[0]; inv[5] = i1[1]; inv[6] = i1[2]; inv[7] = i1[3]; }
        if (u.pn >= 16 && u.pn < 20) {
            bf16* gvt = R1 + (size_t)4 * MTOK * 1024 + ((size_t)(tok0 >> 7) * SW + (u.pn - 16) * 256 + cq) * SCH + (tok0 & 127);
            float ss[8];
#pragma unroll
            for (int j = 0; j < 8; ++j) ss[j] = 0.f;
#pragma unroll
            for (int bj = 0; bj < 2; ++bj)
#pragma unroll
                for (int n = 0; n < 2; ++n)
#pragma unroll
                    for (int i = 0; i < 4; ++i) { float v[8];
#pragma unroll
                        for (int j = 0; j < 8; ++j) { v[j] = gelu_tanh(acc[j >> 2][bj][j & 3][n][i] * inv[j]); ss[j] += v[j] * v[j]; }
                        u32x4 w; w.x = cvt_pk_bf16(v[0], v[1]); w.y = cvt_pk_bf16(v[2], v[3]); w.z = cvt_pk_bf16(v[4], v[5]); w.w = cvt_pk_bf16(v[6], v[7]);
                        *(u32x4*)(gvt + (size_t)(bj * HALF + 4 * n + i) * SCH) = w; }
#pragma unroll
            for (int j = 0; j < 8; ++j) { float s = ss[j]; s = sum_fq(s); if (fq == 0) ssqv[(size_t)(tok0 + j) * 16 + (u.pn - 16) * 4 + wc] = s; }
            return;
        }
        if (u.pn >= 20) {
            bf16* ra = R1 + (size_t)5 * MTOK * 1024 + (u.pn - 20) * HALF + cq; bf16* sb = ra + (size_t)MTOK * 2048;
#pragma unroll
            for (int j = 0; j < 8; ++j) { float r[8], q[8];
#pragma unroll
                for (int n = 0; n < 2; ++n)
#pragma unroll
                    for (int i = 0; i < 4; ++i) { const float i8 = inv[j] * 0.125f, ga = __builtin_amdgcn_fmed3f(acc[j >> 2][0][j & 3][n][i] * i8, -4.0f, 4.0f), gb = __builtin_amdgcn_fmed3f(acc[j >> 2][1][j & 3][n][i] * i8, -4.0f, 4.0f);
                        const float ea = 1.0f + __builtin_amdgcn_exp2f(-11.541560327111707f * ga), eb = 1.0f + __builtin_amdgcn_exp2f(-11.541560327111707f * gb);
                        r[4 * n + i] = eb * __builtin_amdgcn_rcpf(ea); q[4 * n + i] = __builtin_amdgcn_rcpf(eb); }
                u32x4 w; w.x = cvt_pk_bf16(r[0], r[1]); w.y = cvt_pk_bf16(r[2], r[3]); w.z = cvt_pk_bf16(r[4], r[5]); w.w = cvt_pk_bf16(r[6], r[7]);
                *(u32x4*)(ra + (size_t)(tok0 + j) * DM) = w;
                w.x = cvt_pk_bf16(q[0], q[1]); w.y = cvt_pk_bf16(q[2], q[3]); w.z = cvt_pk_bf16(q[4], q[5]); w.w = cvt_pk_bf16(q[6], q[7]);
                *(u32x4*)(sb + (size_t)(tok0 + j) * DM) = w; }
            return;
        }
        const int t = u.pn >> 2, ld = 1024, colb = (u.pn & 3) * 256, mode = 0; bf16* base = R1 + (size_t)t * MTOK * 1024;
#pragma unroll
        for (int j = 0; j < 8; ++j) { bf16* rowp = base + (size_t)(tok0 + j) * ld + colb + cq;
#pragma unroll
            for (int bj = 0; bj < 2; ++bj) { f32x4 v0 = acc[j >> 2][bj][j & 3][0] * inv[j], v1 = acc[j >> 2][bj][j & 3][1] * inv[j];
                if (mode == 1) { const f32x2 g0 = gelu_tanh_pk((f32x2){v0[0], v0[1]}), g1 = gelu_tanh_pk((f32x2){v0[2], v0[3]}), g2 = gelu_tanh_pk((f32x2){v1[0], v1[1]}), g3 = gelu_tanh_pk((f32x2){v1[2], v1[3]});
                    v0 = (f32x4){g0.x, g0.y, g1.x, g1.y}; v1 = (f32x4){g2.x, g2.y, g3.x, g3.y}; }
                u32x4 w; w.x = cvt_pk_bf16(v0[0], v0[1]); w.y = cvt_pk_bf16(v0[2], v0[3]); w.z = cvt_pk_bf16(v1[0], v1[1]); w.w = cvt_pk_bf16(v1[2], v1[3]);
                *(u32x4*)(rowp + bj * HALF) = w; } }
    }
};
struct EpiBranch {
    static constexpr int PROBE_ID = 3;
    static constexpr bool PREP = false, MIDK = true, PERM = true, APERM = false, AFTER_DRAIN = false;
    const bf16* RA; const bf16* SB; bf16* MG;
    __device__ __forceinline__ void mid(f32x4 (&acc)[2][2][4][2], const Unit& u, int wr, int wc, int fr, int fq) const {
        unsigned o0 = (unsigned)((u.pm * BM + wr * 64 + fr) * DM + u.pn * BM + wc * 32 + 8 * fq);
        asm volatile("" : "+v"(o0));
#pragma unroll
        for (int ai = 0; ai < 2; ++ai)
#pragma unroll
            for (int mp = 0; mp < 2; ++mp) { u32x4 g[2][2];
#pragma unroll
                for (int mi = 0; mi < 2; ++mi)
#pragma unroll
                    for (int bj = 0; bj < 2; ++bj) g[mi][bj] = *(const u32x4*)(RA + (size_t)(o0 + (unsigned)((ai * HALF + (2 * mp + mi) * 16) * DM)) + bj * HALF);
#pragma unroll
                for (int mi = 0; mi < 2; ++mi)
#pragma unroll
                    for (int bj = 0; bj < 2; ++bj) { const int m = 2 * mp + mi; const u32x4 q = g[mi][bj];
                        acc[ai][bj][m][0][0] *= bf_lo(q.x); acc[ai][bj][m][0][1] *= bf_hi(q.x); acc[ai][bj][m][0][2] *= bf_lo(q.y); acc[ai][bj][m][0][3] *= bf_hi(q.y);
                        acc[ai][bj][m][1][0] *= bf_lo(q.z); acc[ai][bj][m][1][1] *= bf_hi(q.z); acc[ai][bj][m][1][2] *= bf_lo(q.w); acc[ai][bj][m][1][3] *= bf_hi(q.w); } }
    }
    __device__ __forceinline__ void operator()(const f32x4 (&acc)[2][2][4][2], const Unit& u, int wr, int wc, int fr, int fq) const {
        const int row0 = u.pm * BM + wr * 64 + fr, col0 = u.pn * BM + wc * 32 + 8 * fq;
#pragma unroll
        for (int ai = 0; ai < 2; ++ai) { u32x4 g[4][2];
#pragma unroll
            for (int m = 0; m < 4; ++m)
#pragma unroll
                for (int bj = 0; bj < 2; ++bj) g[m][bj] = *(const u32x4*)(SB + (size_t)(row0 + ai * HALF + m * 16) * DM + col0 + bj * HALF);
#pragma unroll
            for (int m = 0; m < 4; ++m) { const size_t off = (size_t)(row0 + ai * HALF + m * 16) * DM + col0;
#pragma unroll
                for (int bj = 0; bj < 2; ++bj) { const u32x4 gb = g[m][bj]; const f32x4 v0 = acc[ai][bj][m][0], v1 = acc[ai][bj][m][1];
                    u32x4 w; w.x = cvt_pk_bf16(v0[0] * bf_lo(gb.x), v0[1] * bf_hi(gb.x)); w.y = cvt_pk_bf16(v0[2] * bf_lo(gb.y), v0[3] * bf_hi(gb.y));
                    w.z = cvt_pk_bf16(v1[0] * bf_lo(gb.z), v1[1] * bf_hi(gb.z)); w.w = cvt_pk_bf16(v1[2] * bf_lo(gb.w), v1[3] * bf_hi(gb.w));
                    *(u32x4*)(MG + off + bj * HALF) = w; } } }
    }
};
struct EpiResidB {
    static constexpr int PROBE_ID = 5;
    static constexpr bool PREP = false, MIDK = false, PERM = true, APERM = false, AFTER_DRAIN = false;
    const float* xin32; bf16* xb; float* ssq;
    __device__ __forceinline__ float piece(const f32x4 b0, const f32x4 b1, const f32x4 a0, const f32x4 a1, size_t o) const {
        const f32x4 v0 = b0 + a0, v1 = b1 + a1;
        u32x4 w; w.x = cvt_pk_bf16(v0[0], v0[1]); w.y = cvt_pk_bf16(v0[2], v0[3]); w.z = cvt_pk_bf16(v1[0], v1[1]); w.w = cvt_pk_bf16(v1[2], v1[3]);
        *(u32x4*)(xb + o) = w;
        const float r0 = bf_lo(w.x), r1 = bf_hi(w.x), r2 = bf_lo(w.y), r3 = bf_hi(w.y), r4 = bf_lo(w.z), r5 = bf_hi(w.z), r6 = bf_lo(w.w), r7 = bf_hi(w.w);
        return ((r0 * r0 + r1 * r1) + (r2 * r2 + r3 * r3)) + ((r4 * r4 + r5 * r5) + (r6 * r6 + r7 * r7));
    }
    __device__ __forceinline__ void operator()(const f32x4 (&acc)[2][2][4][2], const Unit& u, int wr, int wc, int fr, int fq) const {
        const int row0 = u.pm * BM + wr * 64 + fr, col0 = u.pn * BM + wc * 32 + 8 * fq;
        if (xin32) {
#pragma unroll
            for (int ai = 0; ai < 2; ++ai) { f32x4 b[4][2][2];
#pragma unroll
                for (int m = 0; m < 4; ++m)
#pragma unroll
                    for (int bj = 0; bj < 2; ++bj) { const size_t o = (size_t)(row0 + ai * HALF + m * 16) * DM + col0 + bj * HALF; b[m][bj][0] = *(const f32x4*)(xin32 + o); b[m][bj][1] = *(const f32x4*)(xin32 + o + 4); }
#pragma unroll
                for (int m = 0; m < 4; ++m) { const int row = row0 + ai * HALF + m * 16; const size_t off = (size_t)row * DM + col0; float s = 0.f;
#pragma unroll
                    for (int bj = 0; bj < 2; ++bj) s += piece(b[m][bj][0], b[m][bj][1], acc[ai][bj][m][0], acc[ai][bj][m][1], off + bj * HALF);
                    s = sum_fq(s);
                    if (fq == 0) ssq[(size_t)row * 32 + u.pn * 4 + wc] = s; } }
        } else {
#pragma unroll
            for (int ai = 0; ai < 2; ++ai) { u32x4 r[4][2];
#pragma unroll
                for (int m = 0; m < 4; ++m)
#pragma unroll
                    for (int bj = 0; bj < 2; ++bj) r[m][bj] = *(const u32x4*)(xb + (size_t)(row0 + ai * HALF + m * 16) * DM + col0 + bj * HALF);
#pragma unroll
                for (int m = 0; m < 4; ++m) { const int row = row0 + ai * HALF + m * 16; const size_t off = (size_t)row * DM + col0; float s = 0.f;
#pragma unroll
                    for (int bj = 0; bj < 2; ++bj) { const u32x4 q = r[m][bj];
                        s += piece((f32x4){bf_lo(q.x), bf_hi(q.x), bf_lo(q.y), bf_hi(q.y)}, (f32x4){bf_lo(q.z), bf_hi(q.z), bf_lo(q.w), bf_hi(q.w)}, acc[ai][bj][m][0], acc[ai][bj][m][1], off + bj * HALF); }
                    s = sum_fq(s);
                    if (fq == 0) ssq[(size_t)row * 32 + u.pn * 4 + wc] = s; } }
        }
    }
};

template <class Epi, class Sched, bool ALIGN_EPI = false, bool SP2 = false>
__device__ __forceinline__ void gemm_phase(PG8_LAS unsigned char* lds, const Gemm g, const Sched& S, const Epi& E, int tid_in) {
    const int tid = tid_in, wid = __builtin_amdgcn_readfirstlane(tid >> 6), lane = tid & 63, wr = wid >> 2, wc = wid & 3, fr = lane & 15, fq = lane >> 4;
    const int K = g.K, nt = K / BK;
    unsigned voffA[2], voffB[2];
#pragma unroll
    for (int i = 0; i < 2; ++i) { int R, C; stage_rc(tid * 16 + i * 8192, R, C); const int Rb = Epi::PERM ? ((R & ~31) + perm32(R & 31)) : R;
        const int Ra = Epi::APERM ? (128 * ((R >> 6) & 1) + 8 * (R & 15) + ((R >> 4) & 3)) : R; voffA[i] = (unsigned)(Ra * K + C) * 2u; voffB[i] = (unsigned)(Rb * K + C) * 2u; }
    const size_t kstep = (size_t)(BK * 2);
    const size_t hstep = (size_t)HALF * K * 2;
    const size_t tstep = 2 * hstep; const size_t hstepA = Epi::APERM ? (size_t)4 * K * 2 : hstep;
    const unsigned ldsw = (unsigned)wid * 1024u;
    const int aoff = lds_byte(wr * 64 + fr, fq * 8), boff = lds_byte(wc * 32 + fr, fq * 8);
#define PG8_SA(b, h) (((b) * 2 + (h)) * HTB)
#define PG8_SB(b, h) ((4 + (b) * 2 + (h)) * HTB)
#define PG8_STAGE(bufoff, gbase, voff) do { _Pragma("unroll") for (int _i = 0; _i < 2; ++_i) \
        __builtin_amdgcn_global_load_lds((const unsigned*)((const char*)(gbase) + (voff)[_i]), (PG8_LAS unsigned*)(lds + (bufoff) + ldsw + _i * 8192), 16, 0, 0); } while (0)
#define PG8_LDA(dst, b, h) do { _Pragma("unroll") for (int m = 0; m < 4; ++m) _Pragma("unroll") for (int k = 0; k < 2; ++k) dst[m][k] = *(const PG8_LAS bf16x8*)(lds + PG8_SA(b, h) + aoff + m * 2048 + k * 1024); } while (0)
#define PG8_LDB(dst, b, h) do { _Pragma("unroll") for (int n = 0; n < 2; ++n) _Pragma("unroll") for (int k = 0; k < 2; ++k) dst[n][k] = *(const PG8_LAS bf16x8*)(lds + PG8_SB(b, h) + boff + n * 2048 + k * 1024); } while (0)
#define PG8_MMA(ai, bj, At, Bt) do { __builtin_amdgcn_s_setprio(1); _Pragma("unroll") for (int m = 0; m < 4; ++m) _Pragma("unroll") for (int n = 0; n < 2; ++n) _Pragma("unroll") for (int k = 0; k < 2; ++k) \
        acc[ai][bj][m][n] = __builtin_amdgcn_mfma_f32_16x16x32_bf16(Bt[n][k], At[m][k], acc[ai][bj][m][n], 0, 0, 0); __builtin_amdgcn_s_setprio(0); } while (0)
#define PG8_WAIT_V(n) asm volatile("s_waitcnt vmcnt(" #n ")" ::: "memory")
#define PG8_WAIT_L(n) asm volatile("s_waitcnt lgkmcnt(" #n ")" ::: "memory")
#define PG8_BAR __builtin_amdgcn_s_barrier()
#define PG8_SCHED __builtin_amdgcn_sched_barrier(0)
    Unit cur, nxt; int ui = 0;
    if (!S.next(0, cur)) return;
    f32x4 acc[2][2][4][2];
#pragma unroll
    for (int a = 0; a < 2; ++a)
#pragma unroll
        for (int b = 0; b < 2; ++b)
#pragma unroll
            for (int m = 0; m < 4; ++m)
#pragma unroll
                for (int n = 0; n < 2; ++n) acc[a][b][m][n] = (f32x4){0.f, 0.f, 0.f, 0.f};
    bf16x8 At[4][2], B0[2][2], B1[2][2];
    const char* cA = (const char*)g.A + (size_t)cur.pm * tstep; const char* cB = (const char*)g.Bt + (size_t)cur.pn * tstep;
    cur.par = 0; S.a_ready(cur);
    if constexpr (Epi::PREP) E.prep(cur, tid);
    if constexpr (SP2) {
        PG8_STAGE(PG8_SB(0, 0), cB, voffB); PG8_STAGE(PG8_SB(0, 1), cB + hstep, voffB); PG8_STAGE(PG8_SA(0, 0), cA, voffA); PG8_STAGE(PG8_SA(0, 1), cA + hstepA, voffA);
        if (wr == 1) PG8_BAR;
        PG8_WAIT_V(2); PG8_BAR;
        PG8_STAGE(PG8_SB(1, 0), cB + kstep, voffB); PG8_STAGE(PG8_SA(1, 0), cA + kstep, voffA); PG8_STAGE(PG8_SB(1, 1), cB + hstep + kstep, voffB);
        PG8_WAIT_V(6); PG8_BAR;
    } else {
        PG8_STAGE(PG8_SB(0, 0), cB, voffB); PG8_STAGE(PG8_SA(0, 0), cA, voffA); PG8_STAGE(PG8_SB(0, 1), cB + hstep, voffB); PG8_STAGE(PG8_SA(0, 1), cA + hstepA, voffA);
        if (wr == 1) PG8_BAR;
        PG8_WAIT_V(4); PG8_BAR;
        PG8_STAGE(PG8_SB(1, 0), cB + kstep, voffB); PG8_STAGE(PG8_SA(1, 0), cA + kstep, voffA); PG8_STAGE(PG8_SB(1, 1), cB + hstep + kstep, voffB);
        PG8_WAIT_V(6); PG8_BAR;
    }
    for (;;) {
        const bool has_next = S.next(ui + 1, nxt);
        const char* nA = has_next ? (const char*)g.A + (size_t)nxt.pm * tstep : cA; const char* nB = has_next ? (const char*)g.Bt + (size_t)nxt.pn * tstep : cB;
#ifdef PROBE_K2
        const int ntl = (Epi::PROBE_ID == PROBE_K2) ? 2 * nt : nt;
#define PG8_KT(x) ((x) % nt)
#else
        const int ntl = nt;
#define PG8_KT(x) (x)
#endif
        for (int t = 0; t < ntl; t += 2) {
            const bool last = (t == ntl - 2);
            const char* a1 = cA + (size_t)PG8_KT(t + 1) * kstep;
            const char* a2 = last ? nA : cA + (size_t)PG8_KT(t + 2) * kstep; const char* b2 = last ? nB : cB + (size_t)PG8_KT(t + 2) * kstep;
            const char* a3 = a2 + kstep; const char* b3 = b2 + kstep;
            if (last && has_next) { nxt.par = (ui + 1) & 1; S.a_ready(nxt); if constexpr (Epi::PREP) E.prep(nxt, tid); }
            if constexpr (Epi::MIDK) { if (t == nt / 2) E.mid(acc, cur, wr, wc, fr, fq); }
            if constexpr (SP2) {
            PG8_LDB(B0, 0, 0); PG8_LDB(B1, 0, 1); PG8_SCHED; PG8_LDA(At, 0, 0); PG8_STAGE(PG8_SA(1, 1), a1 + hstepA, voffA);
            PG8_WAIT_V(8); PG8_WAIT_L(0); PG8_BAR; PG8_MMA(0, 0, At, B0); PG8_MMA(0, 1, At, B1); PG8_BAR; PG8_SCHED;
            PG8_LDA(At, 0, 1); PG8_STAGE(PG8_SB(0, 0), b2, voffB); PG8_STAGE(PG8_SB(0, 1), b2 + hstep, voffB); PG8_STAGE(PG8_SA(0, 0), a2, voffA);
            PG8_WAIT_V(8); PG8_WAIT_L(0); PG8_BAR; PG8_MMA(1, 0, At, B0); PG8_MMA(1, 1, At, B1); PG8_BAR; PG8_SCHED;
            PG8_LDB(B0, 1, 0); PG8_LDB(B1, 1, 1); PG8_SCHED; PG8_LDA(At, 1, 0); PG8_STAGE(PG8_SA(0, 1), a2 + hstepA, voffA);
            PG8_WAIT_V(8); PG8_WAIT_L(0); PG8_BAR; PG8_MMA(0, 0, At, B0); PG8_MMA(0, 1, At, B1); PG8_BAR; PG8_SCHED;
            PG8_LDA(At, 1, 1); PG8_STAGE(PG8_SB(1, 0), b3, voffB); PG8_STAGE(PG8_SB(1, 1), b3 + hstep, voffB); PG8_STAGE(PG8_SA(1, 0), a3, voffA);
            PG8_WAIT_V(8); PG8_WAIT_L(0); PG8_BAR; PG8_MMA(1, 0, At, B0); PG8_MMA(1, 1, At, B1); PG8_BAR; PG8_SCHED;
            } else {
            PG8_LDB(B0, 0, 0); PG8_SCHED; PG8_LDA(At, 0, 0); PG8_STAGE(PG8_SA(1, 1), a1 + hstepA, voffA);
            PG8_WAIT_L(8); PG8_BAR; PG8_WAIT_L(0); PG8_MMA(0, 0, At, B0); PG8_BAR; PG8_SCHED;
            PG8_LDB(B1, 0, 1); PG8_STAGE(PG8_SB(0, 0), b2, voffB);
            PG8_BAR; PG8_WAIT_L(0); PG8_MMA(0, 1, At, B1); PG8_BAR;
            PG8_LDA(At, 0, 1); PG8_STAGE(PG8_SA(0, 0), a2, voffA);
            PG8_BAR; PG8_WAIT_L(0); PG8_MMA(1, 0, At, B0); PG8_BAR; PG8_SCHED;
            PG8_STAGE(PG8_SB(0, 1), b2 + hstep, voffB);
            PG8_WAIT_V(6); PG8_BAR; PG8_MMA(1, 1, At, B1); PG8_BAR;
            PG8_LDB(B0, 1, 0); PG8_SCHED; PG8_LDA(At, 1, 0); PG8_STAGE(PG8_SA(0, 1), a2 + hstepA, voffA);
            PG8_WAIT_L(8); PG8_BAR; PG8_WAIT_L(0); PG8_MMA(0, 0, At, B0); PG8_BAR; PG8_SCHED;
            PG8_LDB(B1, 1, 1); PG8_STAGE(PG8_SB(1, 0), b3, voffB);
            PG8_BAR; PG8_WAIT_L(0); PG8_MMA(0, 1, At, B1); PG8_BAR;
            PG8_LDA(At, 1, 1); PG8_STAGE(PG8_SA(1, 0), a3, voffA);
            PG8_BAR; PG8_WAIT_L(0); PG8_MMA(1, 0, At, B0); PG8_BAR; PG8_SCHED;
            PG8_STAGE(PG8_SB(1, 1), b3 + hstep, voffB);
            PG8_WAIT_V(6); PG8_BAR; PG8_MMA(1, 1, At, B1); PG8_BAR;
            }
        }
        if constexpr (ALIGN_EPI) { if (wr == 0) PG8_BAR; }
#ifdef PROBE_K2
        if constexpr (Epi::PROBE_ID == PROBE_K2) {
#pragma unroll
            for (int a_ = 0; a_ < 2; ++a_)
#pragma unroll
                for (int b_ = 0; b_ < 2; ++b_)
#pragma unroll
                    for (int m_ = 0; m_ < 4; ++m_)
#pragma unroll
                        for (int n_ = 0; n_ < 2; ++n_) acc[a_][b_][m_][n_] *= 0.5f; }
#endif
        if constexpr (!Epi::AFTER_DRAIN) { E(acc, cur, wr, wc, fr, fq);
#ifdef PROBE_EPI2
            if constexpr (Epi::PROBE_ID == PROBE_EPI2) { asm volatile("s_waitcnt vmcnt(0)" ::: "memory"); __builtin_amdgcn_sched_barrier(0); E(acc, cur, wr, wc, fr, fq); }
#endif
            S.done(cur); }
        if (!has_next) break;
#pragma unroll
        for (int a = 0; a < 2; ++a)
#pragma unroll
            for (int b = 0; b < 2; ++b)
#pragma unroll
                for (int m = 0; m < 4; ++m)
#pragma unroll
                    for (int n = 0; n < 2; ++n) acc[a][b][m][n] = (f32x4){0.f, 0.f, 0.f, 0.f};
        cur = nxt; cA = nA; cB = nB; ++ui;
        if constexpr (ALIGN_EPI) { if (wr == 1) PG8_BAR; }
    }
    PG8_WAIT_V(0);
    if constexpr (!ALIGN_EPI) { if (wr == 0) PG8_BAR; }
    PG8_BAR;
    if constexpr (Epi::AFTER_DRAIN) { E.fused(acc, cur, wr, wc, fr, fq, lds, wid, lane); S.done(cur); }
#undef PG8_KT
#undef PG8_SA
#undef PG8_SB
#undef PG8_STAGE
#undef PG8_LDA
#undef PG8_LDB
#undef PG8_MMA
#undef PG8_WAIT_V
#undef PG8_WAIT_L
#undef PG8_BAR
#undef PG8_SCHED
}
}

namespace fa {
constexpr int D = 128, LDQ = 1024, LDO = 2048, NW = 8, QBLK = 32, KVBLK = 64, QB = NW * QBLK;
constexpr int SHM_V = KVBLK * D * 2, SHM_K = KVBLK * D * 2;
constexpr int LDS_ATT = 2 * SHM_V + 2 * SHM_K + NW * 64 * 4;
constexpr int TAB_OFF = 69632;
constexpr float SCALE = 0.08838834764831845f, THR = 8.f;
constexpr bool WSKIP = false;
typedef short bf16x8 __attribute__((ext_vector_type(8)));
typedef short s16x4 __attribute__((ext_vector_type(4)));
typedef float f32x16 __attribute__((ext_vector_type(16)));
typedef float f32x4 __attribute__((ext_vector_type(4)));
typedef unsigned u32x4 __attribute__((ext_vector_type(4)));
template <class A, class Bt> struct same_t { static constexpr bool v = false; };
template <class A> struct same_t<A, A> { static constexpr bool v = true; };

#define KSWZ(row, colB) ((row) * 256 + ((colB) ^ (((row) & 7) << 4)))
#define SBAR() __builtin_amdgcn_sched_barrier(0)
__device__ __forceinline__ int v_st(int k, int c) { const int kk = (k & ~0xC) | ((k & 4) << 1) | ((k & 8) >> 1); return ((kk >> 3) * 4 + (c >> 5)) * 512 + ((kk & 7) * 32 + (c & 31)) * 2; }
__device__ __forceinline__ int v_rd_base(int lane) { return ((lane & 3) << 3) | (((lane >> 2) & 3) << 6) | (((lane >> 4) & 1) << 5) | (((lane >> 5) & 1) << 8); }
constexpr int v_rd_off(int d0, int ks, int half) { return d0 * 512 + ks * 4096 + half * 2048; }
__device__ __forceinline__ int crow(int r, int hi) { return (r & 3) + 8 * (r >> 2) + 4 * hi; }
__device__ __forceinline__ unsigned cvtpk(float lo, float hi) { return ::cvt_pk_bf16(lo, hi); }
__device__ __forceinline__ bf16x8 pack8(f32x4 a, f32x4 b) {
    u32x4 w = {cvtpk(a[0], a[1]), cvtpk(a[2], a[3]), cvtpk(b[0], b[1]), cvtpk(b[2], b[3])};
    return *reinterpret_cast<bf16x8*>(&w);
}
template <class T> __device__ __forceinline__ bf16x8 load8(const T* p) {
    if constexpr (same_t<T, float>::v) { return pack8(*(const f32x4*)p, *(const f32x4*)(p + 4)); }
    else { return *reinterpret_cast<const bf16x8*>(p); }
}
__device__ __forceinline__ void mask_tile(f32x16& p0, f32x16& p1, int dq, unsigned W) {
    const float NEG = -__builtin_inff();
#pragma unroll
    for (int r = 0; r < 16; ++r) {
        const int c = (r & 3) + 8 * (r >> 2);
        if ((unsigned)(dq - c) >= W) p0[r] = NEG;
        if ((unsigned)(dq - c - 32) >= W) p1[r] = NEG;
    }
}
__device__ __forceinline__ void partialSM(f32x16& p0, f32x16& p1, float& m_reg, float& mn, float& alpha, bool& dead) {
    float pmax = p0[0]; for (int r = 1; r < 16; ++r) pmax = fmaxf(pmax, p0[r]); for (int r = 0; r < 16; ++r) pmax = fmaxf(pmax, p1[r]);
    { auto rr = __builtin_amdgcn_permlane32_swap(__float_as_uint(pmax), __float_as_uint(pmax), false, false);
      pmax = fmaxf(__uint_as_float(rr[0]), __uint_as_float(rr[1])); }
    constexpr float C2 = 1.4426950408889634f * SCALE;
    if (__builtin_expect(__all((pmax - m_reg) * SCALE <= THR), 1)) { mn = m_reg; alpha = 1.f; }
    else { mn = fmaxf(m_reg, pmax); alpha = __builtin_amdgcn_exp2f((m_reg - mn) * C2); m_reg = mn; }
    dead = __all((pmax - mn) * C2 < -160.f);
    if (dead) return;
    const float mnL = -mn * C2;
    for (int r = 0; r < 16; ++r) p0[r] = fmaf(p0[r], C2, mnL); for (int r = 0; r < 16; ++r) p1[r] = fmaf(p1[r], C2, mnL);
    for (int r = 0; r < 16; ++r) p0[r] = __builtin_amdgcn_exp2f(p0[r]);
}
__device__ __forceinline__ void finishSM(f32x16& p0, f32x16& p1, float alpha, float& l_reg, bf16x8& pa0, bf16x8& pa1, bf16x8& pa2, bf16x8& pa3) {
    for (int r = 0; r < 16; ++r) p1[r] = __builtin_amdgcn_exp2f(p1[r]);
    float ps = 0; for (int r = 0; r < 16; ++r) ps += p0[r]; for (int r = 0; r < 16; ++r) ps += p1[r];
    { auto rr = __builtin_amdgcn_permlane32_swap(__float_as_uint(ps), __float_as_uint(ps), false, false);
      ps = __uint_as_float(rr[0]) + __uint_as_float(rr[1]); }
    l_reg = l_reg * alpha + ps;
#define PK4(P, B_, OUT) do { unsigned a0 = cvtpk(P[B_+0], P[B_+1]), a1 = cvtpk(P[B_+2], P[B_+3]);                          \
        unsigned b0 = cvtpk(P[B_+4], P[B_+5]), b1 = cvtpk(P[B_+6], P[B_+7]);                                             \
        auto r0 = __builtin_amdgcn_permlane32_swap(a0, b0, false, false); auto r1 = __builtin_amdgcn_permlane32_swap(a1, b1, false, false); \
        u32x4 w = {r0[0], r1[0], r0[1], r1[1]}; OUT = *reinterpret_cast<bf16x8*>(&w); } while (0)
    PK4(p0, 0, pa0); PK4(p0, 8, pa1); PK4(p1, 0, pa2); PK4(p1, 8, pa3);
#undef PK4
}
template <int KB, bool SK>
__device__ __forceinline__ void qkt(f32x16& p0, f32x16& p1, const char* K_lds, int r32, int hi, const bf16x8* qr, bool act, const __attribute__((address_space(3))) float* tb) {
    if (SK && !act) { const float NEG = -__builtin_inff();
#pragma unroll
        for (int r = 0; r < 16; ++r) { p0[r] = NEG; p1[r] = NEG; } return; }
#pragma unroll
    for (int j_ = 0; j_ < 4; ++j_) { const f32x4 b0_ = *(const __attribute__((address_space(3))) f32x4*)(tb + 8 * j_), b1_ = *(const __attribute__((address_space(3))) f32x4*)(tb + 32 + 8 * j_);
        p0[4 * j_] = b0_[0]; p0[4 * j_ + 1] = b0_[1]; p0[4 * j_ + 2] = b0_[2]; p0[4 * j_ + 3] = b0_[3]; p1[4 * j_] = b1_[0]; p1[4 * j_ + 1] = b1_[1]; p1[4 * j_ + 2] = b1_[2]; p1[4 * j_ + 3] = b1_[3]; }
    const char* kb[4];
#pragma unroll
    for (int dd = 0; dd < 4; ++dd) kb[dd] = K_lds + KB * SHM_K + KSWZ(r32, (dd * 16 + hi * 8) * 2);
#pragma unroll
    for (int d0 = 0; d0 < 8; ++d0) { const char* a = kb[d0 & 3] + (d0 >> 2) * 128;
        bf16x8 b0 = *reinterpret_cast<const bf16x8*>(a);
        bf16x8 b1 = *reinterpret_cast<const bf16x8*>(a + 32 * 256);
        p0 = __builtin_amdgcn_mfma_f32_32x32x16_bf16(b0, qr[d0], p0, 0, 0, 0);
        p1 = __builtin_amdgcn_mfma_f32_32x32x16_bf16(b1, qr[d0], p1, 0, 0, 0); }
}
template <int VB, bool SK>
__device__ __forceinline__ void pv_tile(f32x16* o, int vb0, bf16x8 pa0, bf16x8 pa1, bf16x8 pa2, bf16x8 pa3, bool act) {
    if (SK && !act) return;
#define TRRD(dst, off) asm volatile("ds_read_b64_tr_b16 %0, %1 offset:%2" : "=&v"(dst) : "v"(vb0), "i"(off) : "memory")
#define PV_D0(d0) do { s16x4 l0, l1, l2, l3, h0, h1, h2, h3; constexpr int b_ = VB * SHM_V + v_rd_off(d0, 0, 0);     \
        TRRD(l0, b_); TRRD(h0, b_ + 2048); TRRD(l1, b_ + 4096); TRRD(h1, b_ + 6144); TRRD(l2, b_ + 8192); TRRD(h2, b_ + 10240); TRRD(l3, b_ + 12288); TRRD(h3, b_ + 14336); \
        asm volatile("s_waitcnt lgkmcnt(0)" ::: "memory"); SBAR();                 \
        o[d0] = __builtin_amdgcn_mfma_f32_32x32x16_bf16(pa0, (bf16x8){l0[0], l0[1], l0[2], l0[3], h0[0], h0[1], h0[2], h0[3]}, o[d0], 0, 0, 0);   \
        o[d0] = __builtin_amdgcn_mfma_f32_32x32x16_bf16(pa1, (bf16x8){l1[0], l1[1], l1[2], l1[3], h1[0], h1[1], h1[2], h1[3]}, o[d0], 0, 0, 0);   \
        o[d0] = __builtin_amdgcn_mfma_f32_32x32x16_bf16(pa2, (bf16x8){l2[0], l2[1], l2[2], l2[3], h2[0], h2[1], h2[2], h2[3]}, o[d0], 0, 0, 0);   \
        o[d0] = __builtin_amdgcn_mfma_f32_32x32x16_bf16(pa3, (bf16x8){l3[0], l3[1], l3[2], l3[3], h3[0], h3[1], h3[2], h3[3]}, o[d0], 0, 0, 0); } while (0)
    PV_D0(0); PV_D0(1); PV_D0(2); PV_D0(3);
#undef PV_D0
#undef TRRD
}
template <class TIn, class TOut> struct BlockRef { const TIn* Q; const TIn* K; const TIn* V; TOut* O; int P0; };
template <class TIn> struct Seam {
    bf16x8 qr[8];
    bf16x8 st_v0, st_v1, st_k0, st_k1; f32x4 sf0, sf1, sf2, sf3;
    f32x4 tq[16];
};
__device__ __forceinline__ int swa_jlo(int P0, int W) { const int lowk = P0 - W + 1; return lowk > 0 ? lowk / KVBLK : 0; }
__device__ __forceinline__ int swa_jhi(int P0) { return (P0 + QB - 1) / KVBLK + 1; }
#define ROW(p, k0, rr) ((p) + (unsigned)(((k0) + (rr)) * LDQ + sc))
#define VMW() asm volatile("s_waitcnt vmcnt(0)" ::: "memory")
#define VMWN(n) asm volatile("s_waitcnt vmcnt(%0)" :: "i"(n) : "memory")
#define SLOAD_H(Kp, Vp, k0) do { S.st_v0 = load8<TIn>(ROW(Vp, k0, sr)); S.st_v1 = load8<TIn>(ROW(Vp, k0, 32 + sr));              \
                         S.st_k0 = load8<TIn>(ROW(Kp, k0, sr)); S.st_k1 = load8<TIn>(ROW(Kp, k0, 32 + sr)); } while (0)
#define SWRITE_HK(bf) do { *(bf16x8*)(K_lds + (bf) * SHM_K + kws) = S.st_k0; *(bf16x8*)(K_lds + (bf) * SHM_K + kws + 32 * 256) = S.st_k1; } while (0)
#define SWRITE_HV(bf) do { *(bf16x8*)(V_lds + (bf) * SHM_V + vst0) = S.st_v0; *(bf16x8*)(V_lds + (bf) * SHM_V + vst1) = S.st_v1; } while (0)
#define SWRITE_H(bf) do { SWRITE_HV(bf); SWRITE_HK(bf); } while (0)
#define SLOAD_F(p, k0) do { S.sf0 = *(const f32x4*)ROW(p, k0, sr); S.sf1 = *(const f32x4*)(ROW(p, k0, sr) + 4);                \
                            S.sf2 = *(const f32x4*)ROW(p, k0, 32 + sr); S.sf3 = *(const f32x4*)(ROW(p, k0, 32 + sr) + 4); } while (0)
#define SWRITE_KF(bf) do { *(bf16x8*)(K_lds + (bf) * SHM_K + kws) = pack8(S.sf0, S.sf1); *(bf16x8*)(K_lds + (bf) * SHM_K + kws + 32 * 256) = pack8(S.sf2, S.sf3); } while (0)
#define SWRITE_VF(bf) do { *(bf16x8*)(V_lds + (bf) * SHM_V + vst0) = pack8(S.sf0, S.sf1); *(bf16x8*)(V_lds + (bf) * SHM_V + vst1) = pack8(S.sf2, S.sf3); } while (0)
template <class TIn, class TOut>
__device__ __forceinline__ void causal_swa_prime(const BlockRef<TIn, TOut>& cur, int W, char* lds, Seam<TIn>& S, int tid_in) {
    constexpr bool F32 = same_t<TIn, float>::v;
    const int tid = tid_in, wid = __builtin_amdgcn_readfirstlane(tid >> 6), lane = tid & 63, r32 = lane & 31, hi = lane >> 5;
    const int sr = tid >> 4, sc = (tid & 15) * 8, kws = KSWZ(sr, sc * 2); char* K_lds = lds + 2 * SHM_V;
    const int kb0 = (swa_jhi(cur.P0) - 1) * KVBLK;
    for (int d0 = 0; d0 < 8; ++d0) S.qr[d0] = load8<TIn>(cur.Q + (unsigned)((wid * QBLK + r32) * LDQ + d0 * 16 + hi * 8));
    if constexpr (F32) { SLOAD_F((const float*)cur.K, kb0); VMW(); SWRITE_KF(0); SBAR(); SLOAD_F((const float*)cur.V, kb0); }
    else { SLOAD_H(cur.K, cur.V, kb0); VMW(); SWRITE_HK(0); }
    __syncthreads();
}
template <class TIn, class TOut>
__device__ __forceinline__ void causal_swa_block(const BlockRef<TIn, TOut>& cur, const BlockRef<TIn, TOut>& nxt, int skv, int W, char* lds, Seam<TIn>& S, int tid_in) {
    constexpr bool F32 = same_t<TIn, float>::v;
    const int tid = tid_in, wid = __builtin_amdgcn_readfirstlane(tid >> 6), lane = tid & 63, r32 = lane & 31, hi = lane >> 5;
    const int j_lo = swa_jlo(cur.P0, W);
    int j_hi = (cur.P0 + QB - 1) / KVBLK + 1; if (j_hi > skv / KVBLK) j_hi = skv / KVBLK;
    const int NT = j_hi - j_lo;
    const int kbn = (swa_jhi(nxt.P0) - 1) * KVBLK;
    const int qlo = cur.P0 + wid * QBLK, qm = qlo + r32 - 4 * hi;
    char* V_lds = lds; char* K_lds = lds + 2 * SHM_V;
    float* ws = (float*)(lds + 2 * SHM_V + 2 * SHM_K) + wid * 64; float* li_l = ws, * al_l = ws + 32;
    float m_reg = -1e30f, l_reg = 0; f32x16 o[4] = {};
    const int sr = tid >> 4, sc = (tid & 15) * 8, vst0 = v_st(sr, sc), vst1 = v_st(32 + sr, sc), kws = KSWZ(sr, sc * 2);
    const int vb0 = (int)(uintptr_t)V_lds + v_rd_base(lane);
    const TIn* Kh = cur.K; const TIn* Vh = cur.V;
#define RESC(a) do { if (__any((a) < 1.f)) { if (hi == 0) al_l[r32] = (a); asm volatile("s_waitcnt lgkmcnt(0)" ::: "memory");              \
                     for (int d_ = 0; d_ < 4; ++d_) for (int r = 0; r < 16; ++r) o[d_][r] *= al_l[crow(r, hi)]; } } while (0)
#define KBASE(t) ((j_hi - 1 - (t)) * KVBLK)
    const __attribute__((address_space(3))) float* tabh = (const __attribute__((address_space(3))) float*)(lds + TAB_OFF) + 4 * hi;
#define BIAS(P0_, P1_, t) do { const __attribute__((address_space(3))) float* tb_ = tabh + KBASE(t); _Pragma("unroll") for (int j_ = 0; j_ < 4; ++j_) { const f32x4 b0_ = *(const __attribute__((address_space(3))) f32x4*)(tb_ + 8 * j_), b1_ = *(const __attribute__((address_space(3))) f32x4*)(tb_ + 32 + 8 * j_); \
        P0_[4 * j_] += b0_[0]; P0_[4 * j_ + 1] += b0_[1]; P0_[4 * j_ + 2] += b0_[2]; P0_[4 * j_ + 3] += b0_[3]; P1_[4 * j_] += b1_[0]; P1_[4 * j_ + 1] += b1_[1]; P1_[4 * j_ + 2] += b1_[2]; P1_[4 * j_ + 3] += b1_[3]; } } while (0)
#define ACT(t) (KBASE(t) <= qlo + QBLK - 1 && KBASE(t) + KVBLK - 1 >= qlo - W + 1)
#define MASKT(P0_, P1_, t) do { const int kb_ = KBASE(t); if ((!SK || ACT(t)) && (kb_ + KVBLK - 1 > qlo || kb_ <= qlo + QBLK - 1 - W)) mask_tile(P0_, P1_, qm - kb_, (unsigned)W); } while (0)
    constexpr int NQL = F32 ? 16 : 8;
    constexpr bool SK = WSKIP && !F32;
#define SEAM_K0() do { VMWN(NQL); if constexpr (F32) { SWRITE_KF(0); SBAR(); SLOAD_F((const float*)nxt.V, kbn); } else { SWRITE_HK(0); } SBAR(); } while (0)
    f32x16 pA0, pA1, pB0, pB1; float mnA, mnB, alA, alB; bf16x8 pa0, pa1, pa2, pa3;
    if constexpr (F32) { VMW(); SWRITE_VF(0); SBAR(); } else { SWRITE_HV(0); SBAR(); }
    if (NT > 1) { if constexpr (F32) SLOAD_F((const float*)Kh, KBASE(1)); else SLOAD_H(Kh, Vh, KBASE(1)); }
    SBAR(); qkt<0, SK>(pA0, pA1, K_lds, r32, hi, S.qr, ACT(0), tabh + KBASE(0));
    if constexpr (F32) { if (NT > 1) { VMW(); SWRITE_KF(1); SBAR(); SLOAD_F((const float*)Vh, KBASE(1)); } }
    bool deadA = false, deadB = false;
    MASKT(pA0, pA1, 0); partialSM(pA0, pA1, m_reg, mnA, alA, deadA);
    if (NT > 1) { VMW(); if constexpr (F32) { SWRITE_VF(1); SBAR(); if (NT > 2) SLOAD_F((const float*)Kh, KBASE(2)); } else SWRITE_H(1); }
    __syncthreads();
#define HALF_STEP(PX0, PX1, mnX, alX, PY0, PY1, alY, t, KB, VB, SB, dX, dY) do {                                                      \
        SBAR(); qkt<KB, SK>(PX0, PX1, K_lds, r32, hi, S.qr, ACT(t), tabh + KBASE(t));                                             \
        if (!(dY)) finishSM(PY0, PY1, alY, l_reg, pa0, pa1, pa2, pa3); SBAR();                                                \
        if ((t) + 1 < NT) { if constexpr (F32) { VMW(); SWRITE_KF(SB); SBAR(); SLOAD_F((const float*)Vh, KBASE((t) + 1)); }  \
                            else { SLOAD_H(Kh, Vh, KBASE((t) + 1)); } SBAR(); }                                               \
        if (!(dY)) pv_tile<VB, SK>(o, vb0, pa0, pa1, pa2, pa3, ACT((t) - 1)); MASKT(PX0, PX1, (t)); partialSM(PX0, PX1, m_reg, mnX, alX, dX);                                        \
        __syncthreads();                                                                                                      \
        if ((t) + 1 < NT) { VMW(); if constexpr (F32) { SWRITE_VF(SB); SBAR(); if ((t) + 2 < NT) SLOAD_F((const float*)Kh, KBASE((t) + 2)); } \
                            else { SWRITE_H(SB); } }                                                                          \
        RESC(alX); __syncthreads(); } while (0)
    for (int t = 1; t + 1 < NT; t += 2) {
        HALF_STEP(pB0, pB1, mnB, alB, pA0, pA1, alA, t, 1, 0, 0, deadB, deadA);
        HALF_STEP(pA0, pA1, mnA, alA, pB0, pB1, alB, t + 1, 0, 1, 1, deadA, deadB);
    }
    const bool even = (NT & 1) == 0;
    if (even) { SBAR(); qkt<1, SK>(pB0, pB1, K_lds, r32, hi, S.qr, ACT(NT - 1), tabh + KBASE(NT - 1)); SBAR(); }
#define QROW(e) (nxt.Q + (size_t)(wid * QBLK + r32) * LDQ + ((e) >> 1) * 16 + hi * 8 + ((e) & 1) * 4)
    if constexpr (F32) { SLOAD_F((const float*)nxt.K, kbn); SBAR();
#pragma unroll
        for (int e = 0; e < 8; ++e) S.tq[e] = *(const f32x4*)QROW(e); }
    else { SLOAD_H(nxt.K, nxt.V, kbn); SBAR();
#pragma unroll
        for (int d0 = 0; d0 < 8; ++d0) S.qr[d0] = load8<TIn>(nxt.Q + (unsigned)((wid * QBLK + r32) * LDQ + d0 * 16 + hi * 8)); }
    SBAR();
    if (!deadA) finishSM(pA0, pA1, alA, l_reg, pa0, pa1, pa2, pa3); SBAR();
    if constexpr (F32) {
#pragma unroll
        for (int e = 8; e < 16; ++e) S.tq[e] = *(const f32x4*)QROW(e); SBAR(); }
#undef QROW
    if (!deadA) pv_tile<0, SK>(o, vb0, pa0, pa1, pa2, pa3, ACT(even ? NT - 2 : NT - 1));
    if (even) { MASKT(pB0, pB1, NT - 1); partialSM(pB0, pB1, m_reg, mnB, alB, deadB); __syncthreads(); RESC(alB);
        if (!deadB) { finishSM(pB0, pB1, alB, l_reg, pa0, pa1, pa2, pa3); SBAR(); pv_tile<1, SK>(o, vb0, pa0, pa1, pa2, pa3, ACT(NT - 1)); } }
    SBAR(); SEAM_K0();
    if (hi == 0) li_l[r32] = l_reg; asm volatile("s_waitcnt lgkmcnt(0)" ::: "memory");
    float rli[16];
#pragma unroll
    for (int r = 0; r < 16; ++r) rli[r] = __builtin_amdgcn_rcpf(li_l[crow(r, hi)]);
    TOut* Ow = cur.O + (unsigned)((wid * QBLK) * LDO);
#pragma unroll
    for (int r = 0; r < 16; ++r) { const int orow = crow(r, hi);
#pragma unroll
        for (int d0 = 0; d0 < 4; ++d0) { const float v = o[d0][r] * rli[r];
            if constexpr (same_t<TOut, float>::v) { Ow[(size_t)orow * LDO + d0 * 32 + r32] = v; }
            else { const float vn = __int_as_float(__builtin_amdgcn_update_dpp(0, __float_as_int(v), 0xB1, 0xf, 0xf, true));
                   if ((r32 & 1) == 0) *(unsigned*)(Ow + (unsigned)(orow * LDO + d0 * 32 + r32)) = cvtpk(v, vn); } } }
    if constexpr (F32) {
#pragma unroll
        for (int d0 = 0; d0 < 8; ++d0) S.qr[d0] = pack8(S.tq[2 * d0], S.tq[2 * d0 + 1]); }
    __syncthreads();
#undef RESC
#undef KBASE
#undef BIAS
#undef ACT
#undef MASKT
#undef SEAM_K0
#undef HALF_STEP
}
#undef ROW
#undef VMW
#undef VMWN
#undef SLOAD_H
#undef SWRITE_HK
#undef SWRITE_HV
#undef SWRITE_H
#undef SLOAD_F
#undef SWRITE_KF
#undef SWRITE_VF


}

constexpr size_t MiB = (size_t)1 << 20;
constexpr size_t WS_CTL = 0, CTL_ZERO_BYTES = 1 * MiB;
constexpr size_t WS_WF = 1 * MiB;
constexpr size_t WS_SSQ = 2 * MiB;
constexpr size_t WS_CL = 4 * MiB;
constexpr size_t WS_TOT = 5 * MiB;
constexpr size_t WS_SSQV = 6 * MiB;
constexpr size_t WS_WTRIL = 7 * MiB;
constexpr size_t WS_W = 8 * MiB, W_LAYER = 118 * MiB;
constexpr size_t W_IN = 0, W_A = 36 * MiB, W_B = 40 * MiB, W_OUT = 44 * MiB, W_UP = 52 * MiB, W_DOWN = 96 * MiB;
constexpr size_t WS_X = 480 * MiB;
constexpr size_t WS_XB = 608 * MiB;
constexpr size_t WS_R1 = 672 * MiB;
constexpr size_t WS_YA = 960 * MiB, WS_YB = 992 * MiB, WS_MG = 1024 * MiB;
constexpr size_t WS_G = 1088 * MiB;
constexpr size_t WS_SIDEA = WS_R1, WS_SIDEH = WS_R1 + 4 * MiB;
constexpr size_t WS_END = 1264 * MiB;
constexpr int CW_BAR = 4096;

constexpr int LDS_BYTES = 160 * 1024;
constexpr int MISC_OFF = LDS_BYTES - 256, ARGS_OFF = LDS_BYTES - 512, HALO_OFF = 131072;

#define XB_TMO      128
#define XB_XCNT(j)  (256  + 64 * (j))
#define XB_XSUB(j)  (1280 + 64 * (j))
#define XB_XGEN(j)  (2304 + 64 * (j))
#define XB_TOP      3328
#define XB_TOPGEN   3392
#define XCD_BAR_WORDS 3456
#define XB_SPIN_CAP (1u << 18)

__device__ __forceinline__ unsigned xb_ld(unsigned* p)              { return __hip_atomic_load(p, __ATOMIC_RELAXED, __HIP_MEMORY_SCOPE_AGENT); }
__device__ __forceinline__ unsigned xb_add(unsigned* p, unsigned v) { return __hip_atomic_fetch_add(p, v, __ATOMIC_RELAXED, __HIP_MEMORY_SCOPE_AGENT); }
__device__ __forceinline__ unsigned xb_xcc_id() { return (unsigned)__builtin_amdgcn_s_getreg((3 << 11) | 20) & 0xFu; }
#define XB_SPIN(cond, bar) do { unsigned _sp = 0; while (cond) { __builtin_amdgcn_s_sleep(1); \
    if ((++_sp & 255u) == 0u) { if (xb_ld(&(bar)[XB_TMO])) break; if (_sp > XB_SPIN_CAP) { atomicAdd(&(bar)[XB_TMO], 1u); break; } } } } while (0)

struct XcdBarrier {
    unsigned* bar; unsigned x;
    volatile LAS unsigned* st;
};

__device__ __forceinline__ XcdBarrier xcd_barrier_post(unsigned* bar, volatile LAS unsigned* st) {
    XcdBarrier b; b.bar = bar; b.x = xb_xcc_id(); b.st = st;
    if (threadIdx.x == 0) (void)xb_add(&bar[XB_XCNT(b.x)], 1u);
    return b;
}
__device__ __forceinline__ void xcd_barrier_complete(unsigned* bar, unsigned x, unsigned& nloc, unsigned& nx) {
    const unsigned G = gridDim.x * gridDim.y * gridDim.z;
    unsigned sum, cnt, mine, sp = 0u;
    for (;;) {
        sum = 0u; cnt = 0u; mine = 0u;
#pragma unroll
        for (unsigned j = 0; j < 16; ++j) { const unsigned c = xb_ld(&bar[XB_XCNT(j)]); sum += c; cnt += (c > 0u) ? 1u : 0u; mine = (j == x) ? c : mine; }
        if (sum == G) break;
        __builtin_amdgcn_s_sleep(1);
        if ((++sp & 255u) == 0u) { if (xb_ld(&bar[XB_TMO])) break; if (sp > XB_SPIN_CAP) { atomicAdd(&bar[XB_TMO], 1u); break; } }
    }
    nloc = mine > 0u ? mine : 1u; nx = cnt > 0u ? cnt : 1u;
}

__device__ __forceinline__ void xcd_barrier(const XcdBarrier& b, int tid_in) {
    asm volatile("s_waitcnt vmcnt(0)" ::: "memory");
    __syncthreads();
    if (tid_in == 0) {
        unsigned* bar = b.bar;
        __builtin_amdgcn_s_waitcnt(0);
        unsigned nloc = b.st[0], nx = b.st[1];
        if (nloc == 0u) { xcd_barrier_complete(bar, b.x, nloc, nx); b.st[0] = nloc; b.st[1] = nx; }
        const unsigned old = xb_add(&bar[XB_XSUB(b.x)], 1u);
        const unsigned gen = old / nloc;
        if (old + 1u == (gen + 1u) * nloc) {
            __builtin_amdgcn_fence(__ATOMIC_RELEASE, "agent");
            asm volatile("s_waitcnt vmcnt(0)" ::: "memory");
            const unsigned og = xb_add(&bar[XB_TOP], 1u);
            const unsigned tg = og / nx;
            if (og + 1u == (tg + 1u) * nx) xb_add(&bar[XB_TOPGEN], 1u);
            else XB_SPIN(xb_ld(&bar[XB_TOPGEN]) == tg, bar);
            __builtin_amdgcn_fence(__ATOMIC_ACQUIRE, "agent");
            xb_add(&bar[XB_XGEN(b.x)], 1u);
            asm volatile("s_waitcnt vmcnt(0)" ::: "memory");
        } else {
            XB_SPIN(xb_ld(&bar[XB_XGEN(b.x)]) == gen, bar);
            __builtin_amdgcn_fence(__ATOMIC_ACQUIRE, "agent");
            asm volatile("s_waitcnt vmcnt(0)" ::: "memory");
        }
    }
    __syncthreads();
}

struct Args { const float* in[16]; float* out; unsigned char* ws; int ph_lo, ph_hi; };
enum { IN_X = 0, IN_GMIX, IN_WIN, IN_BF, IN_GSGU, IN_WSP, IN_BSP, IN_WA, IN_WB, IN_WOUT, IN_GFFN, IN_WUP, IN_CW, IN_CB, IN_WDOWN, IN_GFIN };

struct TrJob { const float* src; const float* gain; bf16* dst; int ldS, srcCol0, K, dstRow0, k0, dk; unsigned gmask; };
__device__ __forceinline__ TrJob tr_decode(const Args& a, int j) {
    constexpr int J_IN = 16 * 72, J_A = 8 * 16, J_OUT = 16 * 16, J_UP = 16 * 88, J_DOWN = 44 * 16, J_LAYER = J_IN + 2 * J_A + J_OUT + J_UP + J_DOWN;
    const int l = j / J_LAYER; int r = j % J_LAYER; unsigned char* wl = a.ws + WS_W + (size_t)l * W_LAYER; TrJob t; t.gain = a.in[IN_GMIX]; t.gmask = 0u; t.dk = 0;
    if (r < J_IN) { const int tn = r % 72, kt = r / 72; t.src = a.in[IN_WIN] + (size_t)l * DM * INW; t.ldS = INW; t.srcCol0 = tn < 24 ? tn * 128 : (tn < 40 ? tn * 128 + 8 : (((tn - 40) & 1) ? 7176 : 5128) + ((tn - 40) >> 1) * 128);
        t.gain = a.in[IN_GMIX] + l * DM; t.gmask = ~0u; t.dst = (bf16*)(wl + W_IN); t.K = DM; t.dstRow0 = tn * 128; t.k0 = kt * 128; return t; } r -= J_IN;
    if (r < J_A) { const int tn = r % 16, kt = r / 16; t.src = a.in[IN_WA] + (size_t)l * FW * DM; t.ldS = DM; t.srcCol0 = tn * 128; t.dst = (bf16*)(wl + W_A); t.K = DM; t.dstRow0 = tn * 128; t.k0 = kt * 128; return t; } r -= J_A;
    if (r < J_A) { const int tn = r % 16, kt = r / 16; t.src = a.in[IN_WB] + (size_t)l * SW * DM; t.ldS = DM; t.srcCol0 = tn * 128; t.dst = (bf16*)(wl + W_A); t.K = DM; t.dstRow0 = tn * 128; t.k0 = kt * 128; t.dk = FW; return t; } r -= J_A;
    if (r < J_OUT) { const int tn = r % 16, kt = r / 16; t.src = a.in[IN_WOUT] + (size_t)l * DM * DM; t.ldS = DM; t.srcCol0 = tn * 128; t.dst = (bf16*)(wl + W_OUT); t.K = DM; t.dstRow0 = tn * 128; t.k0 = kt * 128; return t; } r -= J_OUT;
    if (r < J_UP) { const int tn = r % 88, kt = r / 88; t.src = a.in[IN_WUP] + (size_t)l * DM * NUP; t.ldS = NUP; t.srcCol0 = (tn & 1) * DFF + (tn >> 1) * 128; t.gain = a.in[IN_GFFN] + l * DM; t.gmask = ~0u; t.dst = (bf16*)(wl + W_UP); t.K = DM; t.dstRow0 = tn * 128; t.k0 = kt * 128; return t; } r -= J_UP;
    { const int tn = r % 16, kt = r / 16; t.src = a.in[IN_WDOWN] + (size_t)l * DFF * DM; t.ldS = DM; t.srcCol0 = tn * 128; t.dst = (bf16*)(wl + W_DOWN); t.K = DFF; t.dstRow0 = tn * 128; t.k0 = kt * 128; return t; }
}
__device__ __forceinline__ void tr_load(const TrJob& t, int tid, f32x4 (&v)[8], float (&g)[8]) {
    const int kr = tid >> 5, c4 = tid & 31;
#pragma unroll
    for (int i = 0; i < 8; ++i) { const int k = t.k0 + kr + 16 * i; v[i] = *(const f32x4*)(t.src + (size_t)k * t.ldS + t.srcCol0 + 4 * c4);
        g[i] = t.gain[k]; }
}
__device__ __forceinline__ void tr_step(const Args& a, unsigned char* lds, int tid, int j, int G, int J_TOTAL, int buf, f32x4 (&v)[8], float (&g)[8]) {
    const int kr = tid >> 5, c4 = tid & 31;
    const TrJob t = tr_decode(a, j); float* T = (float*)(lds + buf * 66048);
#pragma unroll
    for (int i = 0; i < 8; ++i) { float* tp = T + (kr + 16 * i) * 129 + 4 * c4; const float gi = __builtin_bit_cast(float, (__builtin_bit_cast(unsigned, g[i]) & t.gmask) | (0x3f800000u & ~t.gmask));
        tp[0] = v[i][0] * gi; tp[1] = v[i][1] * gi; tp[2] = v[i][2] * gi; tp[3] = v[i][3] * gi; }
    if (j + 2 * G < J_TOTAL) { const TrJob tn_ = tr_decode(a, j + 2 * G); tr_load(tn_, tid, v, g); }
    __syncthreads();
#pragma unroll
    for (int i = 0; i < 4; ++i) { const int idx = tid + 512 * i, n = idx >> 4, kc = idx & 15; const float* tp = T + (8 * kc) * 129 + n;
        u32x4 w; w.x = cvt_pk_bf16(tp[0], tp[129]); w.y = cvt_pk_bf16(tp[2 * 129], tp[3 * 129]); w.z = cvt_pk_bf16(tp[4 * 129], tp[5 * 129]); w.w = cvt_pk_bf16(tp[6 * 129], tp[7 * 129]);
        *(u32x4*)(t.dst + (size_t)(t.dstRow0 + n) * t.K + t.dk + t.k0 + 8 * kc) = w; }
}
__device__ __forceinline__ void ph_rowstats(const float* src, bf16* xb, float* ssq, int gw, int ngw, int lane) {
    for (int row = gw; row < MTOK; row += ngw) {
        const f32x4* p = (const f32x4*)(src + (size_t)row * DM) + lane; f32x4 v[8]; float s = 0.f;
#pragma unroll
        for (int j = 0; j < 8; ++j) { v[j] = p[64 * j]; s += (v[j][0] * v[j][0] + v[j][1] * v[j][1]) + (v[j][2] * v[j][2] + v[j][3] * v[j][3]); }
        s = wave_sum(s);
        u32x2* o = (u32x2*)(xb + (size_t)row * DM) + lane;
#pragma unroll
        for (int j = 0; j < 8; ++j) { u32x2 w; w.x = cvt_pk_bf16(v[j][0], v[j][1]); w.y = cvt_pk_bf16(v[j][2], v[j][3]); o[64 * j] = w; }
        if (lane < 32) ssq[(size_t)row * 32 + lane] = lane == 0 ? s : 0.f;
    }
}
__device__ __forceinline__ void ph_prologue(const Args& a, unsigned char* lds, int tid, int lane, int wave, int bx, int G) {
    unsigned char* ws = a.ws;
    constexpr int J_TOTAL = DEPTH * (16 * 72 + 2 * 8 * 16 + 16 * 16 + 16 * 88 + 44 * 16);
    { f32x4 va[8], vb[8]; float ga[8], gb[8]; int j = bx;
      if (j < J_TOTAL) { const TrJob t = tr_decode(a, j); tr_load(t, tid, va, ga); }
      if (j + G < J_TOTAL) { const TrJob t = tr_decode(a, j + G); tr_load(t, tid, vb, gb); }
      for (;;) {
          if (j >= J_TOTAL) break;
          tr_step(a, lds, tid, j, G, J_TOTAL, 0, va, ga);
          j += G; if (j >= J_TOTAL) break;
          tr_step(a, lds, tid, j, G, J_TOTAL, 1, vb, gb);
          j += G;
      }
      __syncthreads(); }
    { bf16* wf = (bf16*)(ws + WS_WF);
      for (int i = bx * 512 + tid; i < DEPTH * 16 * DM; i += G * 512) { const int k = i % DM, h = (i / DM) % 16, l = i / (DM * 16);
          wf[i] = h < NH ? f2bf(a.in[IN_WIN][((size_t)l * DM + k) * INW + 3 * FW + h] * a.in[IN_GMIX][l * DM + k]) : (bf16)0; } }
    { bf16* wt = (bf16*)(ws + WS_WTRIL); const float* wsp = a.in[IN_WSP];
      for (int i = bx * 512 + tid; i < DEPTH * NG * SCH * SCH; i += G * 512) { const int s_ = i & 127, t_ = (i >> 7) & 127; wt[i] = f2bf(s_ <= t_ ? wsp[i] : 0.f); } }
    ph_rowstats(a.in[IN_X], (bf16*)(ws + WS_XB), (float*)(ws + WS_SSQ), bx * 8 + wave, G * 8, lane);
}

__device__ __forceinline__ void f_unit(const Args& a, int l, int u, unsigned char* lds, int tid, int lane, int wave) {
    unsigned char* ws = a.ws; const bf16* xb = (const bf16*)(ws + WS_XB); const bf16* wf = (const bf16*)(ws + WS_WF) + (size_t)l * 16 * DM; const float* ssq = (const float*)(ws + WS_SSQ);
    float* part = (float*)lds;
    float* lf = (float*)(lds + 16384);
    float* invl = (float*)(lds + 16384 + 2048);
    const int r16 = lane & 15, q = lane >> 4, kb = wave * 256, tok0 = u * 64;
    f32x4 acc[4];
#pragma unroll
    for (int tb = 0; tb < 4; ++tb) acc[tb] = (f32x4){0.f, 0.f, 0.f, 0.f};
    const bf16* wrow = wf + (size_t)r16 * DM + kb + 8 * q; const bf16* xrow = xb + (size_t)(tok0 + r16) * DM + kb + 8 * q;
#pragma unroll
    for (int kh = 0; kh < 2; ++kh) { bf16x8 wv[4], xv[4][4];
#pragma unroll
        for (int k4 = 0; k4 < 4; ++k4) { const int ks = 4 * kh + k4; wv[k4] = *(const bf16x8*)(wrow + 32 * ks);
#pragma unroll
            for (int tb = 0; tb < 4; ++tb) xv[k4][tb] = *(const bf16x8*)(xrow + (size_t)(16 * tb) * DM + 32 * ks); }
        __builtin_amdgcn_sched_barrier(0);
#pragma unroll
        for (int k4 = 0; k4 < 4; ++k4)
#pragma unroll
            for (int tb = 0; tb < 4; ++tb) acc[tb] = __builtin_amdgcn_mfma_f32_16x16x32_bf16(wv[k4], xv[k4][tb], acc[tb], 0, 0, 0);
        __builtin_amdgcn_sched_barrier(0); }
    if (q < 2) {
#pragma unroll
        for (int tb = 0; tb < 4; ++tb) *(f32x4*)(part + (size_t)((wave * 64 + 16 * tb + r16) * 8 + 4 * q)) = acc[tb]; }
    if (tid < 64) { const f32x4* p = (const f32x4*)(ssq + (size_t)(tok0 + tid) * 32); float s = 0.f;
#pragma unroll
        for (int j = 0; j < 8; ++j) { const f32x4 v = p[j]; s += (v[0] + v[1]) + (v[2] + v[3]); }
        invl[tid] = rsqrtf(s * (1.0f / DM) + RMS_EPS); }
    __syncthreads();
    { const int token = tid >> 3, h = tid & 7; float s = 0.f;
#pragma unroll
      for (int w = 0; w < 8; ++w) s += part[(w * 64 + token) * 8 + h];
      lf[tid] = log_sigmoid_f(s * invl[token] + a.in[IN_BF][l * NH + h]); }
    __syncthreads();
    if (tid < 8) { float run = 0.f; for (int t = 0; t < 64; ++t) { run += lf[t * 8 + tid]; lf[t * 8 + tid] = run; }
        ((float*)(ws + WS_TOT))[u * 8 + tid] = run; }
    __syncthreads();
    { float* cl = (float*)(ws + WS_CL); const int b = u >> 6, c64 = u & 63; const int tl = tid & 63, h = tid >> 6; cl[((size_t)(b * NH + h)) * SEQ + c64 * 64 + tl] = lf[tl * 8 + h]; }
    __syncthreads();
}

__device__ __forceinline__ void attn_table(const float* cl, const float* tot, char* lds, int bh, int tid) {
    float* tab = (float*)(lds + fa::TAB_OFF); float* pre = tab + SEQ; const int b = bh >> 3, h = bh & 7;
    __syncthreads();
    if (tid < 64) { float s = 0.f; for (int j = 0; j < tid; ++j) s += tot[(b * 64 + j) * 8 + h]; pre[tid] = s; }
    __syncthreads();
    for (int i = tid; i < SEQ; i += 512) tab[i] = -(cl[(size_t)bh * SEQ + i] + pre[i >> 6]) * 11.313708498984761f;
    __syncthreads();
}
__device__ __forceinline__ fa::BlockRef<bf16, bf16> attn_ref(const bf16* Qb, const bf16* Kb, const bf16* Vb, bf16* Ob, int bh, int qb) {
    const int b = bh >> 3, h = bh & 7; const size_t rq = (size_t)(b * SEQ + qb * 256) * 1024 + h * HD, rk = (size_t)(b * SEQ) * 1024 + h * HD, ro = (size_t)(b * SEQ + qb * 256) * 2048 + h * HD;
    fa::BlockRef<bf16, bf16> r; r.Q = Qb + rq; r.O = Ob + ro; r.K = Kb + rk; r.V = Vb + rk; r.P0 = qb * 256; return r;
}
#define MK_TID(t_) int t_; { int l_; asm volatile("v_mbcnt_lo_u32_b32 %0, -1, 0\n\tv_mbcnt_hi_u32_b32 %0, -1, %0" : "=v"(l_)); t_ = wave * 64 + l_; }
__device__ __forceinline__ void attn_fast(unsigned char* ws, unsigned char* ldsg, int wave, int bx, int G) {
    char* lds = (char*)ldsg;
    const bf16* Qb = (const bf16*)(ws + WS_R1); const bf16* Kb = Qb + (size_t)MTOK * 1024; const bf16* Vb = Kb + (size_t)MTOK * 1024; bf16* Ob = (bf16*)(ws + WS_YA);
    const float* cl = (const float*)(ws + WS_CL); const float* tot = (const float*)(ws + WS_TOT);
    const int total = NB * NH * 8, stride = G, W = SEQ;
    int L = bx;
    if (L < total) {
#define FA_DEC(L_, bh_, x_) do { bh_ = (((L_) >> 6) << 3) + ((L_) & 7); x_ = ((L_) >> 3) & 7; } while (0)
        int bh, x, pass = 0; FA_DEC(L, bh, x);
        fa::BlockRef<bf16, bf16> cur = attn_ref(Qb, Kb, Vb, Ob, bh, x);
        fa::Seam<bf16> S;
        { MK_TID(t0); attn_table(cl, tot, lds, bh, t0); fa::causal_swa_prime<bf16, bf16>(cur, W, lds, S, t0); }
        for (;;) {
            const bool more_pass = pass == 0, more_item = L + stride < total, last = !more_pass && !more_item;
            int bhn = bh, xn = x, passn = pass + 1, Ln = L;
            if (!more_pass) { passn = 0; Ln = more_item ? L + stride : L; FA_DEC(Ln, bhn, xn); }
            const fa::BlockRef<bf16, bf16> nxt = last ? cur : attn_ref(Qb, Kb, Vb, Ob, passn ? (bhn ^ 4) : bhn, passn ? 15 - xn : xn);
            { MK_TID(t1); fa::causal_swa_block<bf16, bf16>(cur, nxt, SEQ, W, lds, S, t1); }
            if (last) break;
            { MK_TID(t2); attn_table(cl, tot, lds, passn ? (bhn ^ 4) : bhn, t2); }
            cur = nxt; bh = bhn; x = xn; pass = passn; L = Ln;
        }
#undef FA_DEC
    }
    __syncthreads();
}

__device__ __forceinline__ void sgu_fast(const Args& a, int l, unsigned char* lds, int tid, int lane, int wave, int bx, int G) {
    unsigned char* ws = a.ws; const bf16* GU = (const bf16*)(ws + WS_R1) + (size_t)3 * MTOK * 1024; const bf16* GVT = GU + (size_t)MTOK * 1024; bf16* YB = (bf16*)(ws + WS_YA);
    const float* ssqv = (const float*)(ws + WS_SSQV); const bf16* Wt = (const bf16*)(ws + WS_WTRIL) + (size_t)l * NG * SCH * SCH;
    const float* gs = a.in[IN_GSGU] + l * SW; const float* bsp = a.in[IN_BSP] + (size_t)l * NG * SCH;
    float* invl = (float*)lds;
    const int r16 = lane & 15, q = lane >> 4, nks = (wave >> 1) + 1;
    constexpr int NUNIT = (MTOK / SCH) * NG;
    __syncthreads();
    for (int i = tid; i < 8 * SCH; i += 512) { const int unit = bx + (i >> 7) * G; if (unit < NUNIT) { const int tok = (unit >> 3) * SCH + (i & 127);
            const f32x4* p = (const f32x4*)(ssqv + (size_t)tok * 16); float s = 0.f;
#pragma unroll
            for (int k = 0; k < 4; ++k) { const f32x4 v = p[k]; s += (v[0] + v[1]) + (v[2] + v[3]); }
            invl[i] = rsqrtf(s * (1.0f / SW) + RMS_EPS); } }
    __syncthreads();
    int ui = 0;
    for (int unit = bx; unit < NUNIT; unit += G, ++ui) {
        const int n = unit >> 3, g = unit & 7, tok0 = n * SCH; const float* invu = invl + (ui & 7) * SCH;
        if (ui >= 8) break;
        f32x4 acc[8];
#pragma unroll
        for (int cb = 0; cb < 8; ++cb) acc[cb] = (f32x4){0.f, 0.f, 0.f, 0.f};
        const bf16* wrow = Wt + ((size_t)g * SCH + 16 * wave + r16) * SCH + 8 * q;
        const bf16* vrow = GVT + ((size_t)n * SW + g * GD + r16) * SCH + 8 * q;
#pragma unroll
        for (int kp = 0; kp < 2; ++kp) if (2 * kp < nks) {
            const bool two = 2 * kp + 1 < nks; u32x4 wr2[2]; bf16x8 vf2[2][8]; f32x4 i0[2], i1[2];
#pragma unroll
            for (int j = 0; j < 2; ++j) { const int ks = (j == 0 || two) ? 2 * kp + j : 2 * kp;
                wr2[j] = *(const u32x4*)(wrow + 32 * ks); i0[j] = *(const f32x4*)(invu + 32 * ks + 8 * q); i1[j] = *(const f32x4*)(invu + 32 * ks + 8 * q + 4);
#pragma unroll
                for (int cb = 0; cb < 8; ++cb) vf2[j][cb] = *(const bf16x8*)(vrow + (size_t)(16 * cb) * SCH + 32 * ks); }
            __builtin_amdgcn_sched_barrier(0);
#pragma unroll
            for (int j = 0; j < 2; ++j) if (j == 0 || two) { const u32x4 wr_ = wr2[j];
                u32x4 wp; wp.x = cvt_pk_bf16(bf_lo(wr_.x) * i0[j][0], bf_hi(wr_.x) * i0[j][1]); wp.y = cvt_pk_bf16(bf_lo(wr_.y) * i0[j][2], bf_hi(wr_.y) * i0[j][3]);
                wp.z = cvt_pk_bf16(bf_lo(wr_.z) * i1[j][0], bf_hi(wr_.z) * i1[j][1]); wp.w = cvt_pk_bf16(bf_lo(wr_.w) * i1[j][2], bf_hi(wr_.w) * i1[j][3]);
                const bf16x8 wf = __builtin_bit_cast(bf16x8, wp);
#pragma unroll
                for (int cb = 0; cb < 8; ++cb) acc[cb] = __builtin_amdgcn_mfma_f32_16x16x32_bf16(vf2[j][cb], wf, acc[cb], 0, 0, 0); }
            __builtin_amdgcn_sched_barrier(0);
        }
        const int t = 16 * wave + r16; const float bt = bsp[g * SCH + t]; const size_t orow = (size_t)(tok0 + t) * SW + g * GD + 4 * q, yrow = (size_t)(tok0 + t) * DM + FW + g * GD + 4 * q;
        f32x4 gn8[8]; u32x2 gu8[8];
#pragma unroll
        for (int cb = 0; cb < 8; ++cb) { gn8[cb] = *(const f32x4*)(gs + g * GD + 16 * cb + 4 * q); gu8[cb] = *(const u32x2*)(GU + orow + 16 * cb); }
        __builtin_amdgcn_sched_barrier(0);
#pragma unroll
        for (int cb = 0; cb < 8; ++cb) { const f32x4 gn = gn8[cb]; const u32x2 gu = gu8[cb];
            const f32x2 g01 = gelu_tanh_pk((f32x2){bf_lo(gu.x), bf_hi(gu.x)}), g23 = gelu_tanh_pk((f32x2){bf_lo(gu.y), bf_hi(gu.y)});
            const float o0 = (gn[0] * acc[cb][0] + bt) * g01.x, o1 = (gn[1] * acc[cb][1] + bt) * g01.y, o2 = (gn[2] * acc[cb][2] + bt) * g23.x, o3 = (gn[3] * acc[cb][3] + bt) * g23.y;
            u32x2 w; w.x = cvt_pk_bf16(o0, o1); w.y = cvt_pk_bf16(o2, o3); *(u32x2*)(YB + yrow + 16 * cb) = w; }
    }
    __syncthreads();
}

__device__ __forceinline__ void sgu_simple(const Args& a, int l, unsigned char* lds, int tid, int lane, int wave, int bx, int G) {
    unsigned char* ws = a.ws; const bf16* GU = (const bf16*)(ws + WS_R1) + (size_t)3 * MTOK * 1024; const bf16* GV = GU + (size_t)MTOK * 1024; bf16* YB = (bf16*)(ws + WS_YB);
    float* vn = (float*)lds; float* Wl = (float*)(lds + 65536); float* inv = (float*)(lds + 131072);
    const float* gs = a.in[IN_GSGU] + l * SW; const float* wsp = a.in[IN_WSP] + (size_t)l * NG * SCH * SCH; const float* bsp = a.in[IN_BSP] + (size_t)l * NG * SCH;
    for (int unit = bx; unit < (MTOK / SCH) * NG; unit += G) {
        const int n = unit >> 3, g = unit & 7, tok0 = n * SCH;
        __syncthreads();
        for (int i = 0; i < 16; ++i) { const int s = wave * 16 + i; const bf16* r = GV + (size_t)(tok0 + s) * SW + lane * 16; float ss = 0.f;
#pragma unroll
            for (int q = 0; q < 2; ++q) { const u32x4 w = *(const u32x4*)(r + 8 * q); const float e[8] = {bf_lo(w.x), bf_hi(w.x), bf_lo(w.y), bf_hi(w.y), bf_lo(w.z), bf_hi(w.z), bf_lo(w.w), bf_hi(w.w)};
#pragma unroll
                for (int j = 0; j < 8; ++j) ss += e[j] * e[j]; }
            ss = wave_sum(ss); if (lane == 0) inv[s] = rsqrtf(ss * (1.0f / SW) + RMS_EPS); }
        __syncthreads();
        for (int i = tid; i < SCH * GD; i += 512) { const int s = i >> 7, c = i & 127;
            vn[i] = bf2f(GV[(size_t)(tok0 + s) * SW + g * GD + c]) * inv[s] * gs[g * GD + c];
            Wl[i] = wsp[(size_t)g * SCH * SCH + i]; }
        __syncthreads();
        { const int c = tid & 127, tq = tid >> 7;
          for (int t = tq; t < SCH; t += 4) { float acc = 0.f; for (int s = 0; s <= t; ++s) acc += Wl[t * SCH + s] * vn[s * GD + c];
              const size_t o = (size_t)(tok0 + t) * SW + g * GD + c;
              YB[o] = f2bf((acc + bsp[g * SCH + t]) * bf2f(GU[o])); } }
    }
    __syncthreads();
}

__device__ __forceinline__ void conv_simple(const Args& a, int l, int tid, int bx, int G) {
    unsigned char* ws = a.ws; const bf16* AR = (const bf16*)(ws + WS_R1); bf16* Gb = (bf16*)(ws + WS_G);
    const float* cw = a.in[IN_CW] + (size_t)l * 3 * DFF; const float* cb = a.in[IN_CB] + (size_t)l * DFF;
    constexpr int NCG = DFF / 8;
    for (size_t i = (size_t)bx * 512 + tid; i < (size_t)MTOK * NCG; i += (size_t)G * 512) {
        const int row = (int)(i / NCG), cg = (int)(i % NCG), s = row & (SEQ - 1); const size_t o = (size_t)row * DFF + 8 * cg;
        const u32x4 z = {0u, 0u, 0u, 0u};
        const u32x4 a0 = *(const u32x4*)(AR + o), a1 = s >= 1 ? *(const u32x4*)(AR + o - DFF) : z, a2 = s >= 2 ? *(const u32x4*)(AR + o - 2 * DFF) : z, bb = *(const u32x4*)(Gb + o);
        const float x0[8] = {bf_lo(a0.x), bf_hi(a0.x), bf_lo(a0.y), bf_hi(a0.y), bf_lo(a0.z), bf_hi(a0.z), bf_lo(a0.w), bf_hi(a0.w)};
        const float x1[8] = {bf_lo(a1.x), bf_hi(a1.x), bf_lo(a1.y), bf_hi(a1.y), bf_lo(a1.z), bf_hi(a1.z), bf_lo(a1.w), bf_hi(a1.w)};
        const float x2[8] = {bf_lo(a2.x), bf_hi(a2.x), bf_lo(a2.y), bf_hi(a2.y), bf_lo(a2.z), bf_hi(a2.z), bf_lo(a2.w), bf_hi(a2.w)};
        const float bv[8] = {bf_lo(bb.x), bf_hi(bb.x), bf_lo(bb.y), bf_hi(bb.y), bf_lo(bb.z), bf_hi(bb.z), bf_lo(bb.w), bf_hi(bb.w)};
        float r[8];
#pragma unroll
        for (int j = 0; j < 8; ++j) { const int c = 8 * cg + j; const float v = cb[c] + cw[c] * x2[j] + cw[DFF + c] * x1[j] + cw[2 * DFF + c] * x0[j]; r[j] = gelu_tanh(v) * bv[j]; }
        u32x4 w; w.x = cvt_pk_bf16(r[0], r[1]); w.y = cvt_pk_bf16(r[2], r[3]); w.z = cvt_pk_bf16(r[4], r[5]); w.w = cvt_pk_bf16(r[6], r[7]);
        *(u32x4*)(Gb + o) = w;
    }
}
__device__ __forceinline__ void conv_fixup_panel(const Args& a, int l, int pm, int tid) {
    unsigned char* ws = a.ws; bf16* Gb = (bf16*)(ws + WS_G); const float* sideA = (const float*)(ws + WS_SIDEA); const float* sideH = (const float*)(ws + WS_SIDEH);
    const float* cw = a.in[IN_CW] + (size_t)l * 3 * DFF; const float* cb = a.in[IN_CB] + (size_t)l * DFF;
    for (int c = 4 * tid; c < DFF; c += 4 * 512) {
        const f32x4 z = {0.f, 0.f, 0.f, 0.f};
        const f32x4 xm2 = (pm & 15) ? *(const f32x4*)(sideA + ((size_t)(pm - 1) * 2 + 0) * DFF + c) : z, xm1 = (pm & 15) ? *(const f32x4*)(sideA + ((size_t)(pm - 1) * 2 + 1) * DFF + c) : z;
        const float* sh = sideH + (size_t)pm * 4 * DFF + c; const f32x4 a0 = *(const f32x4*)sh, a1 = *(const f32x4*)(sh + DFF), b0 = *(const f32x4*)(sh + 2 * DFF), b1 = *(const f32x4*)(sh + 3 * DFF);
        const f32x4 w0 = *(const f32x4*)(cw + c), w1 = *(const f32x4*)(cw + DFF + c), w2 = *(const f32x4*)(cw + 2 * DFF + c), cbv = *(const f32x4*)(cb + c);
        float g0[4], g1[4];
#pragma unroll
        for (int k = 0; k < 4; ++k) { g0[k] = gelu_tanh(cbv[k] + w0[k] * xm2[k] + w1[k] * xm1[k] + w2[k] * a0[k]) * b0[k]; g1[k] = gelu_tanh(cbv[k] + w0[k] * xm1[k] + w1[k] * a0[k] + w2[k] * a1[k]) * b1[k]; }
        u32x2 w; w.x = cvt_pk_bf16(g0[0], g0[1]); w.y = cvt_pk_bf16(g0[2], g0[3]); *(u32x2*)(Gb + (size_t)(pm * 256) * DFF + c) = w;
        w.x = cvt_pk_bf16(g1[0], g1[1]); w.y = cvt_pk_bf16(g1[2], g1[3]); *(u32x2*)(Gb + (size_t)(pm * 256 + 1) * DFF + c) = w;
    }
    asm volatile("s_waitcnt vmcnt(0)" ::: "memory"); __syncthreads();
}
__device__ __forceinline__ void ph_final(const Args& a, int gw, int ngw, int lane) {
    const bf16* xb = (const bf16*)(a.ws + WS_XB); const f32x4* gf = (const f32x4*)a.in[IN_GFIN] + lane;
    f32x4 gfr[8];
#pragma unroll
    for (int j = 0; j < 8; ++j) gfr[j] = gf[64 * j];
    for (int row = gw; row < MTOK; row += ngw) {
        const u32x2* p = (const u32x2*)(xb + (size_t)row * DM) + lane; f32x4 v[8]; float s = 0.f;
#pragma unroll
        for (int j = 0; j < 8; ++j) { const u32x2 w = p[64 * j]; v[j] = (f32x4){bf_lo(w.x), bf_hi(w.x), bf_lo(w.y), bf_hi(w.y)}; s += (v[j][0] * v[j][0] + v[j][1] * v[j][1]) + (v[j][2] * v[j][2] + v[j][3] * v[j][3]); }
        s = wave_sum(s); const float inv = rsqrtf(s * (1.0f / DM) + RMS_EPS);
        f32x4* o = (f32x4*)(a.out + (size_t)row * DM) + lane;
#pragma unroll
        for (int j = 0; j < 8; ++j) o[64 * j] = (v[j] * inv) * gfr[j];
    }
}

#ifndef STAGGER_US
#define STAGGER_US 6
#endif
__device__ __forceinline__ void stagger_delay(int bx) {
    const unsigned long long t0 = __builtin_amdgcn_s_memrealtime(), d = (unsigned long long)((bx >> 3) & 7) * (STAGGER_US * 100);
    while (__builtin_amdgcn_s_memrealtime() - t0 < d) __builtin_amdgcn_s_sleep(8);
}
#ifndef WGM_IN
#define WGM_IN 4
#endif
#ifndef WGM_UP
#define WGM_UP 4
#endif
#ifndef WGM_BR
#define WGM_BR 2
#endif
#ifndef WGM_OUT
#define WGM_OUT 2
#endif
#ifndef WGM_DOWN
#define WGM_DOWN 2
#endif
constexpr int PH_PER_LAYER = 6, N_PHASES = 2 + DEPTH * PH_PER_LAYER;
#define PHASE_BEGIN() int wave = wave0; asm volatile("" : "+s"(wave)); int lane; asm volatile("v_mbcnt_lo_u32_b32 %0, -1, 0\n\tv_mbcnt_hi_u32_b32 %0, -1, %0" : "=v"(lane)); int tid = wave * 64 + lane; \
    int bx = blockIdx.x; asm volatile("" : "+s"(bx)); int G = gridDim.x; asm volatile("" : "+s"(G)); \
    Args A; _Pragma("unroll") for (int i_ = 0; i_ < 16; ++i_) A.in[i_] = (const float*)(GAS const float*)ldarg(ARGL, i_); \
    A.out = (float*)(GAS float*)ldarg(ARGL, 16); A.ws = (unsigned char*)(GAS unsigned char*)ldarg(ARGL, 17); A.ph_lo = 0; A.ph_hi = 0; \
    unsigned char* ws = A.ws; (void)lane; (void)wave; (void)ws; (void)bx; (void)G
__device__ __forceinline__ unsigned long long ldarg(volatile LAS unsigned long long* t, int i) {
    const unsigned long long v = t[i]; const unsigned lo = __builtin_amdgcn_readfirstlane((unsigned)v), hi = __builtin_amdgcn_readfirstlane((unsigned)(v >> 32));
    return ((unsigned long long)hi << 32) | lo;
}
__global__ void __launch_bounds__(512, 2) fwd_kernel(Args args) {
    extern __shared__ __attribute__((aligned(16))) unsigned char lds[];
    volatile LAS unsigned* MISC = (volatile LAS unsigned*)((LAS unsigned char*)lds + MISC_OFF);
    volatile LAS unsigned long long* ARGL = (volatile LAS unsigned long long*)((LAS unsigned char*)lds + ARGS_OFF);
    if (threadIdx.x < 64) MISC[threadIdx.x] = 0u;
    { unsigned long long v_ = 0ull;
#pragma unroll
      for (int i_ = 0; i_ < 16; ++i_) if ((int)threadIdx.x == i_) v_ = (unsigned long long)args.in[i_];
      if (threadIdx.x == 16) v_ = (unsigned long long)args.out; if (threadIdx.x == 17) v_ = (unsigned long long)args.ws;
      if (threadIdx.x < 18) ARGL[threadIdx.x] = v_; }
    __syncthreads();
    const int lo = args.ph_lo, hi = args.ph_hi, wave0 = __builtin_amdgcn_readfirstlane(threadIdx.x >> 6);
    unsigned* ctl = (unsigned*)(args.ws + WS_CTL);
    XcdBarrier bar; bar.bar = ctl + CW_BAR; bar.x = 0; bar.st = nullptr;
    if (hi - lo > 1) bar = xcd_barrier_post(ctl + CW_BAR, MISC + 8);
#define IN(k) (lo <= (k) && (k) < hi)
#ifndef ONLY_J
#define ONLY_J -1
#endif
#ifndef DBG_LAST_J
#define DBG_LAST_J 99
#endif
#define INL(j) ((ONLY_J < 0 || ONLY_J == (j)) && (j) <= DBG_LAST_J && IN(pb + (j)))
#ifndef DUP_MASK
#define DUP_MASK 0
#endif
#define REP(bit) for (int rep_ = 0; rep_ < (((DUP_MASK) >> (bit)) & 1) + 1; ++rep_)
#define SEAM(k) do { if (lo <= (k) && (k) + 1 < hi) { XcdBarrier b_ = bar; { GAS unsigned* p_ = (GAS unsigned*)b_.bar; asm volatile("" : "+s"(p_)); b_.bar = (unsigned*)p_; } xcd_barrier(b_, tid); } } while (0)
    LAS unsigned char* ring = (LAS unsigned char*)lds;

    if (IN(0)) { PHASE_BEGIN(); REP(0) ph_prologue(A, lds, tid, lane, wave, bx, G); SEAM(0); }

#ifdef DBG_DUMP
    for (int l = 0; l < 1; ++l) {
#else
    for (int l = 0; l < DEPTH; ++l) {
#endif
        const int pb = 1 + l * PH_PER_LAYER;
        if (INL(0)) { PHASE_BEGIN();  {
            REP(1) for (int u = bx; u < MTOK / 64; u += G) f_unit(A, l, u, lds, tid, lane, wave);
             { const unsigned char* wl = ws + WS_W + (size_t)l * W_LAYER;
            pg8::Gemm g{(const bf16*)(ws + WS_XB), (const bf16*)(wl + W_IN), MTOK, NIN, DM}; pg8::StaticOrder S; S.init(MTOK, NIN, G, bx, WGM_IN);
            pg8::EpiInProj2 E{(const float*)(ws + WS_SSQ), (bf16*)(ws + WS_R1), (float*)(ws + WS_SSQV), (LAS float*)(ring + HALO_OFF) + 256};
            pg8::gemm_phase<pg8::EpiInProj2, pg8::StaticOrder, true, true>(ring, g, S, E, tid); }  }
            SEAM(pb + 0);
        }
        if (INL(1)) { { PHASE_BEGIN(); (void)tid;  attn_fast(ws, lds, wave, bx, G);  } { PHASE_BEGIN();  sgu_fast(A, l, lds, tid, lane, wave, bx, G);  SEAM(pb + 1); } }
        if (INL(2)) { PHASE_BEGIN();  {
            const unsigned char* wl = ws + WS_W + (size_t)l * W_LAYER; bf16* R1 = (bf16*)(ws + WS_R1);
            pg8::Gemm g{(const bf16*)(ws + WS_YA), (const bf16*)(wl + W_A), MTOK, DM, DM}; pg8::StaticOrder S; S.init(MTOK, DM, G, bx, WGM_BR);
            pg8::EpiBranch E{R1 + (size_t)5 * MTOK * 1024, R1 + (size_t)5 * MTOK * 1024 + (size_t)MTOK * 2048, (bf16*)(ws + WS_MG)};
            pg8::gemm_phase<pg8::EpiBranch, pg8::StaticOrder, false, true>(ring, g, S, E, tid); }
            SEAM(pb + 2);
        }
        if (INL(3)) { PHASE_BEGIN();
            const unsigned char* wl = ws + WS_W + (size_t)l * W_LAYER;
            pg8::Gemm g{(const bf16*)(ws + WS_MG), (const bf16*)(wl + W_OUT), MTOK, DM, DM}; pg8::StaticOrder S; S.init(MTOK, DM, G, bx, WGM_OUT);
#ifdef PROBE_D
            { pg8::EpiResidB E{(const float*)nullptr, (bf16*)(ws + WS_R1 + 160 * MiB), (float*)(ws + WS_R1 + 230 * MiB)};
              pg8::gemm_phase<pg8::EpiResidB, pg8::StaticOrder, false, true>(ring, g, S, E, tid); }
#endif
            pg8::EpiResidB E{l == 0 ? A.in[IN_X] : (const float*)nullptr, (bf16*)(ws + WS_XB), (float*)(ws + WS_SSQ)};
            pg8::gemm_phase<pg8::EpiResidB, pg8::StaticOrder, false, true>(ring, g, S, E, tid);
            SEAM(pb + 3);
        }
        if (INL(4)) { PHASE_BEGIN();  {
            const unsigned char* wl = ws + WS_W + (size_t)l * W_LAYER;
            pg8::Gemm g{(const bf16*)(ws + WS_XB), (const bf16*)(wl + W_UP), MTOK, NUP, DM}; pg8::StaticOrder S; S.init(MTOK, NUP, G, bx, WGM_UP);
            pg8::EpiUpConv E{(const float*)(ws + WS_SSQ), (bf16*)(ws + WS_G), A.in[IN_CW] + (size_t)l * 3 * DFF, A.in[IN_CB] + (size_t)l * DFF, (float*)(ws + WS_SIDEA), (float*)(ws + WS_SIDEH), (LAS float*)(ring + HALO_OFF)};
            pg8::gemm_phase<pg8::EpiUpConv, pg8::StaticOrder, true, true>(ring, g, S, E, tid); }
            SEAM(pb + 4);
        }
        if (INL(5)) { PHASE_BEGIN();
            const unsigned char* wl = ws + WS_W + (size_t)l * W_LAYER;
            pg8::Gemm g{(const bf16*)(ws + WS_G), (const bf16*)(wl + W_DOWN), MTOK, DM, DFF}; pg8::StaticOrder S; S.init(MTOK, DM, G, bx, WGM_DOWN);
            { pg8::Unit u0, u1; if (S.next(0, u0)) { conv_fixup_panel(A, l, u0.pm, tid); for (int i_ = 1; S.next(i_, u1); ++i_) if (u1.pm != u0.pm) { conv_fixup_panel(A, l, u1.pm, tid); u0 = u1; } } }
#ifdef PROBE_F
            { pg8::EpiResidB E{(const float*)nullptr, (bf16*)(ws + WS_R1 + 160 * MiB), (float*)(ws + WS_R1 + 230 * MiB)};
              pg8::gemm_phase<pg8::EpiResidB, pg8::StaticOrder, false, true>(ring, g, S, E, tid); }
#endif
            pg8::EpiResidB E{(const float*)nullptr, (bf16*)(ws + WS_XB), (float*)(ws + WS_SSQ)};
            pg8::gemm_phase<pg8::EpiResidB, pg8::StaticOrder, false, true>(ring, g, S, E, tid);
            SEAM(pb + 5);
        }
    }
#ifdef DBG_DUMP
    if (IN(N_PHASES - 1)) { PHASE_BEGIN(); const bf16* src = (const bf16*)(ws + DBG_DUMP); for (size_t i = (size_t)bx * 512 + tid; i < (size_t)MTOK * DM / 2; i += (size_t)G * 512) { const unsigned w = ((const unsigned*)src)[i]; A.out[2 * i] = bf_lo(w); A.out[2 * i + 1] = bf_hi(w); } }
#else
    if (IN(N_PHASES - 1)) { PHASE_BEGIN(); REP(7) ph_final(A, bx * 8 + wave, G * 8, lane); }
#endif
#undef IN
#undef INL
#undef SEAM
}

#ifndef MK_LAUNCH_PER_PHASE
#define MK_LAUNCH_PER_PHASE 0
#endif
extern "C" void kernel_launch(void* const* d_in, const int* in_sizes, int n_in, void* d_out, int out_size, void* d_ws, size_t ws_size, hipStream_t stream) {
    static int grid = 0;
    if (grid == 0) {
        if (n_in != 16 || in_sizes[0] != MTOK * DM || out_size != MTOK * DM || ws_size < WS_END) { fprintf(stderr, "kernel_launch: unexpected shapes (n_in %d, in0 %d, out %d, ws %zu)\n", n_in, n_in > 0 ? in_sizes[0] : -1, out_size, ws_size); grid = -1; return; }
        int dev = 0, cus = 0, per_cu = 0;
        if (hipGetDevice(&dev) != hipSuccess || hipDeviceGetAttribute(&cus, hipDeviceAttributeMultiprocessorCount, dev) != hipSuccess) { grid = -1; return; }
        if (hipFuncSetAttribute((const void*)fwd_kernel, hipFuncAttributeMaxDynamicSharedMemorySize, LDS_BYTES) != hipSuccess) { fprintf(stderr, "kernel_launch: hipFuncSetAttribute failed\n"); grid = -1; return; }
        if (hipOccupancyMaxActiveBlocksPerMultiprocessor(&per_cu, (const void*)fwd_kernel, 512, LDS_BYTES) != hipSuccess || per_cu < 1) { fprintf(stderr, "kernel_launch: occupancy query reports %d\n", per_cu); }
        (void)hipGetLastError();
        grid = cus;
    }
    if (grid < 0) return;
    (void)hipMemsetAsync((char*)d_ws + WS_CTL, 0, CTL_ZERO_BYTES, stream);
    Args a; memset(&a, 0, sizeof(a));
    for (int i = 0; i < 16; ++i) a.in[i] = (const float*)d_in[i];
    a.out = (float*)d_out; a.ws = (unsigned char*)d_ws;
#if MK_LAUNCH_PER_PHASE
    for (int p = 0; p < N_PHASES; ++p) { a.ph_lo = p; a.ph_hi = p + 1; hipLaunchKernelGGL(fwd_kernel, dim3(grid), dim3(512), LDS_BYTES, stream, a); }
#else
    a.ph_lo = 0; a.ph_hi = N_PHASES; hipLaunchKernelGGL(fwd_kernel, dim3(grid), dim3(512), LDS_BYTES, stream, a);
#endif
}
```

```cpp
#include <hip/hip_runtime.h>
#include <cstdio>
#include <cstdint>
#include <cstring>

#define LAS __attribute__((address_space(3)))
#define GAS __attribute__((address_space(1)))
typedef unsigned short bf16;
typedef short bf16x8 __attribute__((ext_vector_type(8)));
typedef float f32x4 __attribute__((ext_vector_type(4)));
typedef float f32x2 __attribute__((ext_vector_type(2)));
typedef unsigned u32x4 __attribute__((ext_vector_type(4)));
typedef unsigned u32x2 __attribute__((ext_vector_type(2)));

constexpr int DM = 2048, NB = 4, SEQ = 4096, DEPTH = 4, MTOK = NB * SEQ;
constexpr int FW = 1024, NH = 8, HD = 128, SW = 1024, NG = 8, GD = 128, SCH = 128, DFF = 5632, INW = 9224, NIN = 9216, NUP = 2 * DFF;
constexpr float RMS_EPS = 1e-6f;
constexpr float ATT_SCALE = 0.08838834764831845f;

__device__ __forceinline__ float bf_lo(unsigned w) { return __uint_as_float(w << 16); }
__device__ __forceinline__ float bf_hi(unsigned w) { return __uint_as_float(w & 0xffff0000u); }
__device__ __forceinline__ float bf2f(bf16 b) { return __uint_as_float(((unsigned)b) << 16); }
typedef __bf16 bf16x2_n __attribute__((ext_vector_type(2)));
__device__ __forceinline__ unsigned cvt_pk_bf16(float lo, float hi) { const f32x2 v = {lo, hi}; return __builtin_bit_cast(unsigned, __builtin_convertvector(v, bf16x2_n)); }
__device__ __forceinline__ bf16 f2bf(float f) { return (bf16)(cvt_pk_bf16(f, 0.f) & 0xffffu); }
__device__ __forceinline__ float gelu_tanh(float x) {
    const float e = __builtin_amdgcn_exp2f(x * ((x * x) * (-0.10294323956f) + (-2.3022081983308417f)));
    return x * __builtin_amdgcn_rcpf(1.0f + e);
}
__device__ __forceinline__ f32x2 gelu_tanh_pk(f32x2 v) {
    const f32x2 arg = v * ((v * v) * (-0.10294323956f) + (-2.3022081983308417f));
    f32x2 e; e.x = __builtin_amdgcn_exp2f(arg.x); e.y = __builtin_amdgcn_exp2f(arg.y);
    const f32x2 d = e + 1.0f; f32x2 r; r.x = __builtin_amdgcn_rcpf(d.x); r.y = __builtin_amdgcn_rcpf(d.y);
    return v * r;
}
__device__ __forceinline__ float sigmoid_f(float x) { return __builtin_amdgcn_rcpf(1.0f + __builtin_amdgcn_exp2f(-1.4426950408889634f * x)); }
__device__ __forceinline__ float log_sigmoid_f(float z) { return fminf(z, 0.f) - 0.6931471805599453f * __builtin_amdgcn_logf(1.0f + __builtin_amdgcn_exp2f(-1.4426950408889634f * fabsf(z))); }
__device__ __forceinline__ float lane_xor_swz16(float v) { return __int_as_float(__builtin_amdgcn_ds_swizzle(__float_as_int(v), (16 << 10) | 0x1F)); }
__device__ __forceinline__ float sum_xor32(float v) { const auto rr = __builtin_amdgcn_permlane32_swap(__float_as_uint(v), __float_as_uint(v), false, false); return __uint_as_float(rr[0]) + __uint_as_float(rr[1]); }
__device__ __forceinline__ float sum_fq(float s) { s += lane_xor_swz16(s); return sum_xor32(s); }
__device__ __forceinline__ float wave_sum(float v) {
    v += __int_as_float(__builtin_amdgcn_ds_swizzle(__float_as_int(v), (1 << 10) | 0x1F)); v += __int_as_float(__builtin_amdgcn_ds_swizzle(__float_as_int(v), (2 << 10) | 0x1F));
    v += __int_as_float(__builtin_amdgcn_ds_swizzle(__float_as_int(v), (4 << 10) | 0x1F)); v += __int_as_float(__builtin_amdgcn_ds_swizzle(__float_as_int(v), (8 << 10) | 0x1F));
    return sum_fq(v);
}

namespace pg8 {
#define PG8_LAS __attribute__((address_space(3)))
typedef unsigned short bf16_t;
typedef short bf16x8 __attribute__((ext_vector_type(8)));
typedef float f32x4 __attribute__((ext_vector_type(4)));
typedef unsigned u32x4 __attribute__((ext_vector_type(4)));
constexpr int BM = 256, BK = 64, HALF = 128, HTB = HALF * BK * 2  , STAGE_BYTES = 8 * HTB, NXCD = 8, WGM = 8;

__host__ __device__ __forceinline__ int lds_byte(int r, int c) { const int st = (r >> 4) * 2 + (c >> 5), rr = r & 15, cc = c & 31, ob = rr * 64 + cc * 2; return st * 1024 + (ob ^ (((ob >> 9) & 1) << 5)); }
__host__ __device__ __forceinline__ void stage_rc(int b, int& R, int& C) { const int st = b / 1024, sb = b % 1024, swz = sb ^ (((sb >> 9) & 1) << 5); R = (st >> 1) * 16 + swz / 64; C = (st & 1) * 32 + (swz % 64) / 2; }
__host__ __device__ __forceinline__ int perm32(int rho) { const int n = rho >> 4, i = rho & 15; return 8 * (i >> 2) + 4 * n + (i & 3); }

struct Unit { int pm, pn, par; };
struct Gemm { const bf16_t* A; const bf16_t* Bt; int M, N, K; };

struct StaticOrder {
    int nM, nN, nwg, G, c, wgm;
    __host__ __device__ void init(int M, int N, int G_, int c_, int wgm_ = WGM) { nM = M / BM; nN = N / BM; nwg = nM * nN; G = G_; c = c_; wgm = wgm_; }
    __host__ __device__ bool next(int i, Unit& u) const {
        const long L = (long)i * G + c; if (L >= nwg) return false;
        int wgid = (int)L; { const int q = nwg / NXCD, r = nwg % NXCD, xcd = wgid % NXCD, off = wgid / NXCD; wgid = (xcd < r ? xcd * (q + 1) : r * (q + 1) + (xcd - r) * q) + off; }
        const int nig = wgm * nN, gid = wgid / nig, fm = gid * wgm, gsz = (nM - fm) < wgm ? (nM - fm) : wgm;
        u.pm = fm + ((wgid % nig) % gsz); u.pn = (wgid % nig) / gsz; return true;
    }
    __device__ __forceinline__ void a_ready(const Unit&) const {}
    __device__ __forceinline__ void done(const Unit&) const {}
};

__device__ __forceinline__ void row_inv8(const float* ssq, int row0, int fq, float (&inv)[2][4]) {
#pragma unroll
    for (int ai = 0; ai < 2; ++ai)
#pragma unroll
        for (int m = 0; m < 4; ++m) {
            const f32x4* p = (const f32x4*)(ssq + (size_t)(row0 + ai * HALF + m * 16) * 32) + 2 * fq;
            const f32x4 a = p[0], b = p[1];
            float s = ((a[0] + a[1]) + (a[2] + a[3])) + ((b[0] + b[1]) + (b[2] + b[3]));
            s = sum_fq(s);
            inv[ai][m] = rsqrtf(s * (1.0f / DM) + RMS_EPS);
        }
}
struct EpiInProj {
    static constexpr int PROBE_ID = 0;
    static constexpr bool PREP = false, MIDK = false, PERM = false, APERM = false, AFTER_DRAIN = false;
    const float* ssq; bf16* R1;
    __device__ __forceinline__ void operator()(const f32x4 (&acc)[2][2][4][2], const Unit& u, int wr, int wc, int fr, int fq) const {
        const int row0 = u.pm * BM + wr * 64 + fr;
        float inv[2][4]; row_inv8(ssq, row0, fq, inv);
        int mode, ld, colb; bf16* base;
        if (u.pn < 20) { const int t = u.pn >> 2; base = R1 + (size_t)t * MTOK * 1024; ld = 1024; colb = (u.pn & 3) * 256; mode = t < 3 ? 0 : 1; }
        else { const int t = (u.pn - 20) >> 3; base = R1 + (size_t)5 * MTOK * 1024 + (size_t)t * MTOK * 2048; ld = 2048; colb = ((u.pn - 20) & 7) * 256; mode = 2; }
#pragma unroll
        for (int ai = 0; ai < 2; ++ai)
#pragma unroll
            for (int m = 0; m < 4; ++m) { bf16* rowp = base + (size_t)(row0 + ai * HALF + m * 16) * ld + colb + wc * 32 + 4 * fq;
#pragma unroll
                for (int bj = 0; bj < 2; ++bj)
#pragma unroll
                    for (int n = 0; n < 2; ++n) { f32x4 v = acc[ai][bj][m][n] * inv[ai][m];
                        if (mode == 1) { v[0] = gelu_tanh(v[0]); v[1] = gelu_tanh(v[1]); v[2] = gelu_tanh(v[2]); v[3] = gelu_tanh(v[3]); }
                        else if (mode == 2) { v[0] = sigmoid_f(v[0]); v[1] = sigmoid_f(v[1]); v[2] = sigmoid_f(v[2]); v[3] = sigmoid_f(v[3]); }
                        u32x2 w; w.x = cvt_pk_bf16(v[0], v[1]); w.y = cvt_pk_bf16(v[2], v[3]);
                        *(u32x2*)(rowp + bj * HALF + n * 16) = w; } }
    }
};
struct EpiBranchA {
    static constexpr int PROBE_ID = 3;
    static constexpr bool PREP = false, MIDK = false, PERM = false, APERM = false, AFTER_DRAIN = false;
    const bf16* SA; float* T;
    __device__ __forceinline__ void operator()(const f32x4 (&acc)[2][2][4][2], const Unit& u, int wr, int wc, int fr, int fq) const {
        const int row0 = u.pm * BM + wr * 64 + fr, col0 = u.pn * BM + wc * 32 + 4 * fq;
#pragma unroll
        for (int ai = 0; ai < 2; ++ai)
#pragma unroll
            for (int m = 0; m < 4; ++m) { const size_t off = (size_t)(row0 + ai * HALF + m * 16) * DM + col0;
#pragma unroll
                for (int bj = 0; bj < 2; ++bj)
#pragma unroll
                    for (int n = 0; n < 2; ++n) { const u32x2 g = *(const u32x2*)(SA + off + bj * HALF + n * 16);
                        const f32x4 gv = {bf_lo(g.x), bf_hi(g.x), bf_lo(g.y), bf_hi(g.y)};
                        *(f32x4*)(T + off + bj * HALF + n * 16) = acc[ai][bj][m][n] * gv; } }
    }
};
struct EpiBranchB {
    static constexpr int PROBE_ID = 4;
    static constexpr bool PREP = false, MIDK = false, PERM = false, APERM = false, AFTER_DRAIN = false;
    const bf16* SB; const float* T; bf16* MG;
    __device__ __forceinline__ void operator()(const f32x4 (&acc)[2][2][4][2], const Unit& u, int wr, int wc, int fr, int fq) const {
        const int row0 = u.pm * BM + wr * 64 + fr, col0 = u.pn * BM + wc * 32 + 4 * fq;
#pragma unroll
        for (int ai = 0; ai < 2; ++ai)
#pragma unroll
            for (int m = 0; m < 4; ++m) { const size_t off = (size_t)(row0 + ai * HALF + m * 16) * DM + col0;
#pragma unroll
                for (int bj = 0; bj < 2; ++bj)
#pragma unroll
                    for (int n = 0; n < 2; ++n) { const u32x2 g = *(const u32x2*)(SB + off + bj * HALF + n * 16);
                        const f32x4 gv = {bf_lo(g.x), bf_hi(g.x), bf_lo(g.y), bf_hi(g.y)};
                        const f32x4 t = *(const f32x4*)(T + off + bj * HALF + n * 16);
                        const f32x4 v = t + acc[ai][bj][m][n] * gv;
                        u32x2 w; w.x = cvt_pk_bf16(v[0], v[1]); w.y = cvt_pk_bf16(v[2], v[3]);
                        *(u32x2*)(MG + off + bj * HALF + n * 16) = w; } }
    }
};
struct EpiResid {
    static constexpr int PROBE_ID = 0;
    static constexpr bool PREP = false, MIDK = false, PERM = false, APERM = false, AFTER_DRAIN = false;
    const float* xin; float* xout;
    __device__ __forceinline__ void operator()(const f32x4 (&acc)[2][2][4][2], const Unit& u, int wr, int wc, int fr, int fq) const {
        const int row0 = u.pm * BM + wr * 64 + fr, col0 = u.pn * BM + wc * 32 + 4 * fq;
#pragma unroll
        for (int ai = 0; ai < 2; ++ai)
#pragma unroll
            for (int m = 0; m < 4; ++m) { const size_t off = (size_t)(row0 + ai * HALF + m * 16) * DM + col0;
#pragma unroll
                for (int bj = 0; bj < 2; ++bj)
#pragma unroll
                    for (int n = 0; n < 2; ++n) { const f32x4 b = *(const f32x4*)(xin + off + bj * HALF + n * 16);
                        *(f32x4*)(xout + off + bj * HALF + n * 16) = b + acc[ai][bj][m][n]; } }
    }
};
struct EpiUp1 {
    static constexpr int PROBE_ID = 0;
    static constexpr bool PREP = false, MIDK = false, PERM = false, APERM = false, AFTER_DRAIN = false;
    const float* ssq; bf16* AR; bf16* BR;
    __device__ __forceinline__ void operator()(const f32x4 (&acc)[2][2][4][2], const Unit& u, int wr, int wc, int fr, int fq) const {
        const int row0 = u.pm * BM + wr * 64 + fr, ch0 = u.pn * HALF + wc * 32 + 4 * fq;
        float inv[2][4]; row_inv8(ssq, row0, fq, inv);
#pragma unroll
        for (int ai = 0; ai < 2; ++ai)
#pragma unroll
            for (int m = 0; m < 4; ++m) { const size_t off = (size_t)(row0 + ai * HALF + m * 16) * DFF + ch0;
#pragma unroll
                for (int bj = 0; bj < 2; ++bj)
#pragma unroll
                    for (int n = 0; n < 2; ++n) { const f32x4 v = acc[ai][bj][m][n] * inv[ai][m];
                        u32x2 w; w.x = cvt_pk_bf16(v[0], v[1]); w.y = cvt_pk_bf16(v[2], v[3]);
                        *(u32x2*)((bj ? BR : AR) + off + n * 16) = w; } }
    }
};
struct EpiResidStats {
    static constexpr int PROBE_ID = 5;
    static constexpr bool PREP = false, MIDK = false, PERM = false, APERM = false, AFTER_DRAIN = false;
    const float* xin; float* xout; bf16* xb; float* ssq;
    __device__ __forceinline__ void operator()(const f32x4 (&acc)[2][2][4][2], const Unit& u, int wr, int wc, int fr, int fq) const {
        const int row0 = u.pm * BM + wr * 64 + fr, col0 = u.pn * BM + wc * 32 + 4 * fq;
#pragma unroll
        for (int ai = 0; ai < 2; ++ai)
#pragma unroll
            for (int m = 0; m < 4; ++m) { const int row = row0 + ai * HALF + m * 16; const size_t off = (size_t)row * DM + col0; float s = 0.f;
#pragma unroll
                for (int bj = 0; bj < 2; ++bj)
#pragma unroll
                    for (int n = 0; n < 2; ++n) { const f32x4 b = *(const f32x4*)(xin + off + bj * HALF + n * 16); const f32x4 v = b + acc[ai][bj][m][n];
                        *(f32x4*)(xout + off + bj * HALF + n * 16) = v;
                        u32x2 w; w.x = cvt_pk_bf16(v[0], v[1]); w.y = cvt_pk_bf16(v[2], v[3]); *(u32x2*)(xb + off + bj * HALF + n * 16) = w;
                        s += (v[0] * v[0] + v[1] * v[1]) + (v[2] * v[2] + v[3] * v[3]); }
                s = sum_fq(s);
                if (fq == 0) ssq[(size_t)row * 32 + u.pn * 4 + wc] = s; }
    }
};
__device__ __forceinline__ void prep_inv_table(const float* ssq, PG8_LAS float* tbl, const Unit& u, int tid) {
    const int r = tid >> 1; const f32x4* p = (const f32x4*)(ssq + (size_t)(u.pm * BM + r) * 32 + (tid & 1) * 16);
    const f32x4 a = p[0], b = p[1], c = p[2], d = p[3];
    float s = (((a[0] + a[1]) + (a[2] + a[3])) + ((b[0] + b[1]) + (b[2] + b[3]))) + (((c[0] + c[1]) + (c[2] + c[3])) + ((d[0] + d[1]) + (d[2] + d[3])));
    s += __int_as_float(__builtin_amdgcn_update_dpp(0, __float_as_int(s), 0xB1, 0xf, 0xf, true));
    if ((tid & 1) == 0) tbl[u.par * BM + r] = rsqrtf(s * (1.0f / DM) + RMS_EPS);
}
__device__ __forceinline__ float dpp_row_shr1(float old, float src) { return __int_as_float(__builtin_amdgcn_update_dpp(__float_as_int(old), __float_as_int(src), 0x111, 0xf, 0xf, false)); }
struct EpiUpConv {
    static constexpr int PROBE_ID = 2;
    static constexpr bool PREP = true, MIDK = false, PERM = true, APERM = true, AFTER_DRAIN = false;
    const float* ssq; bf16* G; const float* cw; const float* cb; float* sideA; float* sideH; PG8_LAS float* halo;
    __device__ __forceinline__ void prep(const Unit& u, int tid) const { prep_inv_table(ssq, halo + 256, u, tid);
        const int arr = tid >> 7, ch = tid & 127;
        halo[768 + u.par * 512 + tid] = arr < 3 ? cw[(size_t)arr * DFF + u.pn * HALF + ch] : cb[u.pn * HALF + ch]; }
    __device__ __forceinline__ void operator()(const f32x4 (&acc)[2][2][4][2], const Unit& u, int wr, int wc, int fr, int fq) const {
        const int tok0 = u.pm * BM + 128 * wr + 8 * fr, ch0 = u.pn * HALF + wc * 32 + 8 * fq;
        float inv[8];
        { const PG8_LAS float* tp = halo + 256 + u.par * BM + 128 * wr + 8 * fr; const f32x4 i0 = *(const PG8_LAS f32x4*)tp, i1 = *(const PG8_LAS f32x4*)(tp + 4);
          inv[0] = i0[0]; inv[1] = i0[1]; inv[2] = i0[2]; inv[3] = i0[3]; inv[4] = i1[0]; inv[5] = i1[1]; inv[6] = i1[2]; inv[7] = i1[3]; }
        f32x2 W0[4], W1[4], W2[4], CB[4];
        const PG8_LAS float* wt = halo + 768 + u.par * 512 + wc * 32 + 8 * fq;
#pragma unroll
        for (int n = 0; n < 2; ++n) { const f32x4 w0 = *(const PG8_LAS f32x4*)(wt + 4 * n), w1 = *(const PG8_LAS f32x4*)(wt + 128 + 4 * n), w2 = *(const PG8_LAS f32x4*)(wt + 256 + 4 * n), cbv = *(const PG8_LAS f32x4*)(wt + 384 + 4 * n);
            W0[2 * n] = (f32x2){w0[0], w0[1]}; W0[2 * n + 1] = (f32x2){w0[2], w0[3]}; W1[2 * n] = (f32x2){w1[0], w1[1]}; W1[2 * n + 1] = (f32x2){w1[2], w1[3]};
            W2[2 * n] = (f32x2){w2[0], w2[1]}; W2[2 * n + 1] = (f32x2){w2[2], w2[3]}; CB[2 * n] = (f32x2){cbv[0], cbv[1]}; CB[2 * n + 1] = (f32x2){cbv[2], cbv[3]}; }
        f32x2 a6[4], a7[4];
#pragma unroll
        for (int c = 0; c < 4; ++c) { const f32x4 x6 = acc[1][0][2][c >> 1], x7 = acc[1][0][3][c >> 1];
            a6[c] = (f32x2){x6[2 * (c & 1)], x6[2 * (c & 1) + 1]} * inv[6]; a7[c] = (f32x2){x7[2 * (c & 1)], x7[2 * (c & 1) + 1]} * inv[7]; }
        PG8_LAS float* hp = halo + (wc * 4 + fq) * 16;
        if (wr == 0 && fr == 15) { *(PG8_LAS f32x4*)(hp) = (f32x4){a6[0].x, a6[0].y, a6[1].x, a6[1].y}; *(PG8_LAS f32x4*)(hp + 4) = (f32x4){a6[2].x, a6[2].y, a6[3].x, a6[3].y};
            *(PG8_LAS f32x4*)(hp + 8) = (f32x4){a7[0].x, a7[0].y, a7[1].x, a7[1].y}; *(PG8_LAS f32x4*)(hp + 12) = (f32x4){a7[2].x, a7[2].y, a7[3].x, a7[3].y}; }
        asm volatile("s_waitcnt lgkmcnt(0)" ::: "memory"); __builtin_amdgcn_s_barrier(); asm volatile("" ::: "memory");
        f32x4 h6a = {0.f, 0.f, 0.f, 0.f}, h6b = h6a, h7a = h6a, h7b = h6a;
        if (wr == 1) { h6a = *(PG8_LAS f32x4*)(hp); h6b = *(PG8_LAS f32x4*)(hp + 4); h7a = *(PG8_LAS f32x4*)(hp + 8); h7b = *(PG8_LAS f32x4*)(hp + 12); }
        const bool first = (wr == 0 && fr == 0), lastl = (wr == 1 && fr == 15);
        f32x2 p2[4], p1[4];
        p2[0] = (f32x2){dpp_row_shr1(h6a[0], a6[0].x), dpp_row_shr1(h6a[1], a6[0].y)}; p2[1] = (f32x2){dpp_row_shr1(h6a[2], a6[1].x), dpp_row_shr1(h6a[3], a6[1].y)};
        p2[2] = (f32x2){dpp_row_shr1(h6b[0], a6[2].x), dpp_row_shr1(h6b[1], a6[2].y)}; p2[3] = (f32x2){dpp_row_shr1(h6b[2], a6[3].x), dpp_row_shr1(h6b[3], a6[3].y)};
        p1[0] = (f32x2){dpp_row_shr1(h7a[0], a7[0].x), dpp_row_shr1(h7a[1], a7[0].y)}; p1[1] = (f32x2){dpp_row_shr1(h7a[2], a7[1].x), dpp_row_shr1(h7a[3], a7[1].y)};
        p1[2] = (f32x2){dpp_row_shr1(h7b[0], a7[2].x), dpp_row_shr1(h7b[1], a7[2].y)}; p1[3] = (f32x2){dpp_row_shr1(h7b[2], a7[3].x), dpp_row_shr1(h7b[3], a7[3].y)};
        if (lastl) { float* sa = sideA + (size_t)u.pm * 2 * DFF + ch0;
            *(f32x4*)(sa) = (f32x4){a6[0].x, a6[0].y, a6[1].x, a6[1].y}; *(f32x4*)(sa + 4) = (f32x4){a6[2].x, a6[2].y, a6[3].x, a6[3].y};
            *(f32x4*)(sa + DFF) = (f32x4){a7[0].x, a7[0].y, a7[1].x, a7[1].y}; *(f32x4*)(sa + DFF + 4) = (f32x4){a7[2].x, a7[2].y, a7[3].x, a7[3].y}; }
#pragma unroll
        for (int j = 0; j < 8; ++j) {
            f32x2 cur[4], bb[4], g[4];
#pragma unroll
            for (int c = 0; c < 4; ++c) { const f32x4 xa = acc[j >> 2][0][j & 3][c >> 1], xb_ = acc[j >> 2][1][j & 3][c >> 1];
                cur[c] = (f32x2){xa[2 * (c & 1)], xa[2 * (c & 1) + 1]} * inv[j]; bb[c] = (f32x2){xb_[2 * (c & 1)], xb_[2 * (c & 1) + 1]} * inv[j];
                g[c] = gelu_tanh_pk(CB[c] + W0[c] * p2[c] + W1[c] * p1[c] + W2[c] * cur[c]) * bb[c]; }
            if (first && j < 2) { float* sh = sideH + (size_t)u.pm * 4 * DFF + (size_t)j * DFF + ch0;
                *(f32x4*)(sh) = (f32x4){cur[0].x, cur[0].y, cur[1].x, cur[1].y}; *(f32x4*)(sh + 4) = (f32x4){cur[2].x, cur[2].y, cur[3].x, cur[3].y};
                *(f32x4*)(sh + 2 * DFF) = (f32x4){bb[0].x, bb[0].y, bb[1].x, bb[1].y}; *(f32x4*)(sh + 2 * DFF + 4) = (f32x4){bb[2].x, bb[2].y, bb[3].x, bb[3].y}; }
            else { u32x4 w; w.x = cvt_pk_bf16(g[0].x, g[0].y); w.y = cvt_pk_bf16(g[1].x, g[1].y); w.z = cvt_pk_bf16(g[2].x, g[2].y); w.w = cvt_pk_bf16(g[3].x, g[3].y);
                *(u32x4*)(G + (size_t)(tok0 + j) * DFF + ch0) = w; }
#pragma unroll
            for (int c = 0; c < 4; ++c) { p2[c] = p1[c]; p1[c] = cur[c]; }
        }
    }
};
struct EpiInProj2 {
    static constexpr int PROBE_ID = 1;
    static constexpr bool PREP = true, MIDK = false, PERM = true, APERM = true, AFTER_DRAIN = false;
    const float* ssq; bf16* R1; float* ssqv; PG8_LAS float* tbl;
    __device__ __forceinline__ void prep(const Unit& u, int tid) const { prep_inv_table(ssq, tbl, u, tid); }
    __device__ __forceinline__ void operator()(const f32x4 (&acc)[2][2][4][2], const Unit& u, int wr, int wc, int fr, int fq) const {
        const int tok0 = u.pm * BM + 128 * wr + 8 * fr, cq = wc * 32 + 8 * fq;
        float inv[8];
        { const PG8_LAS float* tp = tbl + u.par * BM + 128 * wr + 8 * fr; const f32x4 i0 = *(const PG8_LAS f32x4*)tp, i1 = *(const PG8_LAS f32x4*)(tp + 4);
          inv[0] = i0[0]; inv[1] = i0[1]; inv[2] = i0[2]; inv[3] = i0[3]; inv[4] = i1[0]; inv[5] = i1[1]; inv[6] = i1[2]; inv[7] = i1[3]; }
        if (u.pn >= 16 && u.pn < 20) {
            bf16* gvt = R1 + (size_t)4 * MTOK * 1024 + ((size_t)(tok0 >> 7) * SW + (u.pn - 16) * 256 + cq) * SCH + (tok0 & 127);
            float ss[8];
#pragma unroll
            for (int j = 0; j < 8; ++j) ss[j] = 0.f;
#pragma unroll
            for (int bj = 0; bj < 2; ++bj)
#pragma unroll
                for (int n = 0; n < 2; ++n)
#pragma unroll
                    for (int i = 0; i < 4; ++i) { float v[8];
#pragma unroll
                        for (int j = 0; j < 8; ++j) { v[j] = gelu_tanh(acc[j >> 2][bj][j & 3][n][i] * inv[j]); ss[j] += v[j] * v[j]; }
                        u32x4 w; w.x = cvt_pk_bf16(v[0], v[1]); w.y = cvt_pk_bf16(v[2], v[3]); w.z = cvt_pk_bf16(v[4], v[5]); w.w = cvt_pk_bf16(v[6], v[7]);
                        *(u32x4*)(gvt + (size_t)(bj * HALF + 4 * n + i) * SCH) = w; }
#pragma unroll
            for (int j = 0; j < 8; ++j) { float s = ss[j]; s = sum_fq(s); if (fq == 0) ssqv[(size_t)(tok0 + j) * 16 + (u.pn - 16) * 4 + wc] = s; }
            return;
        }
        if (u.pn >= 20) {
            bf16* ra = R1 + (size_t)5 * MTOK * 1024 + (u.pn - 20) * HALF + cq; bf16* sb = ra + (size_t)MTOK * 2048;
#pragma unroll
            for (int j = 0; j < 8; ++j) { float r[8], q[8];
#pragma unroll
                for (int n = 0; n < 2; ++n)
#pragma unroll
                    for (int i = 0; i < 4; ++i) { const float i8 = inv[j] * 0.125f, ga = __builtin_amdgcn_fmed3f(acc[j >> 2][0][j & 3][n][i] * i8, -4.0f, 4.0f), gb = __builtin_amdgcn_fmed3f(acc[j >> 2][1][j & 3][n][i] * i8, -4.0f, 4.0f);
                        const float ea = 1.0f + __builtin_amdgcn_exp2f(-11.541560327111707f * ga), eb = 1.0f + __builtin_amdgcn_exp2f(-11.541560327111707f * gb);
                        r[4 * n + i] = eb * __builtin_amdgcn_rcpf(ea); q[4 * n + i] = __builtin_amdgcn_rcpf(eb); }
                u32x4 w; w.x = cvt_pk_bf16(r[0], r[1]); w.y = cvt_pk_bf16(r[2], r[3]); w.z = cvt_pk_bf16(r[4], r[5]); w.w = cvt_pk_bf16(r[6], r[7]);
                *(u32x4*)(ra + (size_t)(tok0 + j) * DM) = w;
                w.x = cvt_pk_bf16(q[0], q[1]); w.y = cvt_pk_bf16(q[2], q[3]); w.z = cvt_pk_bf16(q[4], q[5]); w.w = cvt_pk_bf16(q[6], q[7]);
                *(u32x4*)(sb + (size_t)(tok0 + j) * DM) = w; }
            return;
        }
        const int t = u.pn >> 2, ld = 1024, colb = (u.pn & 3) * 256, mode = 0; bf16* base = R1 + (size_t)t * MTOK * 1024;
#pragma unroll
        for (int j = 0; j < 8; ++j) { bf16* rowp = base + (size_t)(tok0 + j) * ld + colb + cq;
#pragma unroll
            for (int bj = 0; bj < 2; ++bj) { f32x4 v0 = acc[j >> 2][bj][j & 3][0] * inv[j], v1 = acc[j >> 2][bj][j & 3][1] * inv[j];
                if (mode == 1) { const f32x2 g0 = gelu_tanh_pk((f32x2){v0[0], v0[1]}), g1 = gelu_tanh_pk((f32x2){v0[2], v0[3]}), g2 = gelu_tanh_pk((f32x2){v1[0], v1[1]}), g3 = gelu_tanh_pk((f32x2){v1[2], v1[3]});
                    v0 = (f32x4){g0.x, g0.y, g1.x, g1.y}; v1 = (f32x4){g2.x, g2.y, g3.x, g3.y}; }
                u32x4 w; w.x = cvt_pk_bf16(v0[0], v0[1]); w.y = cvt_pk_bf16(v0[2], v0[3]); w.z = cvt_pk_bf16(v1[0], v1[1]); w.w = cvt_pk_bf16(v1[2], v1[3]);
                *(u32x4*)(rowp + bj * HALF) = w; } }
    }
};
struct EpiBranch {
    static constexpr int PROBE_ID = 3;
    static constexpr bool PREP = false, MIDK = true, PERM = true, APERM = false, AFTER_DRAIN = false;
    const bf16* RA; const bf16* SB; bf16* MG;
    __device__ __forceinline__ void mid(f32x4 (&acc)[2][2][4][2], const Unit& u, int wr, int wc, int fr, int fq) const {
        unsigned o0 = (unsigned)((u.pm * BM + wr * 64 + fr) * DM + u.pn * BM + wc * 32 + 8 * fq);
        asm volatile("" : "+v"(o0));
#pragma unroll
        for (int ai = 0; ai < 2; ++ai)
#pragma unroll
            for (int mp = 0; mp < 2; ++mp) { u32x4 g[2][2];
#pragma unroll
                for (int mi = 0; mi < 2; ++mi)
#pragma unroll
                    for (int bj = 0; bj < 2; ++bj) g[mi][bj] = *(const u32x4*)(RA + (size_t)(o0 + (unsigned)((ai * HALF + (2 * mp + mi) * 16) * DM)) + bj * HALF);
#pragma unroll
                for (int mi = 0; mi < 2; ++mi)
#pragma unroll
                    for (int bj = 0; bj < 2; ++bj) { const int m = 2 * mp + mi; const u32x4 q = g[mi][bj];
                        acc[ai][bj][m][0][0] *= bf_lo(q.x); acc[ai][bj][m][0][1] *= bf_hi(q.x); acc[ai][bj][m][0][2] *= bf_lo(q.y); acc[ai][bj][m][0][3] *= bf_hi(q.y);
                        acc[ai][bj][m][1][0] *= bf_lo(q.z); acc[ai][bj][m][1][1] *= bf_hi(q.z); acc[ai][bj][m][1][2] *= bf_lo(q.w); acc[ai][bj][m][1][3] *= bf_hi(q.w); } }
    }
    __device__ __forceinline__ void operator()(const f32x4 (&acc)[2][2][4][2], const Unit& u, int wr, int wc, int fr, int fq) const {
        const int row0 = u.pm * BM + wr * 64 + fr, col0 = u.pn * BM + wc * 32 + 8 * fq;
#pragma unroll
        for (int ai = 0; ai < 2; ++ai) { u32x4 g[4][2];
#pragma unroll
            for (int m = 0; m < 4; ++m)
#pragma unroll
                for (int bj = 0; bj < 2; ++bj) g[m][bj] = *(const u32x4*)(SB + (size_t)(row0 + ai * HALF + m * 16) * DM + col0 + bj * HALF);
#pragma unroll
            for (int m = 0; m < 4; ++m) { const size_t off = (size_t)(row0 + ai * HALF + m * 16) * DM + col0;
#pragma unroll
                for (int bj = 0; bj < 2; ++bj) { const u32x4 gb = g[m][bj]; const f32x4 v0 = acc[ai][bj][m][0], v1 = acc[ai][bj][m][1];
                    u32x4 w; w.x = cvt_pk_bf16(v0[0] * bf_lo(gb.x), v0[1] * bf_hi(gb.x)); w.y = cvt_pk_bf16(v0[2] * bf_lo(gb.y), v0[3] * bf_hi(gb.y));
                    w.z = cvt_pk_bf16(v1[0] * bf_lo(gb.z), v1[1] * bf_hi(gb.z)); w.w = cvt_pk_bf16(v1[2] * bf_lo(gb.w), v1[3] * bf_hi(gb.w));
                    *(u32x4*)(MG + off + bj * HALF) = w; } } }
    }
};
struct EpiResidB {
    static constexpr int PROBE_ID = 5;
    static constexpr bool PREP = false, MIDK = false, PERM = true, APERM = false, AFTER_DRAIN = false;
    const float* xin32; bf16* xb; float* ssq;
    __device__ __forceinline__ float piece(const f32x4 b0, const f32x4 b1, const f32x4 a0, const f32x4 a1, size_t o) const {
        const f32x4 v0 = b0 + a0, v1 = b1 + a1;
        u32x4 w; w.x = cvt_pk_bf16(v0[0], v0[1]); w.y = cvt_pk_bf16(v0[2], v0[3]); w.z = cvt_pk_bf16(v1[0], v1[1]); w.w = cvt_pk_bf16(v1[2], v1[3]);
        *(u32x4*)(xb + o) = w;
        const float r0 = bf_lo(w.x), r1 = bf_hi(w.x), r2 = bf_lo(w.y), r3 = bf_hi(w.y), r4 = bf_lo(w.z), r5 = bf_hi(w.z), r6 = bf_lo(w.w), r7 = bf_hi(w.w);
        return ((r0 * r0 + r1 * r1) + (r2 * r2 + r3 * r3)) + ((r4 * r4 + r5 * r5) + (r6 * r6 + r7 * r7));
    }
    __device__ __forceinline__ void operator()(const f32x4 (&acc)[2][2][4][2], const Unit& u, int wr, int wc, int fr, int fq) const {
        const int row0 = u.pm * BM + wr * 64 + fr, col0 = u.pn * BM + wc * 32 + 8 * fq;
        if (xin32) {
#pragma unroll
            for (int ai = 0; ai < 2; ++ai) { f32x4 b[4][2][2];
#pragma unroll
                for (int m = 0; m < 4; ++m)
#pragma unroll
                    for (int bj = 0; bj < 2; ++bj) { const size_t o = (size_t)(row0 + ai * HALF + m * 16) * DM + col0 + bj * HALF; b[m][bj][0] = *(const f32x4*)(xin32 + o); b[m][bj][1] = *(const f32x4*)(xin32 + o + 4); }
#pragma unroll
                for (int m = 0; m < 4; ++m) { const int row = row0 + ai * HALF + m * 16; const size_t off = (size_t)row * DM + col0; float s = 0.f;
#pragma unroll
                    for (int bj = 0; bj < 2; ++bj) s += piece(b[m][bj][0], b[m][bj][1], acc[ai][bj][m][0], acc[ai][bj][m][1], off + bj * HALF);
                    s = sum_fq(s);
                    if (fq == 0) ssq[(size_t)row * 32 + u.pn * 4 + wc] = s; } }
        } else {
#pragma unroll
            for (int ai = 0; ai < 2; ++ai) { u32x4 r[4][2];
#pragma unroll
                for (int m = 0; m < 4; ++m)
#pragma unroll
                    for (int bj = 0; bj < 2; ++bj) r[m][bj] = *(const u32x4*)(xb + (size_t)(row0 + ai * HALF + m * 16) * DM + col0 + bj * HALF);
#pragma unroll
                for (int m = 0; m < 4; ++m) { const int row = row0 + ai * HALF + m * 16; const size_t off = (size_t)row * DM + col0; float s = 0.f;
#pragma unroll
                    for (int bj = 0; bj < 2; ++bj) { const u32x4 q = r[m][bj];
                        s += piece((f32x4){bf_lo(q.x), bf_hi(q.x), bf_lo(q.y), bf_hi(q.y)}, (f32x4){bf_lo(q.z), bf_hi(q.z), bf_lo(q.w), bf_hi(q.w)}, acc[ai][bj][m][0], acc[ai][bj][m][1], off + bj * HALF); }
                    s = sum_fq(s);
                    if (fq == 0) ssq[(size_t)row * 32 + u.pn * 4 + wc] = s; } }
        }
    }
};

template <class Epi, class Sched, bool ALIGN_EPI = false, bool SP2 = false>
__device__ __forceinline__ void gemm_phase(PG8_LAS unsigned char* lds, const Gemm g, const Sched& S, const Epi& E, int tid_in) {
    const int tid = tid_in, wid = __builtin_amdgcn_readfirstlane(tid >> 6), lane = tid & 63, wr = wid >> 2, wc = wid & 3, fr = lane & 15, fq = lane >> 4;
    const int K = g.K, nt = K / BK;
    unsigned voffA[2], voffB[2];
#pragma unroll
    for (int i = 0; i < 2; ++i) { int R, C; stage_rc(tid * 16 + i * 8192, R, C); const int Rb = Epi::PERM ? ((R & ~31) + perm32(R & 31)) : R;
        const int Ra = Epi::APERM ? (128 * ((R >> 6) & 1) + 8 * (R & 15) + ((R >> 4) & 3)) : R; voffA[i] = (unsigned)(Ra * K + C) * 2u; voffB[i] = (unsigned)(Rb * K + C) * 2u; }
    const size_t kstep = (size_t)(BK * 2);
    const size_t hstep = (size_t)HALF * K * 2;
    const size_t tstep = 2 * hstep; const size_t hstepA = Epi::APERM ? (size_t)4 * K * 2 : hstep;
    const unsigned ldsw = (unsigned)wid * 1024u;
    const int aoff = lds_byte(wr * 64 + fr, fq * 8), boff = lds_byte(wc * 32 + fr, fq * 8);
#define PG8_SA(b, h) (((b) * 2 + (h)) * HTB)
#define PG8_SB(b, h) ((4 + (b) * 2 + (h)) * HTB)
#define PG8_STAGE(bufoff, gbase, voff) do { _Pragma("unroll") for (int _i = 0; _i < 2; ++_i) \
        __builtin_amdgcn_global_load_lds((const unsigned*)((const char*)(gbase) + (voff)[_i]), (PG8_LAS unsigned*)(lds + (bufoff) + ldsw + _i * 8192), 16, 0, 0); } while (0)
#define PG8_LDA(dst, b, h) do { _Pragma("unroll") for (int m = 0; m < 4; ++m) _Pragma("unroll") for (int k = 0; k < 2; ++k) dst[m][k] = *(const PG8_LAS bf16x8*)(lds + PG8_SA(b, h) + aoff + m * 2048 + k * 1024); } while (0)
#define PG8_LDB(dst, b, h) do { _Pragma("unroll") for (int n = 0; n < 2; ++n) _Pragma("unroll") for (int k = 0; k < 2; ++k) dst[n][k] = *(const PG8_LAS bf16x8*)(lds + PG8_SB(b, h) + boff + n * 2048 + k * 1024); } while (0)
#define PG8_MMA(ai, bj, At, Bt) do { __builtin_amdgcn_s_setprio(1); _Pragma("unroll") for (int m = 0; m < 4; ++m) _Pragma("unroll") for (int n = 0; n < 2; ++n) _Pragma("unroll") for (int k = 0; k < 2; ++k) \
        acc[ai][bj][m][n] = __builtin_amdgcn_mfma_f32_16x16x32_bf16(Bt[n][k], At[m][k], acc[ai][bj][m][n], 0, 0, 0); __builtin_amdgcn_s_setprio(0); } while (0)
#define PG8_WAIT_V(n) asm volatile("s_waitcnt vmcnt(" #n ")" ::: "memory")
#define PG8_WAIT_L(n) asm volatile("s_waitcnt lgkmcnt(" #n ")" ::: "memory")
#define PG8_BAR __builtin_amdgcn_s_barrier()
#define PG8_SCHED __builtin_amdgcn_sched_barrier(0)
    Unit cur, nxt; int ui = 0;
    if (!S.next(0, cur)) return;
    f32x4 acc[2][2][4][2];
#pragma unroll
    for (int a = 0; a < 2; ++a)
#pragma unroll
        for (int b = 0; b < 2; ++b)
#pragma unroll
            for (int m = 0; m < 4; ++m)
#pragma unroll
                for (int n = 0; n < 2; ++n) acc[a][b][m][n] = (f32x4){0.f, 0.f, 0.f, 0.f};
    bf16x8 At[4][2], B0[2][2], B1[2][2];
    const char* cA = (const char*)g.A + (size_t)cur.pm * tstep; const char* cB = (const char*)g.Bt + (size_t)cur.pn * tstep;
    cur.par = 0; S.a_ready(cur);
    if constexpr (Epi::PREP) E.prep(cur, tid);
    if constexpr (SP2) {
        PG8_STAGE(PG8_SB(0, 0), cB, voffB); PG8_STAGE(PG8_SB(0, 1), cB + hstep, voffB); PG8_STAGE(PG8_SA(0, 0), cA, voffA); PG8_STAGE(PG8_SA(0, 1), cA + hstepA, voffA);
        if (wr == 1) PG8_BAR;
        PG8_WAIT_V(2); PG8_BAR;
        PG8_STAGE(PG8_SB(1, 0), cB + kstep, voffB); PG8_STAGE(PG8_SA(1, 0), cA + kstep, voffA); PG8_STAGE(PG8_SB(1, 1), cB + hstep + kstep, voffB);
        PG8_WAIT_V(6); PG8_BAR;
    } else {
        PG8_STAGE(PG8_SB(0, 0), cB, voffB); PG8_STAGE(PG8_SA(0, 0), cA, voffA); PG8_STAGE(PG8_SB(0, 1), cB + hstep, voffB); PG8_STAGE(PG8_SA(0, 1), cA + hstepA, voffA);
        if (wr == 1) PG8_BAR;
        PG8_WAIT_V(4); PG8_BAR;
        PG8_STAGE(PG8_SB(1, 0), cB + kstep, voffB); PG8_STAGE(PG8_SA(1, 0), cA + kstep, voffA); PG8_STAGE(PG8_SB(1, 1), cB + hstep + kstep, voffB);
        PG8_WAIT_V(6); PG8_BAR;
    }
    for (;;) {
        const bool has_next = S.next(ui + 1, nxt);
        const char* nA = has_next ? (const char*)g.A + (size_t)nxt.pm * tstep : cA; const char* nB = has_next ? (const char*)g.Bt + (size_t)nxt.pn * tstep : cB;
#ifdef PROBE_K2
        const int ntl = (Epi::PROBE_ID == PROBE_K2) ? 2 * nt : nt;
#define PG8_KT(x) ((x) % nt)
#else
        const int ntl = nt;
#define PG8_KT(x) (x)
#endif
        for (int t = 0; t < ntl; t += 2) {
            const bool last = (t == ntl - 2);
            const char* a1 = cA + (size_t)PG8_KT(t + 1) * kstep;
            const char* a2 = last ? nA : cA + (size_t)PG8_KT(t + 2) * kstep; const char* b2 = last ? nB : cB + (size_t)PG8_KT(t + 2) * kstep;
            const char* a3 = a2 + kstep; const char* b3 = b2 + kstep;
            if (last && has_next) { nxt.par = (ui + 1) & 1; S.a_ready(nxt); if constexpr (Epi::PREP) E.prep(nxt, tid); }
            if constexpr (Epi::MIDK) { if (t == nt / 2) E.mid(acc, cur, wr, wc, fr, fq); }
            if constexpr (SP2) {
            PG8_LDB(B0, 0, 0); PG8_LDB(B1, 0, 1); PG8_SCHED; PG8_LDA(At, 0, 0); PG8_STAGE(PG8_SA(1, 1), a1 + hstepA, voffA);
            PG8_WAIT_V(8); PG8_WAIT_L(0); PG8_BAR; PG8_MMA(0, 0, At, B0); PG8_MMA(0, 1, At, B1); PG8_BAR; PG8_SCHED;
            PG8_LDA(At, 0, 1); PG8_STAGE(PG8_SB(0, 0), b2, voffB); PG8_STAGE(PG8_SB(0, 1), b2 + hstep, voffB); PG8_STAGE(PG8_SA(0, 0), a2, voffA);
            PG8_WAIT_V(8); PG8_WAIT_L(0); PG8_BAR; PG8_MMA(1, 0, At, B0); PG8_MMA(1, 1, At, B1); PG8_BAR; PG8_SCHED;
            PG8_LDB(B0, 1, 0); PG8_LDB(B1, 1, 1); PG8_SCHED; PG8_LDA(At, 1, 0); PG8_STAGE(PG8_SA(0, 1), a2 + hstepA, voffA);
            PG8_WAIT_V(8); PG8_WAIT_L(0); PG8_BAR; PG8_MMA(0, 0, At, B0); PG8_MMA(0, 1, At, B1); PG8_BAR; PG8_SCHED;
            PG8_LDA(At, 1, 1); PG8_STAGE(PG8_SB(1, 0), b3, voffB); PG8_STAGE(PG8_SB(1, 1), b3 + hstep, voffB); PG8_STAGE(PG8_SA(1, 0), a3, voffA);
            PG8_WAIT_V(8); PG8_WAIT_L(0); PG8_BAR; PG8_MMA(1, 0, At, B0); PG8_MMA(1, 1, At, B1); PG8_BAR; PG8_SCHED;
            } else {
            PG8_LDB(B0, 0, 0); PG8_SCHED; PG8_LDA(At, 0, 0); PG8_STAGE(PG8_SA(1, 1), a1 + hstepA, voffA);
            PG8_WAIT_L(8); PG8_BAR; PG8_WAIT_L(0); PG8_MMA(0, 0, At, B0); PG8_BAR; PG8_SCHED;
            PG8_LDB(B1, 0, 1); PG8_STAGE(PG8_SB(0, 0), b2, voffB);
            PG8_BAR; PG8_WAIT_L(0); PG8_MMA(0, 1, At, B1); PG8_BAR;
            PG8_LDA(At, 0, 1); PG8_STAGE(PG8_SA(0, 0), a2, voffA);
            PG8_BAR; PG8_WAIT_L(0); PG8_MMA(1, 0, At, B0); PG8_BAR; PG8_SCHED;
            PG8_STAGE(PG8_SB(0, 1), b2 + hstep, voffB);
            PG8_WAIT_V(6); PG8_BAR; PG8_MMA(1, 1, At, B1); PG8_BAR;
            PG8_LDB(B0, 1, 0); PG8_SCHED; PG8_LDA(At, 1, 0); PG8_STAGE(PG8_SA(0, 1), a2 + hstepA, voffA);
            PG8_WAIT_L(8); PG8_BAR; PG8_WAIT_L(0); PG8_MMA(0, 0, At, B0); PG8_BAR; PG8_SCHED;
            PG8_LDB(B1, 1, 1); PG8_STAGE(PG8_SB(1, 0), b3, voffB);
            PG8_BAR; PG8_WAIT_L(0); PG8_MMA(0, 1, At, B1); PG8_BAR;
            PG8_LDA(At, 1, 1); PG8_STAGE(PG8_SA(1, 0), a3, voffA);
            PG8_BAR; PG8_WAIT_L(0); PG8_MMA(1, 0, At, B0); PG8_BAR; PG8_SCHED;
            PG8_STAGE(PG8_SB(1, 1), b3 + hstep, voffB);
            PG8_WAIT_V(6); PG8_BAR; PG8_MMA(1, 1, At, B1); PG8_BAR;
            }
        }
        if constexpr (ALIGN_EPI) { if (wr == 0) PG8_BAR; }
#ifdef PROBE_K2
        if constexpr (Epi::PROBE_ID == PROBE_K2) {
#pragma unroll
            for (int a_ = 0; a_ < 2; ++a_)
#pragma unroll
                for (int b_ = 0; b_ < 2; ++b_)
#pragma unroll
                    for (int m_ = 0; m_ < 4; ++m_)
#pragma unroll
                        for (int n_ = 0; n_ < 2; ++n_) acc[a_][b_][m_][n_] *= 0.5f; }
#endif
        if constexpr (!Epi::AFTER_DRAIN) { E(acc, cur, wr, wc, fr, fq);
#ifdef PROBE_EPI2
            if constexpr (Epi::PROBE_ID == PROBE_EPI2) { asm volatile("s_waitcnt vmcnt(0)" ::: "memory"); __builtin_amdgcn_sched_barrier(0); E(acc, cur, wr, wc, fr, fq); }
#endif
            S.done(cur); }
        if (!has_next) break;
#pragma unroll
        for (int a = 0; a < 2; ++a)
#pragma unroll
            for (int b = 0; b < 2; ++b)
#pragma unroll
                for (int m = 0; m < 4; ++m)
#pragma unroll
                    for (int n = 0; n < 2; ++n) acc[a][b][m][n] = (f32x4){0.f, 0.f, 0.f, 0.f};
        cur = nxt; cA = nA; cB = nB; ++ui;
        if constexpr (ALIGN_EPI) { if (wr == 1) PG8_BAR; }
    }
    PG8_WAIT_V(0);
    if constexpr (!ALIGN_EPI) { if (wr == 0) PG8_BAR; }
    PG8_BAR;
    if constexpr (Epi::AFTER_DRAIN) { E.fused(acc, cur, wr, wc, fr, fq, lds, wid, lane); S.done(cur); }
#undef PG8_KT
#undef PG8_SA
#undef PG8_SB
#undef PG8_STAGE
#undef PG8_LDA
#undef PG8_LDB
#undef PG8_MMA
#undef PG8_WAIT_V
#undef PG8_WAIT_L
#undef PG8_BAR
#undef PG8_SCHED
}
}

namespace fa {
constexpr int D = 128, LDQ = 1024, LDO = 2048, NW = 8, QBLK = 32, KVBLK = 64, QB = NW * QBLK;
constexpr int SHM_V = KVBLK * D * 2, SHM_K = KVBLK * D * 2;
constexpr int LDS_ATT = 2 * SHM_V + 2 * SHM_K + NW * 64 * 4;
constexpr int TAB_OFF = 69632;
constexpr float SCALE = 0.08838834764831845f, THR = 8.f;
constexpr bool WSKIP = false;
typedef short bf16x8 __attribute__((ext_vector_type(8)));
typedef short s16x4 __attribute__((ext_vector_type(4)));
typedef float f32x16 __attribute__((ext_vector_type(16)));
typedef float f32x4 __attribute__((ext_vector_type(4)));
typedef unsigned u32x4 __attribute__((ext_vector_type(4)));
template <class A, class Bt> struct same_t { static constexpr bool v = false; };
template <class A> struct same_t<A, A> { static constexpr bool v = true; };

#define KSWZ(row, colB) ((row) * 256 + ((colB) ^ (((row) & 7) << 4)))
#define SBAR() __builtin_amdgcn_sched_barrier(0)
__device__ __forceinline__ int v_st(int k, int c) { const int kk = (k & ~0xC) | ((k & 4) << 1) | ((k & 8) >> 1); return ((kk >> 3) * 4 + (c >> 5)) * 512 + ((kk & 7) * 32 + (c & 31)) * 2; }
__device__ __forceinline__ int v_rd_base(int lane) { return ((lane & 3) << 3) | (((lane >> 2) & 3) << 6) | (((lane >> 4) & 1) << 5) | (((lane >> 5) & 1) << 8); }
constexpr int v_rd_off(int d0, int ks, int half) { return d0 * 512 + ks * 4096 + half * 2048; }
__device__ __forceinline__ int crow(int r, int hi) { return (r & 3) + 8 * (r >> 2) + 4 * hi; }
__device__ __forceinline__ unsigned cvtpk(float lo, float hi) { return ::cvt_pk_bf16(lo, hi); }
__device__ __forceinline__ bf16x8 pack8(f32x4 a, f32x4 b) {
    u32x4 w = {cvtpk(a[0], a[1]), cvtpk(a[2], a[3]), cvtpk(b[0], b[1]), cvtpk(b[2], b[3])};
    return *reinterpret_cast<bf16x8*>(&w);
}
template <class T> __device__ __forceinline__ bf16x8 load8(const T* p) {
    if constexpr (same_t<T, float>::v) { return pack8(*(const f32x4*)p, *(const f32x4*)(p + 4)); }
    else { return *reinterpret_cast<const bf16x8*>(p); }
}
__device__ __forceinline__ void mask_tile(f32x16& p0, f32x16& p1, int dq, unsigned W) {
    const float NEG = -__builtin_inff();
#pragma unroll
    for (int r = 0; r < 16; ++r) {
        const int c = (r & 3) + 8 * (r >> 2);
        if ((unsigned)(dq - c) >= W) p0[r] = NEG;
        if ((unsigned)(dq - c - 32) >= W) p1[r] = NEG;
    }
}
__device__ __forceinline__ void partialSM(f32x16& p0, f32x16& p1, float& m_reg, float& mn, float& alpha, bool& dead) {
    float pmax = p0[0]; for (int r = 1; r < 16; ++r) pmax = fmaxf(pmax, p0[r]); for (int r = 0; r < 16; ++r) pmax = fmaxf(pmax, p1[r]);
    { auto rr = __builtin_amdgcn_permlane32_swap(__float_as_uint(pmax), __float_as_uint(pmax), false, false);
      pmax = fmaxf(__uint_as_float(rr[0]), __uint_as_float(rr[1])); }
    constexpr float C2 = 1.4426950408889634f * SCALE;
    if (__builtin_expect(__all((pmax - m_reg) * SCALE <= THR), 1)) { mn = m_reg; alpha = 1.f; }
    else { mn = fmaxf(m_reg, pmax); alpha = __builtin_amdgcn_exp2f((m_reg - mn) * C2); m_reg = mn; }
    dead = __all((pmax - mn) * C2 < -160.f);
    if (dead) return;
    const float mnL = -mn * C2;
    for (int r = 0; r < 16; ++r) p0[r] = fmaf(p0[r], C2, mnL); for (int r = 0; r < 16; ++r) p1[r] = fmaf(p1[r], C2, mnL);
    for (int r = 0; r < 16; ++r) p0[r] = __builtin_amdgcn_exp2f(p0[r]);
}
__device__ __forceinline__ void finishSM(f32x16& p0, f32x16& p1, float alpha, float& l_reg, bf16x8& pa0, bf16x8& pa1, bf16x8& pa2, bf16x8& pa3) {
    for (int r = 0; r < 16; ++r) p1[r] = __builtin_amdgcn_exp2f(p1[r]);
    float ps = 0; for (int r = 0; r < 16; ++r) ps += p0[r]; for (int r = 0; r < 16; ++r) ps += p1[r];
    { auto rr = __builtin_amdgcn_permlane32_swap(__float_as_uint(ps), __float_as_uint(ps), false, false);
      ps = __uint_as_float(rr[0]) + __uint_as_float(rr[1]); }
    l_reg = l_reg * alpha + ps;
#define PK4(P, B_, OUT) do { unsigned a0 = cvtpk(P[B_+0], P[B_+1]), a1 = cvtpk(P[B_+2], P[B_+3]);                          \
        unsigned b0 = cvtpk(P[B_+4], P[B_+5]), b1 = cvtpk(P[B_+6], P[B_+7]);                                             \
        auto r0 = __builtin_amdgcn_permlane32_swap(a0, b0, false, false); auto r1 = __builtin_amdgcn_permlane32_swap(a1, b1, false, false); \
        u32x4 w = {r0[0], r1[0], r0[1], r1[1]}; OUT = *reinterpret_cast<bf16x8*>(&w); } while (0)
    PK4(p0, 0, pa0); PK4(p0, 8, pa1); PK4(p1, 0, pa2); PK4(p1, 8, pa3);
#undef PK4
}
template <int KB, bool SK>
__device__ __forceinline__ void qkt(f32x16& p0, f32x16& p1, const char* K_lds, int r32, int hi, const bf16x8* qr, bool act, const __attribute__((address_space(3))) float* tb) {
    if (SK && !act) { const float NEG = -__builtin_inff();
#pragma unroll
        for (int r = 0; r < 16; ++r) { p0[r] = NEG; p1[r] = NEG; } return; }
#pragma unroll
    for (int j_ = 0; j_ < 4; ++j_) { const f32x4 b0_ = *(const __attribute__((address_space(3))) f32x4*)(tb + 8 * j_), b1_ = *(const __attribute__((address_space(3))) f32x4*)(tb + 32 + 8 * j_);
        p0[4 * j_] = b0_[0]; p0[4 * j_ + 1] = b0_[1]; p0[4 * j_ + 2] = b0_[2]; p0[4 * j_ + 3] = b0_[3]; p1[4 * j_] = b1_[0]; p1[4 * j_ + 1] = b1_[1]; p1[4 * j_ + 2] = b1_[2]; p1[4 * j_ + 3] = b1_[3]; }
    const char* kb[4];
#pragma unroll
    for (int dd = 0; dd < 4; ++dd) kb[dd] = K_lds + KB * SHM_K + KSWZ(r32, (dd * 16 + hi * 8) * 2);
#pragma unroll
    for (int d0 = 0; d0 < 8; ++d0) { const char* a = kb[d0 & 3] + (d0 >> 2) * 128;
        bf16x8 b0 = *reinterpret_cast<const bf16x8*>(a);
        bf16x8 b1 = *reinterpret_cast<const bf16x8*>(a + 32 * 256);
        p0 = __builtin_amdgcn_mfma_f32_32x32x16_bf16(b0, qr[d0], p0, 0, 0, 0);
        p1 = __builtin_amdgcn_mfma_f32_32x32x16_bf16(b1, qr[d0], p1, 0, 0, 0); }
}
template <int VB, bool SK>
__device__ __forceinline__ void pv_tile(f32x16* o, int vb0, bf16x8 pa0, bf16x8 pa1, bf16x8 pa2, bf16x8 pa3, bool act) {
    if (SK && !act) return;
#define TRRD(dst, off) asm volatile("ds_read_b64_tr_b16 %0, %1 offset:%2" : "=&v"(dst) : "v"(vb0), "i"(off) : "memory")
#define PV_D0(d0) do { s16x4 l0, l1, l2, l3, h0, h1, h2, h3; constexpr int b_ = VB * SHM_V + v_rd_off(d0, 0, 0);     \
        TRRD(l0, b_); TRRD(h0, b_ + 2048); TRRD(l1, b_ + 4096); TRRD(h1, b_ + 6144); TRRD(l2, b_ + 8192); TRRD(h2, b_ + 10240); TRRD(l3, b_ + 12288); TRRD(h3, b_ + 14336); \
        asm volatile("s_waitcnt lgkmcnt(0)" ::: "memory"); SBAR();                 \
        o[d0] = __builtin_amdgcn_mfma_f32_32x32x16_bf16(pa0, (bf16x8){l0[0], l0[1], l0[2], l0[3], h0[0], h0[1], h0[2], h0[3]}, o[d0], 0, 0, 0);   \
        o[d0] = __builtin_amdgcn_mfma_f32_32x32x16_bf16(pa1, (bf16x8){l1[0], l1[1], l1[2], l1[3], h1[0], h1[1], h1[2], h1[3]}, o[d0], 0, 0, 0);   \
        o[d0] = __builtin_amdgcn_mfma_f32_32x32x16_bf16(pa2, (bf16x8){l2[0], l2[1], l2[2], l2[3], h2[0], h2[1], h2[2], h2[3]}, o[d0], 0, 0, 0);   \
        o[d0] = __builtin_amdgcn_mfma_f32_32x32x16_bf16(pa3, (bf16x8){l3[0], l3[1], l3[2], l3[3], h3[0], h3[1], h3[2], h3[3]}, o[d0], 0, 0, 0); } while (0)
    PV_D0(0); PV_D0(1); PV_D0(2); PV_D0(3);
#undef PV_D0
#undef TRRD
}
template <class TIn, class TOut> struct BlockRef { const TIn* Q; const TIn* K; const TIn* V; TOut* O; int P0; };
template <class TIn> struct Seam {
    bf16x8 qr[8];
    bf16x8 st_v0, st_v1, st_k0, st_k1; f32x4 sf0, sf1, sf2, sf3;
    f32x4 tq[16];
};
__device__ __forceinline__ int swa_jlo(int P0, int W) { const int lowk = P0 - W + 1; return lowk > 0 ? lowk / KVBLK : 0; }
__device__ __forceinline__ int swa_jhi(int P0) { return (P0 + QB - 1) / KVBLK + 1; }
#define ROW(p, k0, rr) ((p) + (unsigned)(((k0) + (rr)) * LDQ + sc))
#define VMW() asm volatile("s_waitcnt vmcnt(0)" ::: "memory")
#define VMWN(n) asm volatile("s_waitcnt vmcnt(%0)" :: "i"(n) : "memory")
#define SLOAD_H(Kp, Vp, k0) do { S.st_v0 = load8<TIn>(ROW(Vp, k0, sr)); S.st_v1 = load8<TIn>(ROW(Vp, k0, 32 + sr));              \
                         S.st_k0 = load8<TIn>(ROW(Kp, k0, sr)); S.st_k1 = load8<TIn>(ROW(Kp, k0, 32 + sr)); } while (0)
#define SWRITE_HK(bf) do { *(bf16x8*)(K_lds + (bf) * SHM_K + kws) = S.st_k0; *(bf16x8*)(K_lds + (bf) * SHM_K + kws + 32 * 256) = S.st_k1; } while (0)
#define SWRITE_HV(bf) do { *(bf16x8*)(V_lds + (bf) * SHM_V + vst0) = S.st_v0; *(bf16x8*)(V_lds + (bf) * SHM_V + vst1) = S.st_v1; } while (0)
#define SWRITE_H(bf) do { SWRITE_HV(bf); SWRITE_HK(bf); } while (0)
#define SLOAD_F(p, k0) do { S.sf0 = *(const f32x4*)ROW(p, k0, sr); S.sf1 = *(const f32x4*)(ROW(p, k0, sr) + 4);                \
                            S.sf2 = *(const f32x4*)ROW(p, k0, 32 + sr); S.sf3 = *(const f32x4*)(ROW(p, k0, 32 + sr) + 4); } while (0)
#define SWRITE_KF(bf) do { *(bf16x8*)(K_lds + (bf) * SHM_K + kws) = pack8(S.sf0, S.sf1); *(bf16x8*)(K_lds + (bf) * SHM_K + kws + 32 * 256) = pack8(S.sf2, S.sf3); } while (0)
#define SWRITE_VF(bf) do { *(bf16x8*)(V_lds + (bf) * SHM_V + vst0) = pack8(S.sf0, S.sf1); *(bf16x8*)(V_lds + (bf) * SHM_V + vst1) = pack8(S.sf2, S.sf3); } while (0)
template <class TIn, class TOut>
__device__ __forceinline__ void causal_swa_prime(const BlockRef<TIn, TOut>& cur, int W, char* lds, Seam<TIn>& S, int tid_in) {
    constexpr bool F32 = same_t<TIn, float>::v;
    const int tid = tid_in, wid = __builtin_amdgcn_readfirstlane(tid >> 6), lane = tid & 63, r32 = lane & 31, hi = lane >> 5;
    const int sr = tid >> 4, sc = (tid & 15) * 8, kws = KSWZ(sr, sc * 2); char* K_lds = lds + 2 * SHM_V;
    const int kb0 = (swa_jhi(cur.P0) - 1) * KVBLK;
    for (int d0 = 0; d0 < 8; ++d0) S.qr[d0] = load8<TIn>(cur.Q + (unsigned)((wid * QBLK + r32) * LDQ + d0 * 16 + hi * 8));
    if constexpr (F32) { SLOAD_F((const float*)cur.K, kb0); VMW(); SWRITE_KF(0); SBAR(); SLOAD_F((const float*)cur.V, kb0); }
    else { SLOAD_H(cur.K, cur.V, kb0); VMW(); SWRITE_HK(0); }
    __syncthreads();
}
template <class TIn, class TOut>
__device__ __forceinline__ void causal_swa_block(const BlockRef<TIn, TOut>& cur, const BlockRef<TIn, TOut>& nxt, int skv, int W, char* lds, Seam<TIn>& S, int tid_in) {
    constexpr bool F32 = same_t<TIn, float>::v;
    const int tid = tid_in, wid = __builtin_amdgcn_readfirstlane(tid >> 6), lane = tid & 63, r32 = lane & 31, hi = lane >> 5;
    const int j_lo = swa_jlo(cur.P0, W);
    int j_hi = (cur.P0 + QB - 1) / KVBLK + 1; if (j_hi > skv / KVBLK) j_hi = skv / KVBLK;
    const int NT = j_hi - j_lo;
    const int kbn = (swa_jhi(nxt.P0) - 1) * KVBLK;
    const int qlo = cur.P0 + wid * QBLK, qm = qlo + r32 - 4 * hi;
    char* V_lds = lds; char* K_lds = lds + 2 * SHM_V;
    float* ws = (float*)(lds + 2 * SHM_V + 2 * SHM_K) + wid * 64; float* li_l = ws, * al_l = ws + 32;
    float m_reg = -1e30f, l_reg = 0; f32x16 o[4] = {};
    const int sr = tid >> 4, sc = (tid & 15) * 8, vst0 = v_st(sr, sc), vst1 = v_st(32 + sr, sc), kws = KSWZ(sr, sc * 2);
    const int vb0 = (int)(uintptr_t)V_lds + v_rd_base(lane);
    const TIn* Kh = cur.K; const TIn* Vh = cur.V;
#define RESC(a) do { if (__any((a) < 1.f)) { if (hi == 0) al_l[r32] = (a); asm volatile("s_waitcnt lgkmcnt(0)" ::: "memory");              \
                     for (int d_ = 0; d_ < 4; ++d_) for (int r = 0; r < 16; ++r) o[d_][r] *= al_l[crow(r, hi)]; } } while (0)
#define KBASE(t) ((j_hi - 1 - (t)) * KVBLK)
    const __attribute__((address_space(3))) float* tabh = (const __attribute__((address_space(3))) float*)(lds + TAB_OFF) + 4 * hi;
#define BIAS(P0_, P1_, t) do { const __attribute__((address_space(3))) float* tb_ = tabh + KBASE(t); _Pragma("unroll") for (int j_ = 0; j_ < 4; ++j_) { const f32x4 b0_ = *(const __attribute__((address_space(3))) f32x4*)(tb_ + 8 * j_), b1_ = *(const __attribute__((address_space(3))) f32x4*)(tb_ + 32 + 8 * j_); \
        P0_[4 * j_] += b0_[0]; P0_[4 * j_ + 1] += b0_[1]; P0_[4 * j_ + 2] += b0_[2]; P0_[4 * j_ + 3] += b0_[3]; P1_[4 * j_] += b1_[0]; P1_[4 * j_ + 1] += b1_[1]; P1_[4 * j_ + 2] += b1_[2]; P1_[4 * j_ + 3] += b1_[3]; } } while (0)
#define ACT(t) (KBASE(t) <= qlo + QBLK - 1 && KBASE(t) + KVBLK - 1 >= qlo - W + 1)
#define MASKT(P0_, P1_, t) do { const int kb_ = KBASE(t); if ((!SK || ACT(t)) && (kb_ + KVBLK - 1 > qlo || kb_ <= qlo + QBLK - 1 - W)) mask_tile(P0_, P1_, qm - kb_, (unsigned)W); } while (0)
    constexpr int NQL = F32 ? 16 : 8;
    constexpr bool SK = WSKIP && !F32;
#define SEAM_K0() do { VMWN(NQL); if constexpr (F32) { SWRITE_KF(0); SBAR(); SLOAD_F((const float*)nxt.V, kbn); } else { SWRITE_HK(0); } SBAR(); } while (0)
    f32x16 pA0, pA1, pB0, pB1; float mnA, mnB, alA, alB; bf16x8 pa0, pa1, pa2, pa3;
    if constexpr (F32) { VMW(); SWRITE_VF(0); SBAR(); } else { SWRITE_HV(0); SBAR(); }
    if (NT > 1) { if constexpr (F32) SLOAD_F((const float*)Kh, KBASE(1)); else SLOAD_H(Kh, Vh, KBASE(1)); }
    SBAR(); qkt<0, SK>(pA0, pA1, K_lds, r32, hi, S.qr, ACT(0), tabh + KBASE(0));
    if constexpr (F32) { if (NT > 1) { VMW(); SWRITE_KF(1); SBAR(); SLOAD_F((const float*)Vh, KBASE(1)); } }
    bool deadA = false, deadB = false;
    MASKT(pA0, pA1, 0); partialSM(pA0, pA1, m_reg, mnA, alA, deadA);
    if (NT > 1) { VMW(); if constexpr (F32) { SWRITE_VF(1); SBAR(); if (NT > 2) SLOAD_F((const float*)Kh, KBASE(2)); } else SWRITE_H(1); }
    __syncthreads();
#define HALF_STEP(PX0, PX1, mnX, alX, PY0, PY1, alY, t, KB, VB, SB, dX, dY) do {                                                      \
        SBAR(); qkt<KB, SK>(PX0, PX1, K_lds, r32, hi, S.qr, ACT(t), tabh + KBASE(t));                                             \
        if (!(dY)) finishSM(PY0, PY1, alY, l_reg, pa0, pa1, pa2, pa3); SBAR();                                                \
        if ((t) + 1 < NT) { if constexpr (F32) { VMW(); SWRITE_KF(SB); SBAR(); SLOAD_F((const float*)Vh, KBASE((t) + 1)); }  \
                            else { SLOAD_H(Kh, Vh, KBASE((t) + 1)); } SBAR(); }                                               \
        if (!(dY)) pv_tile<VB, SK>(o, vb0, pa0, pa1, pa2, pa3, ACT((t) - 1)); MASKT(PX0, PX1, (t)); partialSM(PX0, PX1, m_reg, mnX, alX, dX);                                        \
        __syncthreads();                                                                                                      \
        if ((t) + 1 < NT) { VMW(); if constexpr (F32) { SWRITE_VF(SB); SBAR(); if ((t) + 2 < NT) SLOAD_F((const float*)Kh, KBASE((t) + 2)); } \
                            else { SWRITE_H(SB); } }                                                                          \
        RESC(alX); __syncthreads(); } while (0)
    for (int t = 1; t + 1 < NT; t += 2) {
        HALF_STEP(pB0, pB1, mnB, alB, pA0, pA1, alA, t, 1, 0, 0, deadB, deadA);
        HALF_STEP(pA0, pA1, mnA, alA, pB0, pB1, alB, t + 1, 0, 1, 1, deadA, deadB);
    }
    const bool even = (NT & 1) == 0;
    if (even) { SBAR(); qkt<1, SK>(pB0, pB1, K_lds, r32, hi, S.qr, ACT(NT - 1), tabh + KBASE(NT - 1)); SBAR(); }
#define QROW(e) (nxt.Q + (size_t)(wid * QBLK + r32) * LDQ + ((e) >> 1) * 16 + hi * 8 + ((e) & 1) * 4)
    if constexpr (F32) { SLOAD_F((const float*)nxt.K, kbn); SBAR();
#pragma unroll
        for (int e = 0; e < 8; ++e) S.tq[e] = *(const f32x4*)QROW(e); }
    else { SLOAD_H(nxt.K, nxt.V, kbn); SBAR();
#pragma unroll
        for (int d0 = 0; d0 < 8; ++d0) S.qr[d0] = load8<TIn>(nxt.Q + (unsigned)((wid * QBLK + r32) * LDQ + d0 * 16 + hi * 8)); }
    SBAR();
    if (!deadA) finishSM(pA0, pA1, alA, l_reg, pa0, pa1, pa2, pa3); SBAR();
    if constexpr (F32) {
#pragma unroll
        for (int e = 8; e < 16; ++e) S.tq[e] = *(const f32x4*)QROW(e); SBAR(); }
#undef QROW
    if (!deadA) pv_tile<0, SK>(o, vb0, pa0, pa1, pa2, pa3, ACT(even ? NT - 2 : NT - 1));
    if (even) { MASKT(pB0, pB1, NT - 1); partialSM(pB0, pB1, m_reg, mnB, alB, deadB); __syncthreads(); RESC(alB);
        if (!deadB) { finishSM(pB0, pB1, alB, l_reg, pa0, pa1, pa2, pa3); SBAR(); pv_tile<1, SK>(o, vb0, pa0, pa1, pa2, pa3, ACT(NT - 1)); } }
    SBAR(); SEAM_K0();
    if (hi == 0) li_l[r32] = l_reg; asm volatile("s_waitcnt lgkmcnt(0)" ::: "memory");
    float rli[16];
#pragma unroll
    for (int r = 0; r < 16; ++r) rli[r] = __builtin_amdgcn_rcpf(li_l[crow(r, hi)]);
    TOut* Ow = cur.O + (unsigned)((wid * QBLK) * LDO);
#pragma unroll
    for (int r = 0; r < 16; ++r) { const int orow = crow(r, hi);
#pragma unroll
        for (int d0 = 0; d0 < 4; ++d0) { const float v = o[d0][r] * rli[r];
            if constexpr (same_t<TOut, float>::v) { Ow[(size_t)orow * LDO + d0 * 32 + r32] = v; }
            else { const float vn = __int_as_float(__builtin_amdgcn_update_dpp(0, __float_as_int(v), 0xB1, 0xf, 0xf, true));
                   if ((r32 & 1) == 0) *(unsigned*)(Ow + (unsigned)(orow * LDO + d0 * 32 + r32)) = cvtpk(v, vn); } } }
    if constexpr (F32) {
#pragma unroll
        for (int d0 = 0; d0 < 8; ++d0) S.qr[d0] = pack8(S.tq[2 * d0], S.tq[2 * d0 + 1]); }
    __syncthreads();
#undef RESC
#undef KBASE
#undef BIAS
#undef ACT
#undef MASKT
#undef SEAM_K0
#undef HALF_STEP
}
#undef ROW
#undef VMW
#undef VMWN
#undef SLOAD_H
#undef SWRITE_HK
#undef SWRITE_HV
#undef SWRITE_H
#undef SLOAD_F
#undef SWRITE_KF
#undef SWRITE_VF


}

constexpr size_t MiB = (size_t)1 << 20;
constexpr size_t WS_CTL = 0, CTL_ZERO_BYTES = 1 * MiB;
constexpr size_t WS_WF = 1 * MiB;
constexpr size_t WS_SSQ = 2 * MiB;
constexpr size_t WS_CL = 4 * MiB;
constexpr size_t WS_TOT = 5 * MiB;
constexpr size_t WS_SSQV = 6 * MiB;
constexpr size_t WS_WTRIL = 7 * MiB;
constexpr size_t WS_W = 8 * MiB, W_LAYER = 118 * MiB;
constexpr size_t W_IN = 0, W_A = 36 * MiB, W_B = 40 * MiB, W_OUT = 44 * MiB, W_UP = 52 * MiB, W_DOWN = 96 * MiB;
constexpr size_t WS_X = 480 * MiB;
constexpr size_t WS_XB = 608 * MiB;
constexpr size_t WS_R1 = 672 * MiB;
constexpr size_t WS_YA = 960 * MiB, WS_YB = 992 * MiB, WS_MG = 1024 * MiB;
constexpr size_t WS_G = 1088 * MiB;
constexpr size_t WS_SIDEA = WS_R1, WS_SIDEH = WS_R1 + 4 * MiB;
constexpr size_t WS_END = 1264 * MiB;
constexpr int CW_BAR = 4096;

constexpr int LDS_BYTES = 160 * 1024;
constexpr int MISC_OFF = LDS_BYTES - 256, ARGS_OFF = LDS_BYTES - 512, HALO_OFF = 131072;

#define XB_TMO      128
#define XB_XCNT(j)  (256  + 64 * (j))
#define XB_XSUB(j)  (1280 + 64 * (j))
#define XB_XGEN(j)  (2304 + 64 * (j))
#define XB_TOP      3328
#define XB_TOPGEN   3392
#define XCD_BAR_WORDS 3456
#define XB_SPIN_CAP (1u << 18)

__device__ __forceinline__ unsigned xb_ld(unsigned* p)              { return __hip_atomic_load(p, __ATOMIC_RELAXED, __HIP_MEMORY_SCOPE_AGENT); }
__device__ __forceinline__ unsigned xb_add(unsigned* p, unsigned v) { return __hip_atomic_fetch_add(p, v, __ATOMIC_RELAXED, __HIP_MEMORY_SCOPE_AGENT); }
__device__ __forceinline__ unsigned xb_xcc_id() { return (unsigned)__builtin_amdgcn_s_getreg((3 << 11) | 20) & 0xFu; }
#define XB_SPIN(cond, bar) do { unsigned _sp = 0; while (cond) { __builtin_amdgcn_s_sleep(1); \
    if ((++_sp & 255u) == 0u) { if (xb_ld(&(bar)[XB_TMO])) break; if (_sp > XB_SPIN_CAP) { atomicAdd(&(bar)[XB_TMO], 1u); break; } } } } while (0)

struct XcdBarrier {
    unsigned* bar; unsigned x;
    volatile LAS unsigned* st;
};

__device__ __forceinline__ XcdBarrier xcd_barrier_post(unsigned* bar, volatile LAS unsigned* st) {
    XcdBarrier b; b.bar = bar; b.x = xb_xcc_id(); b.st = st;
    if (threadIdx.x == 0) (void)xb_add(&bar[XB_XCNT(b.x)], 1u);
    return b;
}
__device__ __forceinline__ void xcd_barrier_complete(unsigned* bar, unsigned x, unsigned& nloc, unsigned& nx) {
    const unsigned G = gridDim.x * gridDim.y * gridDim.z;
    unsigned sum, cnt, mine, sp = 0u;
    for (;;) {
        sum = 0u; cnt = 0u; mine = 0u;
#pragma unroll
        for (unsigned j = 0; j < 16; ++j) { const unsigned c = xb_ld(&bar[XB_XCNT(j)]); sum += c; cnt += (c > 0u) ? 1u : 0u; mine = (j == x) ? c : mine; }
        if (sum == G) break;
        __builtin_amdgcn_s_sleep(1);
        if ((++sp & 255u) == 0u) { if (xb_ld(&bar[XB_TMO])) break; if (sp > XB_SPIN_CAP) { atomicAdd(&bar[XB_TMO], 1u); break; } }
    }
    nloc = mine > 0u ? mine : 1u; nx = cnt > 0u ? cnt : 1u;
}

__device__ __forceinline__ void xcd_barrier(const XcdBarrier& b, int tid_in) {
    asm volatile("s_waitcnt vmcnt(0)" ::: "memory");
    __syncthreads();
    if (tid_in == 0) {
        unsigned* bar = b.bar;
        __builtin_amdgcn_s_waitcnt(0);
        unsigned nloc = b.st[0], nx = b.st[1];
        if (nloc == 0u) { xcd_barrier_complete(bar, b.x, nloc, nx); b.st[0] = nloc; b.st[1] = nx; }
        const unsigned old = xb_add(&bar[XB_XSUB(b.x)], 1u);
        const unsigned gen = old / nloc;
        if (old + 1u == (gen + 1u) * nloc) {
            __builtin_amdgcn_fence(__ATOMIC_RELEASE, "agent");
            asm volatile("s_waitcnt vmcnt(0)" ::: "memory");
            const unsigned og = xb_add(&bar[XB_TOP], 1u);
            const unsigned tg = og / nx;
            if (og + 1u == (tg + 1u) * nx) xb_add(&bar[XB_TOPGEN], 1u);
            else XB_SPIN(xb_ld(&bar[XB_TOPGEN]) == tg, bar);
            __builtin_amdgcn_fence(__ATOMIC_ACQUIRE, "agent");
            xb_add(&bar[XB_XGEN(b.x)], 1u);
            asm volatile("s_waitcnt vmcnt(0)" ::: "memory");
        } else {
            XB_SPIN(xb_ld(&bar[XB_XGEN(b.x)]) == gen, bar);
            __builtin_amdgcn_fence(__ATOMIC_ACQUIRE, "agent");
            asm volatile("s_waitcnt vmcnt(0)" ::: "memory");
        }
    }
    __syncthreads();
}

struct Args { const float* in[16]; float* out; unsigned char* ws; int ph_lo, ph_hi; };
enum { IN_X = 0, IN_GMIX, IN_WIN, IN_BF, IN_GSGU, IN_WSP, IN_BSP, IN_WA, IN_WB, IN_WOUT, IN_GFFN, IN_WUP, IN_CW, IN_CB, IN_WDOWN, IN_GFIN };

struct TrJob { const float* src; const float* gain; bf16* dst; int ldS, srcCol0, K, dstRow0, k0, dk; unsigned gmask; };
__device__ __forceinline__ TrJob tr_decode(const Args& a, int j) {
    constexpr int J_IN = 16 * 72, J_A = 8 * 16, J_OUT = 16 * 16, J_UP = 16 * 88, J_DOWN = 44 * 16, J_LAYER = J_IN + 2 * J_A + J_OUT + J_UP + J_DOWN;
    const int l = j / J_LAYER; int r = j % J_LAYER; unsigned char* wl = a.ws + WS_W + (size_t)l * W_LAYER; TrJob t; t.gain = a.in[IN_GMIX]; t.gmask = 0u; t.dk = 0;
    if (r < J_IN) { const int tn = r % 72, kt = r / 72; t.src = a.in[IN_WIN] + (size_t)l * DM * INW; t.ldS = INW; t.srcCol0 = tn < 24 ? tn * 128 : (tn < 40 ? tn * 128 + 8 : (((tn - 40) & 1) ? 7176 : 5128) + ((tn - 40) >> 1) * 128);
        t.gain = a.in[IN_GMIX] + l * DM; t.gmask = ~0u; t.dst = (bf16*)(wl + W_IN); t.K = DM; t.dstRow0 = tn * 128; t.k0 = kt * 128; return t; } r -= J_IN;
    if (r < J_A) { const int tn = r % 16, kt = r / 16; t.src = a.in[IN_WA] + (size_t)l * FW * DM; t.ldS = DM; t.srcCol0 = tn * 128; t.dst = (bf16*)(wl + W_A); t.K = DM; t.dstRow0 = tn * 128; t.k0 = kt * 128; return t; } r -= J_A;
    if (r < J_A) { const int tn = r % 16, kt = r / 16; t.src = a.in[IN_WB] + (size_t)l * SW * DM; t.ldS = DM; t.srcCol0 = tn * 128; t.dst = (bf16*)(wl + W_A); t.K = DM; t.dstRow0 = tn * 128; t.k0 = kt * 128; t.dk = FW; return t; } r -= J_A;
    if (r < J_OUT) { const int tn = r % 16, kt = r / 16; t.src = a.in[IN_WOUT] + (size_t)l * DM * DM; t.ldS = DM; t.srcCol0 = tn * 128; t.dst = (bf16*)(wl + W_OUT); t.K = DM; t.dstRow0 = tn * 128; t.k0 = kt * 128; return t; } r -= J_OUT;
    if (r < J_UP) { const int tn = r % 88, kt = r / 88; t.src = a.in[IN_WUP] + (size_t)l * DM * NUP; t.ldS = NUP; t.srcCol0 = (tn & 1) * DFF + (tn >> 1) * 128; t.gain = a.in[IN_GFFN] + l * DM; t.gmask = ~0u; t.dst = (bf16*)(wl + W_UP); t.K = DM; t.dstRow0 = tn * 128; t.k0 = kt * 128; return t; } r -= J_UP;
    { const int tn = r % 16, kt = r / 16; t.src = a.in[IN_WDOWN] + (size_t)l * DFF * DM; t.ldS = DM; t.srcCol0 = tn * 128; t.dst = (bf16*)(wl + W_DOWN); t.K = DFF; t.dstRow0 = tn * 128; t.k0 = kt * 128; return t; }
}
__device__ __forceinline__ void tr_load(const TrJob& t, int tid, f32x4 (&v)[8], float (&g)[8]) {
    const int kr = tid >> 5, c4 = tid & 31;
#pragma unroll
    for (int i = 0; i < 8; ++i) { const int k = t.k0 + kr + 16 * i; v[i] = *(const f32x4*)(t.src + (size_t)k * t.ldS + t.srcCol0 + 4 * c4);
        g[i] = t.gain[k]; }
}
__device__ __forceinline__ void tr_step(const Args& a, unsigned char* lds, int tid, int j, int G, int J_TOTAL, int buf, f32x4 (&v)[8], float (&g)[8]) {
    const int kr = tid >> 5, c4 = tid & 31;
    const TrJob t = tr_decode(a, j); float* T = (float*)(lds + buf * 66048);
#pragma unroll
    for (int i = 0; i < 8; ++i) { float* tp = T + (kr + 16 * i) * 129 + 4 * c4; const float gi = __builtin_bit_cast(float, (__builtin_bit_cast(unsigned, g[i]) & t.gmask) | (0x3f800000u & ~t.gmask));
        tp[0] = v[i][0] * gi; tp[1] = v[i][1] * gi; tp[2] = v[i][2] * gi; tp[3] = v[i][3] * gi; }
    if (j + 2 * G < J_TOTAL) { const TrJob tn_ = tr_decode(a, j + 2 * G); tr_load(tn_, tid, v, g); }
    __syncthreads();
#pragma unroll
    for (int i = 0; i < 4; ++i) { const int idx = tid + 512 * i, n = idx >> 4, kc = idx & 15; const float* tp = T + (8 * kc) * 129 + n;
        u32x4 w; w.x = cvt_pk_bf16(tp[0], tp[129]); w.y = cvt_pk_bf16(tp[2 * 129], tp[3 * 129]); w.z = cvt_pk_bf16(tp[4 * 129], tp[5 * 129]); w.w = cvt_pk_bf16(tp[6 * 129], tp[7 * 129]);
        *(u32x4*)(t.dst + (size_t)(t.dstRow0 + n) * t.K + t.dk + t.k0 + 8 * kc) = w; }
}
__device__ __forceinline__ void ph_rowstats(const float* src, bf16* xb, float* ssq, int gw, int ngw, int lane) {
    for (int row = gw; row < MTOK; row += ngw) {
        const f32x4* p = (const f32x4*)(src + (size_t)row * DM) + lane; f32x4 v[8]; float s = 0.f;
#pragma unroll
        for (int j = 0; j < 8; ++j) { v[j] = p[64 * j]; s += (v[j][0] * v[j][0] + v[j][1] * v[j][1]) + (v[j][2] * v[j][2] + v[j][3] * v[j][3]); }
        s = wave_sum(s);
        u32x2* o = (u32x2*)(xb + (size_t)row * DM) + lane;
#pragma unroll
        for (int j = 0; j < 8; ++j) { u32x2 w; w.x = cvt_pk_bf16(v[j][0], v[j][1]); w.y = cvt_pk_bf16(v[j][2], v[j][3]); o[64 * j] = w; }
        if (lane < 32) ssq[(size_t)row * 32 + lane] = lane == 0 ? s : 0.f;
    }
}
__device__ __forceinline__ void ph_prologue(const Args& a, unsigned char* lds, int tid, int lane, int wave, int bx, int G) {
    unsigned char* ws = a.ws;
    constexpr int J_TOTAL = DEPTH * (16 * 72 + 2 * 8 * 16 + 16 * 16 + 16 * 88 + 44 * 16);
    { f32x4 va[8], vb[8]; float ga[8], gb[8]; int j = bx;
      if (j < J_TOTAL) { const TrJob t = tr_decode(a, j); tr_load(t, tid, va, ga); }
      if (j + G < J_TOTAL) { const TrJob t = tr_decode(a, j + G); tr_load(t, tid, vb, gb); }
      for (;;) {
          if (j >= J_TOTAL) break;
          tr_step(a, lds, tid, j, G, J_TOTAL, 0, va, ga);
          j += G; if (j >= J_TOTAL) break;
          tr_step(a, lds, tid, j, G, J_TOTAL, 1, vb, gb);
          j += G;
      }
      __syncthreads(); }
    { bf16* wf = (bf16*)(ws + WS_WF);
      for (int i = bx * 512 + tid; i < DEPTH * 16 * DM; i += G * 512) { const int k = i % DM, h = (i / DM) % 16, l = i / (DM * 16);
          wf[i] = h < NH ? f2bf(a.in[IN_WIN][((size_t)l * DM + k) * INW + 3 * FW + h] * a.in[IN_GMIX][l * DM + k]) : (bf16)0; } }
    { bf16* wt = (bf16*)(ws + WS_WTRIL); const float* wsp = a.in[IN_WSP];
      for (int i = bx * 512 + tid; i < DEPTH * NG * SCH * SCH; i += G * 512) { const int s_ = i & 127, t_ = (i >> 7) & 127; wt[i] = f2bf(s_ <= t_ ? wsp[i] : 0.f); } }
    ph_rowstats(a.in[IN_X], (bf16*)(ws + WS_XB), (float*)(ws + WS_SSQ), bx * 8 + wave, G * 8, lane);
}

__device__ __forceinline__ void f_unit(const Args& a, int l, int u, unsigned char* lds, int tid, int lane, int wave) {
    unsigned char* ws = a.ws; const bf16* xb = (const bf16*)(ws + WS_XB); const bf16* wf = (const bf16*)(ws + WS_WF) + (size_t)l * 16 * DM; const float* ssq = (const float*)(ws + WS_SSQ);
    float* part = (float*)lds;
    float* lf = (float*)(lds + 16384);
    float* invl = (float*)(lds + 16384 + 2048);
    const int r16 = lane & 15, q = lane >> 4, kb = wave * 256, tok0 = u * 64;
    f32x4 acc[4];
#pragma unroll
    for (int tb = 0; tb < 4; ++tb) acc[tb] = (f32x4){0.f, 0.f, 0.f, 0.f};
    const bf16* wrow = wf + (size_t)r16 * DM + kb + 8 * q; const bf16* xrow = xb + (size_t)(tok0 + r16) * DM + kb + 8 * q;
#pragma unroll
    for (int kh = 0; kh < 2; ++kh) { bf16x8 wv[4], xv[4][4];
#pragma unroll
        for (int k4 = 0; k4 < 4; ++k4) { const int ks = 4 * kh + k4; wv[k4] = *(const bf16x8*)(wrow + 32 * ks);
#pragma unroll
            for (int tb = 0; tb < 4; ++tb) xv[k4][tb] = *(const bf16x8*)(xrow + (size_t)(16 * tb) * DM + 32 * ks); }
        __builtin_amdgcn_sched_barrier(0);
#pragma unroll
        for (int k4 = 0; k4 < 4; ++k4)
#pragma unroll
            for (int tb = 0; tb < 4; ++tb) acc[tb] = __builtin_amdgcn_mfma_f32_16x16x32_bf16(wv[k4], xv[k4][tb], acc[tb], 0, 0, 0);
        __builtin_amdgcn_sched_barrier(0); }
    if (q < 2) {
#pragma unroll
        for (int tb = 0; tb < 4; ++tb) *(f32x4*)(part + (size_t)((wave * 64 + 16 * tb + r16) * 8 + 4 * q)) = acc[tb]; }
    if (tid < 64) { const f32x4* p = (const f32x4*)(ssq + (size_t)(tok0 + tid) * 32); float s = 0.f;
#pragma unroll
        for (int j = 0; j < 8; ++j) { const f32x4 v = p[j]; s += (v[0] + v[1]) + (v[2] + v[3]); }
        invl[tid] = rsqrtf(s * (1.0f / DM) + RMS_EPS); }
    __syncthreads();
    { const int token = tid >> 3, h = tid & 7; float s = 0.f;
#pragma unroll
      for (int w = 0; w < 8; ++w) s += part[(w * 64 + token) * 8 + h];
      lf[tid] = log_sigmoid_f(s * invl[token] + a.in[IN_BF][l * NH + h]); }
    __syncthreads();
    if (tid < 8) { float run = 0.f; for (int t = 0; t < 64; ++t) { run += lf[t * 8 + tid]; lf[t * 8 + tid] = run; }
        ((float*)(ws + WS_TOT))[u * 8 + tid] = run; }
    __syncthreads();
    { float* cl = (float*)(ws + WS_CL); const int b = u >> 6, c64 = u & 63; const int tl = tid & 63, h = tid >> 6; cl[((size_t)(b * NH + h)) * SEQ + c64 * 64 + tl] = lf[tl * 8 + h]; }
    __syncthreads();
}

__device__ __forceinline__ void attn_table(const float* cl, const float* tot, char* lds, int bh, int tid) {
    float* tab = (float*)(lds + fa::TAB_OFF); float* pre = tab + SEQ; const int b = bh >> 3, h = bh & 7;
    __syncthreads();
    if (tid < 64) {
        const float v = tot[(b * 64 + tid) * 8 + h]; float s = v;
        s += __builtin_bit_cast(float, __builtin_amdgcn_update_dpp(0, __builtin_bit_cast(int, s), 0x111, 0xf, 0xf, false));
        s += __builtin_bit_cast(float, __builtin_amdgcn_update_dpp(0, __builtin_bit_cast(int, s), 0x112, 0xf, 0xf, false));
        s += __builtin_bit_cast(float, __builtin_amdgcn_update_dpp(0, __builtin_bit_cast(int, s), 0x114, 0xf, 0xf, false));
        s += __builtin_bit_cast(float, __builtin_amdgcn_update_dpp(0, __builtin_bit_cast(int, s), 0x118, 0xf, 0xf, false));
        s += __builtin_bit_cast(float, __builtin_amdgcn_update_dpp(0, __builtin_bit_cast(int, s), 0x142, 0xa, 0xf, false));
        s += __builtin_bit_cast(float, __builtin_amdgcn_update_dpp(0, __builtin_bit_cast(int, s), 0x143, 0xc, 0xf, false));
        pre[tid] = s - v; }
    __syncthreads();
    for (int i = tid; i < SEQ; i += 512) tab[i] = -(cl[(size_t)bh * SEQ + i] + pre[i >> 6]) * 11.313708498984761f;
    __syncthreads();
}
__device__ __forceinline__ fa::BlockRef<bf16, bf16> attn_ref(const bf16* Qb, const bf16* Kb, const bf16* Vb, bf16* Ob, int bh, int qb) {
    const int b = bh >> 3, h = bh & 7; const size_t rq = (size_t)(b * SEQ + qb * 256) * 1024 + h * HD, rk = (size_t)(b * SEQ) * 1024 + h * HD, ro = (size_t)(b * SEQ + qb * 256) * 2048 + h * HD;
    fa::BlockRef<bf16, bf16> r; r.Q = Qb + rq; r.O = Ob + ro; r.K = Kb + rk; r.V = Vb + rk; r.P0 = qb * 256; return r;
}
#define MK_TID(t_) int t_; { int l_; asm volatile("v_mbcnt_lo_u32_b32 %0, -1, 0\n\tv_mbcnt_hi_u32_b32 %0, -1, %0" : "=v"(l_)); t_ = wave * 64 + l_; }
__device__ __forceinline__ void attn_fast(unsigned char* ws, unsigned char* ldsg, int wave, int bx, int G) {
    char* lds = (char*)ldsg;
    const bf16* Qb = (const bf16*)(ws + WS_R1); const bf16* Kb = Qb + (size_t)MTOK * 1024; const bf16* Vb = Kb + (size_t)MTOK * 1024; bf16* Ob = (bf16*)(ws + WS_YA);
    const float* cl = (const float*)(ws + WS_CL); const float* tot = (const float*)(ws + WS_TOT);
    const int total = NB * NH * 8, stride = G, W = SEQ;
    int L = bx;
    if (L < total) {
#define FA_DEC(L_, bh_, x_) do { bh_ = (((L_) >> 6) << 3) + ((L_) & 7); x_ = ((L_) >> 3) & 7; } while (0)
        int bh, x, pass = 0; FA_DEC(L, bh, x);
        fa::BlockRef<bf16, bf16> cur = attn_ref(Qb, Kb, Vb, Ob, bh, x);
        fa::Seam<bf16> S;
        { MK_TID(t0); attn_table(cl, tot, lds, bh, t0); fa::causal_swa_prime<bf16, bf16>(cur, W, lds, S, t0); }
        for (;;) {
            const bool more_pass = pass == 0, more_item = L + stride < total, last = !more_pass && !more_item;
            int bhn = bh, xn = x, passn = pass + 1, Ln = L;
            if (!more_pass) { passn = 0; Ln = more_item ? L + stride : L; FA_DEC(Ln, bhn, xn); }
            const fa::BlockRef<bf16, bf16> nxt = last ? cur : attn_ref(Qb, Kb, Vb, Ob, passn ? (bhn ^ 4) : bhn, passn ? 15 - xn : xn);
            { MK_TID(t1); fa::causal_swa_block<bf16, bf16>(cur, nxt, SEQ, W, lds, S, t1); }
            if (last) break;
            { MK_TID(t2); attn_table(cl, tot, lds, passn ? (bhn ^ 4) : bhn, t2); }
            cur = nxt; bh = bhn; x = xn; pass = passn; L = Ln;
        }
#undef FA_DEC
    }
    __syncthreads();
}

__device__ __forceinline__ void sgu_fast(const Args& a, int l, unsigned char* lds, int tid, int lane, int wave, int bx, int G) {
    unsigned char* ws = a.ws; const bf16* GU = (const bf16*)(ws + WS_R1) + (size_t)3 * MTOK * 1024; const bf16* GVT = GU + (size_t)MTOK * 1024; bf16* YB = (bf16*)(ws + WS_YA);
    const float* ssqv = (const float*)(ws + WS_SSQV); const bf16* Wt = (const bf16*)(ws + WS_WTRIL) + (size_t)l * NG * SCH * SCH;
    const float* gs = a.in[IN_GSGU] + l * SW; const float* bsp = a.in[IN_BSP] + (size_t)l * NG * SCH;
    float* invl = (float*)lds;
    const int r16 = lane & 15, q = lane >> 4, nks = (wave >> 1) + 1;
    constexpr int NUNIT = (MTOK / SCH) * NG;
    __syncthreads();
    for (int i = tid; i < 8 * SCH; i += 512) { const int unit = bx + (i >> 7) * G; if (unit < NUNIT) { const int tok = (unit >> 3) * SCH + (i & 127);
            const f32x4* p = (const f32x4*)(ssqv + (size_t)tok * 16); float s = 0.f;
#pragma unroll
            for (int k = 0; k < 4; ++k) { const f32x4 v = p[k]; s += (v[0] + v[1]) + (v[2] + v[3]); }
            invl[i] = rsqrtf(s * (1.0f / SW) + RMS_EPS); } }
    __syncthreads();
    int ui = 0;
    for (int unit = bx; unit < NUNIT; unit += G, ++ui) {
        const int n = unit >> 3, g = unit & 7, tok0 = n * SCH; const float* invu = invl + (ui & 7) * SCH;
        if (ui >= 8) break;
        f32x4 acc[8];
#pragma unroll
        for (int cb = 0; cb < 8; ++cb) acc[cb] = (f32x4){0.f, 0.f, 0.f, 0.f};
        const bf16* wrow = Wt + ((size_t)g * SCH + 16 * wave + r16) * SCH + 8 * q;
        const bf16* vrow = GVT + ((size_t)n * SW + g * GD + r16) * SCH + 8 * q;
#pragma unroll
        for (int kp = 0; kp < 2; ++kp) if (2 * kp < nks) {
            const bool two = 2 * kp + 1 < nks; u32x4 wr2[2]; bf16x8 vf2[2][8]; f32x4 i0[2], i1[2];
#pragma unroll
            for (int j = 0; j < 2; ++j) { const int ks = (j == 0 || two) ? 2 * kp + j : 2 * kp;
                wr2[j] = *(const u32x4*)(wrow + 32 * ks); i0[j] = *(const f32x4*)(invu + 32 * ks + 8 * q); i1[j] = *(const f32x4*)(invu + 32 * ks + 8 * q + 4);
#pragma unroll
                for (int cb = 0; cb < 8; ++cb) vf2[j][cb] = *(const bf16x8*)(vrow + (size_t)(16 * cb) * SCH + 32 * ks); }
            __builtin_amdgcn_sched_barrier(0);
#pragma unroll
            for (int j = 0; j < 2; ++j) if (j == 0 || two) { const u32x4 wr_ = wr2[j];
                u32x4 wp; wp.x = cvt_pk_bf16(bf_lo(wr_.x) * i0[j][0], bf_hi(wr_.x) * i0[j][1]); wp.y = cvt_pk_bf16(bf_lo(wr_.y) * i0[j][2], bf_hi(wr_.y) * i0[j][3]);
                wp.z = cvt_pk_bf16(bf_lo(wr_.z) * i1[j][0], bf_hi(wr_.z) * i1[j][1]); wp.w = cvt_pk_bf16(bf_lo(wr_.w) * i1[j][2], bf_hi(wr_.w) * i1[j][3]);
                const bf16x8 wf = __builtin_bit_cast(bf16x8, wp);
#pragma unroll
                for (int cb = 0; cb < 8; ++cb) acc[cb] = __builtin_amdgcn_mfma_f32_16x16x32_bf16(vf2[j][cb], wf, acc[cb], 0, 0, 0); }
            __builtin_amdgcn_sched_barrier(0);
        }
        const int t = 16 * wave + r16; const float bt = bsp[g * SCH + t]; const size_t orow = (size_t)(tok0 + t) * SW + g * GD + 4 * q, yrow = (size_t)(tok0 + t) * DM + FW + g * GD + 4 * q;
        f32x4 gn8[8]; u32x2 gu8[8];
#pragma unroll
        for (int cb = 0; cb < 8; ++cb) { gn8[cb] = *(const f32x4*)(gs + g * GD + 16 * cb + 4 * q); gu8[cb] = *(const u32x2*)(GU + orow + 16 * cb); }
        __builtin_amdgcn_sched_barrier(0);
#pragma unroll
        for (int cb = 0; cb < 8; ++cb) { const f32x4 gn = gn8[cb]; const u32x2 gu = gu8[cb];
            const f32x2 g01 = gelu_tanh_pk((f32x2){bf_lo(gu.x), bf_hi(gu.x)}), g23 = gelu_tanh_pk((f32x2){bf_lo(gu.y), bf_hi(gu.y)});
            const float o0 = (gn[0] * acc[cb][0] + bt) * g01.x, o1 = (gn[1] * acc[cb][1] + bt) * g01.y, o2 = (gn[2] * acc[cb][2] + bt) * g23.x, o3 = (gn[3] * acc[cb][3] + bt) * g23.y;
            u32x2 w; w.x = cvt_pk_bf16(o0, o1); w.y = cvt_pk_bf16(o2, o3); *(u32x2*)(YB + yrow + 16 * cb) = w; }
    }
    __syncthreads();
}

__device__ __forceinline__ void sgu_simple(const Args& a, int l, unsigned char* lds, int tid, int lane, int wave, int bx, int G) {
    unsigned char* ws = a.ws; const bf16* GU = (const bf16*)(ws + WS_R1) + (size_t)3 * MTOK * 1024; const bf16* GV = GU + (size_t)MTOK * 1024; bf16* YB = (bf16*)(ws + WS_YB);
    float* vn = (float*)lds; float* Wl = (float*)(lds + 65536); float* inv = (float*)(lds + 131072);
    const float* gs = a.in[IN_GSGU] + l * SW; const float* wsp = a.in[IN_WSP] + (size_t)l * NG * SCH * SCH; const float* bsp = a.in[IN_BSP] + (size_t)l * NG * SCH;
    for (int unit = bx; unit < (MTOK / SCH) * NG; unit += G) {
        const int n = unit >> 3, g = unit & 7, tok0 = n * SCH;
        __syncthreads();
        for (int i = 0; i < 16; ++i) { const int s = wave * 16 + i; const bf16* r = GV + (size_t)(tok0 + s) * SW + lane * 16; float ss = 0.f;
#pragma unroll
            for (int q = 0; q < 2; ++q) { const u32x4 w = *(const u32x4*)(r + 8 * q); const float e[8] = {bf_lo(w.x), bf_hi(w.x), bf_lo(w.y), bf_hi(w.y), bf_lo(w.z), bf_hi(w.z), bf_lo(w.w), bf_hi(w.w)};
#pragma unroll
                for (int j = 0; j < 8; ++j) ss += e[j] * e[j]; }
            ss = wave_sum(ss); if (lane == 0) inv[s] = rsqrtf(ss * (1.0f / SW) + RMS_EPS); }
        __syncthreads();
        for (int i = tid; i < SCH * GD; i += 512) { const int s = i >> 7, c = i & 127;
            vn[i] = bf2f(GV[(size_t)(tok0 + s) * SW + g * GD + c]) * inv[s] * gs[g * GD + c];
            Wl[i] = wsp[(size_t)g * SCH * SCH + i]; }
        __syncthreads();
        { const int c = tid & 127, tq = tid >> 7;
          for (int t = tq; t < SCH; t += 4) { float acc = 0.f; for (int s = 0; s <= t; ++s) acc += Wl[t * SCH + s] * vn[s * GD + c];
              const size_t o = (size_t)(tok0 + t) * SW + g * GD + c;
              YB[o] = f2bf((acc + bsp[g * SCH + t]) * bf2f(GU[o])); } }
    }
    __syncthreads();
}

__device__ __forceinline__ void conv_simple(const Args& a, int l, int tid, int bx, int G) {
    unsigned char* ws = a.ws; const bf16* AR = (const bf16*)(ws + WS_R1); bf16* Gb = (bf16*)(ws + WS_G);
    const float* cw = a.in[IN_CW] + (size_t)l * 3 * DFF; const float* cb = a.in[IN_CB] + (size_t)l * DFF;
    constexpr int NCG = DFF / 8;
    for (size_t i = (size_t)bx * 512 + tid; i < (size_t)MTOK * NCG; i += (size_t)G * 512) {
        const int row = (int)(i / NCG), cg = (int)(i % NCG), s = row & (SEQ - 1); const size_t o = (size_t)row * DFF + 8 * cg;
        const u32x4 z = {0u, 0u, 0u, 0u};
        const u32x4 a0 = *(const u32x4*)(AR + o), a1 = s >= 1 ? *(const u32x4*)(AR + o - DFF) : z, a2 = s >= 2 ? *(const u32x4*)(AR + o - 2 * DFF) : z, bb = *(const u32x4*)(Gb + o);
        const float x0[8] = {bf_lo(a0.x), bf_hi(a0.x), bf_lo(a0.y), bf_hi(a0.y), bf_lo(a0.z), bf_hi(a0.z), bf_lo(a0.w), bf_hi(a0.w)};
        const float x1[8] = {bf_lo(a1.x), bf_hi(a1.x), bf_lo(a1.y), bf_hi(a1.y), bf_lo(a1.z), bf_hi(a1.z), bf_lo(a1.w), bf_hi(a1.w)};
        const float x2[8] = {bf_lo(a2.x), bf_hi(a2.x), bf_lo(a2.y), bf_hi(a2.y), bf_lo(a2.z), bf_hi(a2.z), bf_lo(a2.w), bf_hi(a2.w)};
        const float bv[8] = {bf_lo(bb.x), bf_hi(bb.x), bf_lo(bb.y), bf_hi(bb.y), bf_lo(bb.z), bf_hi(bb.z), bf_lo(bb.w), bf_hi(bb.w)};
        float r[8];
#pragma unroll
        for (int j = 0; j < 8; ++j) { const int c = 8 * cg + j; const float v = cb[c] + cw[c] * x2[j] + cw[DFF + c] * x1[j] + cw[2 * DFF + c] * x0[j]; r[j] = gelu_tanh(v) * bv[j]; }
        u32x4 w; w.x = cvt_pk_bf16(r[0], r[1]); w.y = cvt_pk_bf16(r[2], r[3]); w.z = cvt_pk_bf16(r[4], r[5]); w.w = cvt_pk_bf16(r[6], r[7]);
        *(u32x4*)(Gb + o) = w;
    }
}
__device__ __forceinline__ void conv_fixup_panel(const Args& a, int l, int pm, int tid) {
    unsigned char* ws = a.ws; bf16* Gb = (bf16*)(ws + WS_G); const float* sideA = (const float*)(ws + WS_SIDEA); const float* sideH = (const float*)(ws + WS_SIDEH);
    const float* cw = a.in[IN_CW] + (size_t)l * 3 * DFF; const float* cb = a.in[IN_CB] + (size_t)l * DFF;
    for (int c = 4 * tid; c < DFF; c += 4 * 512) {
        const f32x4 z = {0.f, 0.f, 0.f, 0.f};
        const f32x4 xm2 = (pm & 15) ? *(const f32x4*)(sideA + ((size_t)(pm - 1) * 2 + 0) * DFF + c) : z, xm1 = (pm & 15) ? *(const f32x4*)(sideA + ((size_t)(pm - 1) * 2 + 1) * DFF + c) : z;
        const float* sh = sideH + (size_t)pm * 4 * DFF + c; const f32x4 a0 = *(const f32x4*)sh, a1 = *(const f32x4*)(sh + DFF), b0 = *(const f32x4*)(sh + 2 * DFF), b1 = *(const f32x4*)(sh + 3 * DFF);
        const f32x4 w0 = *(const f32x4*)(cw + c), w1 = *(const f32x4*)(cw + DFF + c), w2 = *(const f32x4*)(cw + 2 * DFF + c), cbv = *(const f32x4*)(cb + c);
        float g0[4], g1[4];
#pragma unroll
        for (int k = 0; k < 4; ++k) { g0[k] = gelu_tanh(cbv[k] + w0[k] * xm2[k] + w1[k] * xm1[k] + w2[k] * a0[k]) * b0[k]; g1[k] = gelu_tanh(cbv[k] + w0[k] * xm1[k] + w1[k] * a0[k] + w2[k] * a1[k]) * b1[k]; }
        u32x2 w; w.x = cvt_pk_bf16(g0[0], g0[1]); w.y = cvt_pk_bf16(g0[2], g0[3]); *(u32x2*)(Gb + (size_t)(pm * 256) * DFF + c) = w;
        w.x = cvt_pk_bf16(g1[0], g1[1]); w.y = cvt_pk_bf16(g1[2], g1[3]); *(u32x2*)(Gb + (size_t)(pm * 256 + 1) * DFF + c) = w;
    }
    asm volatile("s_waitcnt vmcnt(0)" ::: "memory"); __syncthreads();
}
__device__ __forceinline__ void ph_final(const Args& a, int gw, int ngw, int lane) {
    const bf16* xb = (const bf16*)(a.ws + WS_XB); const f32x4* gf = (const f32x4*)a.in[IN_GFIN] + lane;
    f32x4 gfr[8];
#pragma unroll
    for (int j = 0; j < 8; ++j) gfr[j] = gf[64 * j];
    for (int row = gw; row < MTOK; row += ngw) {
        const u32x2* p = (const u32x2*)(xb + (size_t)row * DM) + lane; f32x4 v[8]; float s = 0.f;
#pragma unroll
        for (int j = 0; j < 8; ++j) { const u32x2 w = p[64 * j]; v[j] = (f32x4){bf_lo(w.x), bf_hi(w.x), bf_lo(w.y), bf_hi(w.y)}; s += (v[j][0] * v[j][0] + v[j][1] * v[j][1]) + (v[j][2] * v[j][2] + v[j][3] * v[j][3]); }
        s = wave_sum(s); const float inv = rsqrtf(s * (1.0f / DM) + RMS_EPS);
        f32x4* o = (f32x4*)(a.out + (size_t)row * DM) + lane;
#pragma unroll
        for (int j = 0; j < 8; ++j) o[64 * j] = (v[j] * inv) * gfr[j];
    }
}

#ifndef STAGGER_US
#define STAGGER_US 6
#endif
__device__ __forceinline__ void stagger_delay(int bx) {
    const unsigned long long t0 = __builtin_amdgcn_s_memrealtime(), d = (unsigned long long)((bx >> 3) & 7) * (STAGGER_US * 100);
    while (__builtin_amdgcn_s_memrealtime() - t0 < d) __builtin_amdgcn_s_sleep(8);
}
#ifndef WGM_IN
#define WGM_IN 4
#endif
#ifndef WGM_UP
#define WGM_UP 4
#endif
#ifndef WGM_BR
#define WGM_BR 2
#endif
#ifndef WGM_OUT
#define WGM_OUT 2
#endif
#ifndef WGM_DOWN
#define WGM_DOWN 2
#endif
constexpr int PH_PER_LAYER = 6, N_PHASES = 2 + DEPTH * PH_PER_LAYER;
#define PHASE_BEGIN() int wave = wave0; asm volatile("" : "+s"(wave)); int lane; asm volatile("v_mbcnt_lo_u32_b32 %0, -1, 0\n\tv_mbcnt_hi_u32_b32 %0, -1, %0" : "=v"(lane)); int tid = wave * 64 + lane; \
    int bx = blockIdx.x; asm volatile("" : "+s"(bx)); int G = gridDim.x; asm volatile("" : "+s"(G)); \
    Args A; _Pragma("unroll") for (int i_ = 0; i_ < 16; ++i_) A.in[i_] = (const float*)(GAS const float*)ldarg(ARGL, i_); \
    A.out = (float*)(GAS float*)ldarg(ARGL, 16); A.ws = (unsigned char*)(GAS unsigned char*)ldarg(ARGL, 17); A.ph_lo = 0; A.ph_hi = 0; \
    unsigned char* ws = A.ws; (void)lane; (void)wave; (void)ws; (void)bx; (void)G
__device__ __forceinline__ unsigned long long ldarg(volatile LAS unsigned long long* t, int i) {
    const unsigned long long v = t[i]; const unsigned lo = __builtin_amdgcn_readfirstlane((unsigned)v), hi = __builtin_amdgcn_readfirstlane((unsigned)(v >> 32));
    return ((unsigned long long)hi << 32) | lo;
}
__global__ void __launch_bounds__(512, 2) fwd_kernel(Args args) {
    extern __shared__ __attribute__((aligned(16))) unsigned char lds[];
    volatile LAS unsigned* MISC = (volatile LAS unsigned*)((LAS unsigned char*)lds + MISC_OFF);
    volatile LAS unsigned long long* ARGL = (volatile LAS unsigned long long*)((LAS unsigned char*)lds + ARGS_OFF);
    if (threadIdx.x < 64) MISC[threadIdx.x] = 0u;
    { unsigned long long v_ = 0ull;
#pragma unroll
      for (int i_ = 0; i_ < 16; ++i_) if ((int)threadIdx.x == i_) v_ = (unsigned long long)args.in[i_];
      if (threadIdx.x == 16) v_ = (unsigned long long)args.out; if (threadIdx.x == 17) v_ = (unsigned long long)args.ws;
      if (threadIdx.x < 18) ARGL[threadIdx.x] = v_; }
    __syncthreads();
    const int lo = args.ph_lo, hi = args.ph_hi, wave0 = __builtin_amdgcn_readfirstlane(threadIdx.x >> 6);
    unsigned* ctl = (unsigned*)(args.ws + WS_CTL);
    XcdBarrier bar; bar.bar = ctl + CW_BAR; bar.x = 0; bar.st = nullptr;
    if (hi - lo > 1) bar = xcd_barrier_post(ctl + CW_BAR, MISC + 8);
#define IN(k) (lo <= (k) && (k) < hi)
#ifndef ONLY_J
#define ONLY_J -1
#endif
#ifndef DBG_LAST_J
#define DBG_LAST_J 99
#endif
#define INL(j) ((ONLY_J < 0 || ONLY_J == (j)) && (j) <= DBG_LAST_J && IN(pb + (j)))
#ifndef DUP_MASK
#define DUP_MASK 0
#endif
#define REP(bit) for (int rep_ = 0; rep_ < (((DUP_MASK) >> (bit)) & 1) + 1; ++rep_)
#define SEAM(k) do { if (lo <= (k) && (k) + 1 < hi) { XcdBarrier b_ = bar; { GAS unsigned* p_ = (GAS unsigned*)b_.bar; asm volatile("" : "+s"(p_)); b_.bar = (unsigned*)p_; } xcd_barrier(b_, tid); } } while (0)
    LAS unsigned char* ring = (LAS unsigned char*)lds;

    if (IN(0)) { PHASE_BEGIN(); REP(0) ph_prologue(A, lds, tid, lane, wave, bx, G); SEAM(0); }

#ifdef DBG_DUMP
    for (int l = 0; l < 1; ++l) {
#else
    for (int l = 0; l < DEPTH; ++l) {
#endif
        const int pb = 1 + l * PH_PER_LAYER;
        if (INL(0)) { PHASE_BEGIN();  {
            REP(1) for (int u = bx; u < MTOK / 64; u += G) f_unit(A, l, u, lds, tid, lane, wave);
             { const unsigned char* wl = ws + WS_W + (size_t)l * W_LAYER;
            pg8::Gemm g{(const bf16*)(ws + WS_XB), (const bf16*)(wl + W_IN), MTOK, NIN, DM}; pg8::StaticOrder S; S.init(MTOK, NIN, G, bx, WGM_IN);
            pg8::EpiInProj2 E{(const float*)(ws + WS_SSQ), (bf16*)(ws + WS_R1), (float*)(ws + WS_SSQV), (LAS float*)(ring + HALO_OFF) + 256};
            pg8::gemm_phase<pg8::EpiInProj2, pg8::StaticOrder, true, true>(ring, g, S, E, tid); }  }
            SEAM(pb + 0);
        }
        if (INL(1)) { { PHASE_BEGIN(); (void)tid;  attn_fast(ws, lds, wave, bx, G);  } { PHASE_BEGIN();  sgu_fast(A, l, lds, tid, lane, wave, bx, G);  SEAM(pb + 1); } }
        if (INL(2)) { PHASE_BEGIN();  {
            const unsigned char* wl = ws + WS_W + (size_t)l * W_LAYER; bf16* R1 = (bf16*)(ws + WS_R1);
            pg8::Gemm g{(const bf16*)(ws + WS_YA), (const bf16*)(wl + W_A), MTOK, DM, DM}; pg8::StaticOrder S; S.init(MTOK, DM, G, bx, WGM_BR);
            pg8::EpiBranch E{R1 + (size_t)5 * MTOK * 1024, R1 + (size_t)5 * MTOK * 1024 + (size_t)MTOK * 2048, (bf16*)(ws + WS_MG)};
            pg8::gemm_phase<pg8::EpiBranch, pg8::StaticOrder, true, true>(ring, g, S, E, tid); }
            SEAM(pb + 2);
        }
        if (INL(3)) { PHASE_BEGIN();
            const unsigned char* wl = ws + WS_W + (size_t)l * W_LAYER;
            pg8::Gemm g{(const bf16*)(ws + WS_MG), (const bf16*)(wl + W_OUT), MTOK, DM, DM}; pg8::StaticOrder S; S.init(MTOK, DM, G, bx, WGM_OUT);
#ifdef PROBE_D
            { pg8::EpiResidB E{(const float*)nullptr, (bf16*)(ws + WS_R1 + 160 * MiB), (float*)(ws + WS_R1 + 230 * MiB)};
              pg8::gemm_phase<pg8::EpiResidB, pg8::StaticOrder, true, true>(ring, g, S, E, tid); }
#endif
            pg8::EpiResidB E{l == 0 ? A.in[IN_X] : (const float*)nullptr, (bf16*)(ws + WS_XB), (float*)(ws + WS_SSQ)};
            pg8::gemm_phase<pg8::EpiResidB, pg8::StaticOrder, true, true>(ring, g, S, E, tid);
            SEAM(pb + 3);
        }
        if (INL(4)) { PHASE_BEGIN();  {
            const unsigned char* wl = ws + WS_W + (size_t)l * W_LAYER;
            pg8::Gemm g{(const bf16*)(ws + WS_XB), (const bf16*)(wl + W_UP), MTOK, NUP, DM}; pg8::StaticOrder S; S.init(MTOK, NUP, G, bx, WGM_UP);
            pg8::EpiUpConv E{(const float*)(ws + WS_SSQ), (bf16*)(ws + WS_G), A.in[IN_CW] + (size_t)l * 3 * DFF, A.in[IN_CB] + (size_t)l * DFF, (float*)(ws + WS_SIDEA), (float*)(ws + WS_SIDEH), (LAS float*)(ring + HALO_OFF)};
            pg8::gemm_phase<pg8::EpiUpConv, pg8::StaticOrder, true, true>(ring, g, S, E, tid); }
            SEAM(pb + 4);
        }
        if (INL(5)) { PHASE_BEGIN();
            const unsigned char* wl = ws + WS_W + (size_t)l * W_LAYER;
            pg8::Gemm g{(const bf16*)(ws + WS_G), (const bf16*)(wl + W_DOWN), MTOK, DM, DFF}; pg8::StaticOrder S; S.init(MTOK, DM, G, bx, WGM_DOWN);
            { pg8::Unit u0, u1; if (S.next(0, u0)) { conv_fixup_panel(A, l, u0.pm, tid); for (int i_ = 1; S.next(i_, u1); ++i_) if (u1.pm != u0.pm) { conv_fixup_panel(A, l, u1.pm, tid); u0 = u1; } } }
#ifdef PROBE_F
            { pg8::EpiResidB E{(const float*)nullptr, (bf16*)(ws + WS_R1 + 160 * MiB), (float*)(ws + WS_R1 + 230 * MiB)};
              pg8::gemm_phase<pg8::EpiResidB, pg8::StaticOrder, true, true>(ring, g, S, E, tid); }
#endif
            pg8::EpiResidB E{(const float*)nullptr, (bf16*)(ws + WS_XB), (float*)(ws + WS_SSQ)};
            pg8::gemm_phase<pg8::EpiResidB, pg8::StaticOrder, true, true>(ring, g, S, E, tid);
            SEAM(pb + 5);
        }
    }
#ifdef DBG_DUMP
    if (IN(N_PHASES - 1)) { PHASE_BEGIN(); const bf16* src = (const bf16*)(ws + DBG_DUMP); for (size_t i = (size_t)bx * 512 + tid; i < (size_t)MTOK * DM / 2; i += (size_t)G * 512) { const unsigned w = ((const unsigned*)src)[i]; A.out[2 * i] = bf_lo(w); A.out[2 * i + 1] = bf_hi(w); } }
#else
    if (IN(N_PHASES - 1)) { PHASE_BEGIN(); REP(7) ph_final(A, bx * 8 + wave, G * 8, lane); }
#endif
#undef IN
#undef INL
#undef SEAM
}

#ifndef MK_LAUNCH_PER_PHASE
#define MK_LAUNCH_PER_PHASE 0
#endif
extern "C" void kernel_launch(void* const* d_in, const int* in_sizes, int n_in, void* d_out, int out_size, void* d_ws, size_t ws_size, hipStream_t stream) {
    static int grid = 0;
    if (grid == 0) {
        if (n_in != 16 || in_sizes[0] != MTOK * DM || out_size != MTOK * DM || ws_size < WS_END) { fprintf(stderr, "kernel_launch: unexpected shapes (n_in %d, in0 %d, out %d, ws %zu)\n", n_in, n_in > 0 ? in_sizes[0] : -1, out_size, ws_size); grid = -1; return; }
        int dev = 0, cus = 0, per_cu = 0;
        if (hipGetDevice(&dev) != hipSuccess || hipDeviceGetAttribute(&cus, hipDeviceAttributeMultiprocessorCount, dev) != hipSuccess) { grid = -1; return; }
        if (hipFuncSetAttribute((const void*)fwd_kernel, hipFuncAttributeMaxDynamicSharedMemorySize, LDS_BYTES) != hipSuccess) { fprintf(stderr, "kernel_launch: hipFuncSetAttribute failed\n"); grid = -1; return; }
        if (hipOccupancyMaxActiveBlocksPerMultiprocessor(&per_cu, (const void*)fwd_kernel, 512, LDS_BYTES) != hipSuccess || per_cu < 1) { fprintf(stderr, "kernel_launch: occupancy query reports %d\n", per_cu); }
        (void)hipGetLastError();
        grid = cus;
    }
    if (grid < 0) return;
    (void)hipMemsetAsync((char*)d_ws + WS_CTL, 0, CTL_ZERO_BYTES, stream);
    Args a; memset(&a, 0, sizeof(a));
    for (int i = 0; i < 16; ++i) a.in[i] = (const float*)d_in[i];
    a.out = (float*)d_out; a.ws = (unsigned char*)d_ws;
#if MK_LAUNCH_PER_PHASE
    for (int p = 0; p < N_PHASES; ++p) { a.ph_lo = p; a.ph_hi = p + 1; hipLaunchKernelGGL(fwd_kernel, dim3(grid), dim3(512), LDS_BYTES, stream, a); }
#else
    a.ph_lo = 0; a.ph_hi = N_PHASES; hipLaunchKernelGGL(fwd_kernel, dim3(grid), dim3(512), LDS_BYTES, stream, a);
#endif
}
```
